# Optimizing an MI355X kernel written in HIP

```python
import jax
import jax.numpy as jnp
from jax import lax
import numpy as np

D_MODEL = 1024
BATCH = 8
SEQ = 4096
DEPTH = 2

HEAD_DIM = 64
NSA_HEADS = 6
NSA_KV_GROUPS = 2
NSA_HPG = NSA_HEADS // NSA_KV_GROUPS
SB_HEADS = 5
MLA_HEADS = 5
NSA_D = NSA_HEADS * HEAD_DIM
NSA_KV = NSA_KV_GROUPS * HEAD_DIM
SB_D = SB_HEADS * HEAD_DIM
MLA_NOPE = 64
MLA_ROPE = 32
MLA_V = 64
MLA_Q_RANK = 192
MLA_KV_RANK = 128
MLA_D = MLA_HEADS * MLA_V
D_MIX = NSA_D + SB_D + MLA_D
CMP_LEN = 32
CMP_STRIDE = 16
CMP_HIDDEN = 128
SEL_BLOCK = 64
SEL_TOPK = 16
WINDOW = 512
Q_BLOCK = 128
ROPE_THETA = 10000.0
EPS = 1e-6
NEG_INF = -1e30
SEL_FORCE = 1e9

IN_WIDTHS = (
    NSA_D,
    NSA_KV, NSA_KV, NSA_KV, NSA_KV, NSA_KV, NSA_KV,
    NSA_HEADS * 3,
    NSA_D,
    SB_D, SB_D, SB_D, SB_D,
    MLA_Q_RANK, MLA_KV_RANK, MLA_ROPE,
    MLA_D,
)
D_IN = sum(IN_WIDTHS)
IN_SPLITS = tuple(int(v) for v in np.cumsum(IN_WIDTHS)[:-1])

kernel_name = 'hybrid_nsa_stickbreak_mla_block'


def rmsnorm(x, g):
    xf = x.astype(jnp.float32)
    y = xf * lax.rsqrt(jnp.mean(xf * xf, axis=-1, keepdims=True) + EPS)
    return (y * g.astype(jnp.float32)).astype(x.dtype)


def rope(x, pos):
    half = x.shape[-1] // 2
    inv = ROPE_THETA ** (-jnp.arange(half, dtype=jnp.float32) / half)
    ang = pos.astype(jnp.float32)[..., None] * inv
    ang = ang.reshape((ang.shape[0],) + (1,) * (x.ndim - 3) + ang.shape[1:])
    cos, sin = jnp.cos(ang), jnp.sin(ang)
    xf = x.astype(jnp.float32)
    x1, x2 = xf[..., :half], xf[..., half:]
    return jnp.concatenate([x1 * cos - x2 * sin, x2 * cos + x1 * sin], axis=-1).astype(x.dtype)


def masked_softmax(s, mask):
    p = jax.nn.softmax(jnp.where(mask, s, NEG_INF), axis=-1)
    return jnp.where(mask, p, 0.0)


def nsa_attention(q, k_cmp, v_cmp, k_slc, v_slc, k_win, v_win, gates,
                  pos_k, pos_v, ck_w1, ck_w2, cv_w1, cv_w2):
    B, G, HPG, S, D = q.shape
    scale = D ** -0.5
    n_cmp = (S - CMP_LEN) // CMP_STRIDE + 1
    cmp_idx = np.arange(n_cmp)[:, None] * CMP_STRIDE + np.arange(CMP_LEN)[None, :]
    cmp_end = jnp.asarray(cmp_idx[:, -1])

    def compress(tok, pos_emb, w1, w2):
        blk = (tok[:, :, cmp_idx] + pos_emb).reshape(B, G, n_cmp, CMP_LEN * D)
        return jax.nn.silu(blk @ w1) @ w2

    kc = compress(k_cmp, pos_k, ck_w1, ck_w2)
    vc = compress(v_cmp, pos_v, cv_w1, cv_w2)

    n_sel = S // SEL_BLOCK
    top = min(SEL_TOPK, n_sel)
    c_start = cmp_idx[:, 0]
    s_start = np.arange(n_sel) * SEL_BLOCK
    overlap = jnp.asarray((c_start[:, None] < s_start[None, :] + SEL_BLOCK)
                          & (c_start[:, None] + CMP_LEN > s_start[None, :]), dtype=jnp.float32)
    ks_blk = k_slc.reshape(B, G, n_sel, SEL_BLOCK, D)
    vs_blk = v_slc.reshape(B, G, n_sel, SEL_BLOCK, D)
    kw_pad = jnp.pad(k_win, ((0, 0), (0, 0), (WINDOW, 0), (0, 0)))
    vw_pad = jnp.pad(v_win, ((0, 0), (0, 0), (WINDOW, 0), (0, 0)))
    b_ix = jnp.arange(B)[:, None, None, None]
    g_ix = jnp.arange(G)[None, :, None, None]
    sel_j = jnp.arange(n_sel)

    def block(i):
        q0 = i * Q_BLOCK
        t = q0 + jnp.arange(Q_BLOCK)
        qb = lax.dynamic_slice_in_dim(q, q0, Q_BLOCK, axis=3)
        gb = lax.dynamic_slice_in_dim(gates, q0, Q_BLOCK, axis=3)
        s_c = jnp.einsum('bghtd,bgnd->bghtn', qb, kc).astype(jnp.float32) * scale
        p_c = masked_softmax(s_c, cmp_end[None, :] <= t[:, None])
        o_c = jnp.einsum('bghtn,bgnd->bghtd', p_c.astype(vc.dtype), vc)
        imp = jnp.einsum('bghtn,nj->bgtj', p_c, overlap)
        cur = (t // SEL_BLOCK)[:, None]
        forced = (sel_j == 0) | (sel_j == cur) | (sel_j == cur - 1)
        valid = sel_j * SEL_BLOCK <= t[:, None]
        imp = jnp.where(valid, jnp.where(forced, SEL_FORCE, imp), -SEL_FORCE)
        _, top_idx = lax.top_k(imp, top)
        k_g = ks_blk[b_ix, g_ix, top_idx].reshape(B, G, Q_BLOCK, top * SEL_BLOCK, D)
        v_g = vs_blk[b_ix, g_ix, top_idx].reshape(B, G, Q_BLOCK, top * SEL_BLOCK, D)
        tok = (top_idx[..., None] * SEL_BLOCK + jnp.arange(SEL_BLOCK)).reshape(B, G, Q_BLOCK, top * SEL_BLOCK)
        m_s = (tok <= t[:, None])[:, :, None]
        s_s = jnp.einsum('bghtd,bgtkd->bghtk', qb, k_g).astype(jnp.float32) * scale
        p_s = masked_softmax(s_s, m_s)
        o_s = jnp.einsum('bghtk,bgtkd->bghtd', p_s.astype(v_g.dtype), v_g)
        kwb = lax.dynamic_slice_in_dim(kw_pad, q0, Q_BLOCK + WINDOW, axis=2)
        vwb = lax.dynamic_slice_in_dim(vw_pad, q0, Q_BLOCK + WINDOW, axis=2)
        s_pos = q0 - WINDOW + jnp.arange(Q_BLOCK + WINDOW)
        m_w = (s_pos[None, :] <= t[:, None]) & (s_pos[None, :] > t[:, None] - WINDOW) & (s_pos[None, :] >= 0)
        s_w = jnp.einsum('bghtd,bgsd->bghts', qb, kwb).astype(jnp.float32) * scale
        p_w = masked_softmax(s_w, m_w)
        o_w = jnp.einsum('bghts,bgsd->bghtd', p_w.astype(vwb.dtype), vwb)
        return gb[..., 0:1] * o_c + gb[..., 1:2] * o_s + gb[..., 2:3] * o_w

    out = lax.map(block, jnp.arange(S // Q_BLOCK))
    return out.transpose(1, 0, 4, 2, 3, 5).reshape(B, S, G * HPG * D)


def stick_breaking_attention(q, k, v):
    B, H, S, D = q.shape
    scale = D ** -0.5
    s_pos = jnp.arange(S)

    def block(i):
        q0 = i * Q_BLOCK
        t = q0 + jnp.arange(Q_BLOCK)
        qb = lax.dynamic_slice_in_dim(q, q0, Q_BLOCK, axis=2)
        z = jnp.einsum('bhtd,bhsd->bhts', qb, k).astype(jnp.float32) * scale
        mask = s_pos[None, :] < t[:, None]
        log_1mb = jnp.where(mask, jax.nn.log_sigmoid(-z), 0.0)
        rev = lax.cumsum(log_1mb, axis=3, reverse=True)
        between = jnp.concatenate([rev[..., 1:], jnp.zeros_like(rev[..., :1])], axis=-1)
        a = jnp.where(mask, jnp.exp(jax.nn.log_sigmoid(z) + between), 0.0)
        return jnp.einsum('bhts,bhsd->bhtd', a.astype(v.dtype), v)

    out = lax.map(block, jnp.arange(S // Q_BLOCK))
    return out.transpose(1, 0, 3, 2, 4).reshape(B, S, H * D)


def causal_attention(q, k, v):
    B, H, S, Dk = q.shape
    scale = Dk ** -0.5
    s_pos = jnp.arange(S)

    def block(i):
        q0 = i * Q_BLOCK
        t = q0 + jnp.arange(Q_BLOCK)
        qb = lax.dynamic_slice_in_dim(q, q0, Q_BLOCK, axis=2)
        s = jnp.einsum('bhtd,bhsd->bhts', qb, k).astype(jnp.float32) * scale
        p = masked_softmax(s, s_pos[None, :] <= t[:, None])
        return jnp.einsum('bhts,bhsd->bhtd', p.astype(v.dtype), v)

    out = lax.map(block, jnp.arange(S // Q_BLOCK))
    return out.transpose(1, 0, 3, 2, 4).reshape(B, S, H * v.shape[-1])


def hybrid_mixer(h, positions, w_in, pos_k, pos_v, ck_w1, ck_w2, cv_w1, cv_w2,
                 q_norm, w_uq, kv_norm, w_ukv, w_out):
    B, S, _ = h.shape
    (n_q, n_kc, n_vc, n_ks, n_vs, n_kw, n_vw, n_gate, n_z,
     s_q, s_k, s_v, s_z, m_cq, m_ckv, m_kr, m_z) = jnp.split(h @ w_in, IN_SPLITS, axis=-1)

    def heads(t, n):
        return t.reshape(B, S, n, -1).transpose(0, 2, 1, 3)

    q_a = rope(n_q.reshape(B, S, NSA_KV_GROUPS, NSA_HPG, HEAD_DIM).transpose(0, 2, 3, 1, 4), positions)
    gates = jax.nn.sigmoid(n_gate.reshape(B, S, NSA_KV_GROUPS, NSA_HPG, 3).transpose(0, 2, 3, 1, 4))
    o_a = nsa_attention(q_a,
                        rope(heads(n_kc, NSA_KV_GROUPS), positions), heads(n_vc, NSA_KV_GROUPS),
                        rope(heads(n_ks, NSA_KV_GROUPS), positions), heads(n_vs, NSA_KV_GROUPS),
                        rope(heads(n_kw, NSA_KV_GROUPS), positions), heads(n_vw, NSA_KV_GROUPS),
                        gates, pos_k, pos_v, ck_w1, ck_w2, cv_w1, cv_w2) * jax.nn.silu(n_z)

    o_b = stick_breaking_attention(heads(s_q, SB_HEADS), heads(s_k, SB_HEADS),
                                   heads(s_v, SB_HEADS)) * jax.nn.silu(s_z)

    qh = heads(rmsnorm(m_cq, q_norm) @ w_uq, MLA_HEADS)
    kvh = heads(rmsnorm(m_ckv, kv_norm) @ w_ukv, MLA_HEADS)
    k_pe = rope(m_kr[:, None], positions)
    q_c = jnp.concatenate([qh[..., :MLA_NOPE], rope(qh[..., MLA_NOPE:], positions)], axis=-1)
    k_c = jnp.concatenate([kvh[..., :MLA_NOPE], jnp.broadcast_to(k_pe, (B, MLA_HEADS, S, MLA_ROPE))], axis=-1)
    o_c = causal_attention(q_c, k_c, kvh[..., MLA_NOPE:]) * jax.nn.silu(m_z)

    return jnp.concatenate([o_a, o_b, o_c], axis=-1) @ w_out


def setup_inputs(seed: int = 0) -> dict:
    key = jax.random.key(seed)
    ks = jax.random.split(key, 24)

    def nrm(k, shape, scale):
        return jax.random.normal(k, shape, jnp.float32) * scale

    x = nrm(ks[0], (BATCH, SEQ, D_MODEL), 1.0)
    c = nrm(ks[1], (BATCH, D_MODEL), 1.0)
    start = jax.random.randint(ks[2], (BATCH, 1), 0, 2048, dtype=jnp.int32)
    positions = (start + jnp.arange(SEQ, dtype=jnp.int32)[None, :]).astype(jnp.int32)
    return {
        'x': x,
        'c': c,
        'positions': positions,
        'ada_w': nrm(ks[3], (DEPTH, D_MODEL, 3 * D_MODEL), 0.5 * D_MODEL ** -0.5),
        'ada_b': nrm(ks[4], (DEPTH, 3 * D_MODEL), 0.01),
        'norm_g': 1.0 + nrm(ks[5], (DEPTH, D_MODEL), 0.01),
        'w_in': nrm(ks[6], (DEPTH, D_MODEL, D_IN), D_MODEL ** -0.5),
        'nsa_pos_k': nrm(ks[7], (DEPTH, CMP_LEN, HEAD_DIM), 0.1),
        'nsa_pos_v': nrm(ks[8], (DEPTH, CMP_LEN, HEAD_DIM), 0.1),
        'nsa_ck_w1': nrm(ks[9], (DEPTH, CMP_LEN * HEAD_DIM, CMP_HIDDEN), (CMP_LEN * HEAD_DIM) ** -0.5),
        'nsa_ck_w2': nrm(ks[10], (DEPTH, CMP_HIDDEN, HEAD_DIM), CMP_HIDDEN ** -0.5),
        'nsa_cv_w1': nrm(ks[11], (DEPTH, CMP_LEN * HEAD_DIM, CMP_HIDDEN), (CMP_LEN * HEAD_DIM) ** -0.5),
        'nsa_cv_w2': nrm(ks[12], (DEPTH, CMP_HIDDEN, HEAD_DIM), CMP_HIDDEN ** -0.5),
        'mla_q_norm': 1.0 + nrm(ks[13], (DEPTH, MLA_Q_RANK), 0.01),
        'mla_w_uq': nrm(ks[14], (DEPTH, MLA_Q_RANK, MLA_HEADS * (MLA_NOPE + MLA_ROPE)), MLA_Q_RANK ** -0.5),
        'mla_kv_norm': 1.0 + nrm(ks[15], (DEPTH, MLA_KV_RANK), 0.01),
        'mla_w_ukv': nrm(ks[16], (DEPTH, MLA_KV_RANK, MLA_HEADS * (MLA_NOPE + MLA_V)), MLA_KV_RANK ** -0.5),
        'w_out': nrm(ks[17], (DEPTH, D_MIX, D_MODEL), D_MIX ** -0.5),
        'final_norm': 1.0 + nrm(ks[18], (D_MODEL,), 0.01),
    }


def reference(x, c, positions, ada_w, ada_b, norm_g, w_in, nsa_pos_k, nsa_pos_v,
              nsa_ck_w1, nsa_ck_w2, nsa_cv_w1, nsa_cv_w2, mla_q_norm, mla_w_uq,
              mla_kv_norm, mla_w_ukv, w_out, final_norm):
    for l in range(DEPTH):
        mod = jax.nn.silu(c) @ ada_w[l] + ada_b[l]
        shift, scale, gate = jnp.split(mod, 3, axis=-1)
        h = rmsnorm(x, norm_g[l]) * (1.0 + scale[:, None, :]) + shift[:, None, :]
        y = hybrid_mixer(h, positions, w_in[l], nsa_pos_k[l], nsa_pos_v[l],
                         nsa_ck_w1[l], nsa_ck_w2[l], nsa_cv_w1[l], nsa_cv_w2[l],
                         mla_q_norm[l], mla_w_uq[l], mla_kv_norm[l], mla_w_ukv[l], w_out[l])
        x = x + gate[:, None, :] * y
    return rmsnorm(x, final_norm)
```

```cpp
#include <hip/hip_runtime.h>
#include <cstdio>
#include <cstdint>
#include <cmath>

typedef unsigned short bf16_t;
typedef unsigned long long u64;

constexpr int NB = 8, SEQ = 4096, DM = 1024, M = NB * SEQ, DEPTH = 2;
constexpr int D_IN = 3506;
constexpr int NCMP = 255;
constexpr int ACTW = 3584;
constexpr int A_NQ = 0, A_KC = 384, A_VC = 512, A_KS = 640, A_VS = 768, A_KW = 896, A_VW = 1024;
constexpr int A_NZ = 1152, A_SQ = 1536, A_SK = 1856, A_SV = 2176, A_SZ = 2496;
constexpr int A_MCQ = 2816, A_MCKV = 3008, A_MKR = 3136, A_GATE = 3168, A_MZ = 3200;
constexpr float LOG2E = 1.4426950408889634f;
constexpr float QS_NSA = 0.125f * LOG2E;
constexpr float QS_MLA = 0.10206207261596577f * LOG2E;

constexpr size_t MiB = 1u << 20;
constexpr size_t WS_CTL = 0;
constexpr size_t WS_MOD = 1 * MiB;
constexpr size_t WS_CS64 = 2 * MiB;
constexpr size_t WS_CS32 = 10 * MiB;
constexpr size_t WS_POSB = 14 * MiB;
constexpr size_t WS_HID = 15 * MiB;
constexpr size_t WS_H = 64 * MiB;
constexpr size_t WS_MIX = 64 * MiB;
constexpr size_t WS_ACT = 128 * MiB;
constexpr size_t WS_MQ = 352 * MiB;
constexpr size_t WS_MK = 382 * MiB;
constexpr size_t WS_MV = 412 * MiB;
constexpr size_t WS_OC = 432 * MiB;
constexpr size_t WS_KC = 456 * MiB;
constexpr size_t WS_VC = 457 * MiB;
constexpr size_t WS_SEL = 458 * MiB;
constexpr size_t WS_END = 460 * MiB;

__device__ __forceinline__ float bf2f(bf16_t v) { return __uint_as_float(((unsigned)v) << 16); }
__device__ __forceinline__ bf16_t f2bf(float f) { unsigned u = __float_as_uint(f); return (bf16_t)((u + 0x7fffu + ((u >> 16) & 1u)) >> 16); }
__device__ __forceinline__ float blo(unsigned u) { return __uint_as_float(u << 16); }
__device__ __forceinline__ float bhi(unsigned u) { return __uint_as_float(u & 0xffff0000u); }
__device__ __forceinline__ float silu_f(float v) { return v / (1.f + __expf(-v)); }
__device__ __forceinline__ float sigm_f(float v) { return 1.f / (1.f + __expf(-v)); }

struct RopeInv { float i64[32]; float i32[16]; };

__global__ void nv_prep_mod(const float* c, const float* ada_w, const float* ada_b, float* mod) {
    int idx = blockIdx.x * 256 + threadIdx.x; if (idx >= DEPTH * NB * 3072) return;
    int col = idx % 3072, b = (idx / 3072) % NB, l = idx / (3072 * NB);
    float acc = ada_b[l * 3072 + col];
    for (int k = 0; k < DM; ++k) { float cv = c[b * DM + k]; acc += silu_f(cv) * ada_w[((size_t)l * DM + k) * 3072 + col]; }
    mod[idx] = acc;
}
__device__ __forceinline__ void sincos_rev(float ang, float& s, float& c) {
    double rev = (double)ang * 0.15915494309189535; rev -= rint(rev);
    float r = (float)rev; s = __builtin_amdgcn_sinf(r); c = __builtin_amdgcn_cosf(r);
}
__global__ void nv_prep_rope(const int* pos, RopeInv inv, float* cs64, float* cs32) {
    int idx = blockIdx.x * 256 + threadIdx.x; if (idx >= M * 48) return;
    int m = idx / 48, i = idx % 48; float p = (float)pos[m];
    if (i < 32) { float ang = p * inv.i64[i], s, c; sincos_rev(ang, s, c); cs64[((size_t)m * 32 + i) * 2] = c; cs64[((size_t)m * 32 + i) * 2 + 1] = s; }
    else { int j = i - 32; float ang = p * inv.i32[j], s, c; sincos_rev(ang, s, c); cs32[((size_t)m * 16 + j) * 2] = c; cs32[((size_t)m * 16 + j) * 2 + 1] = s; }
}
__global__ void nv_prep_posb(const float* pos_k, const float* pos_v, const float* ck_w1, const float* cv_w1, float* posb) {
    int idx = blockIdx.x * 256 + threadIdx.x; if (idx >= DEPTH * 2 * 128) return;
    int u = idx % 128, kv = (idx / 128) % 2, l = idx / 256;
    const float* pe = (kv ? pos_v : pos_k) + (size_t)l * 2048; const float* w1 = (kv ? cv_w1 : ck_w1) + (size_t)l * 2048 * 128;
    float acc = 0.f; for (int k = 0; k < 2048; ++k) acc += pe[k] * w1[(size_t)k * 128 + u];
    posb[idx] = acc;
}

__global__ void nv_norm_mod(const float* x, const float* g, const float* mod, bf16_t* H) {
    int row = blockIdx.x * 4 + (threadIdx.x >> 6), lane = threadIdx.x & 63; int b = row / SEQ;
    const float* xr = x + (size_t)row * DM; float v[16]; float ss = 0.f;
#pragma unroll
    for (int j = 0; j < 4; ++j) { float4 t = *(const float4*)(xr + j * 256 + lane * 4); v[4 * j] = t.x; v[4 * j + 1] = t.y; v[4 * j + 2] = t.z; v[4 * j + 3] = t.w; ss += t.x * t.x + t.y * t.y + t.z * t.z + t.w * t.w; }
#pragma unroll
    for (int o = 1; o < 64; o <<= 1) ss += __shfl_xor(ss, o);
    float r = rsqrtf(ss * (1.f / DM) + 1e-6f);
    const float* sh = mod + (size_t)b * 3072, * sc = sh + 1024;
#pragma unroll
    for (int j = 0; j < 4; ++j)
#pragma unroll
        for (int e = 0; e < 4; ++e) { int c = j * 256 + lane * 4 + e; float h = v[4 * j + e] * r * g[c] * (1.f + sc[c]) + sh[c]; H[(size_t)row * DM + c] = f2bf(h); }
}
__global__ void nv_final_norm(float* xo, const float* g) {
    int row = blockIdx.x * 4 + (threadIdx.x >> 6), lane = threadIdx.x & 63;
    float* xr = xo + (size_t)row * DM; float v[16]; float ss = 0.f;
#pragma unroll
    for (int j = 0; j < 4; ++j) { float4 t = *(const float4*)(xr + j * 256 + lane * 4); v[4 * j] = t.x; v[4 * j + 1] = t.y; v[4 * j + 2] = t.z; v[4 * j + 3] = t.w; ss += t.x * t.x + t.y * t.y + t.z * t.z + t.w * t.w; }
#pragma unroll
    for (int o = 1; o < 64; o <<= 1) ss += __shfl_xor(ss, o);
    float r = rsqrtf(ss * (1.f / DM) + 1e-6f);
#pragma unroll
    for (int j = 0; j < 4; ++j) { float4 t; int c = j * 256 + lane * 4; t.x = v[4 * j] * r * g[c]; t.y = v[4 * j + 1] * r * g[c + 1]; t.z = v[4 * j + 2] * r * g[c + 2]; t.w = v[4 * j + 3] * r * g[c + 3]; *(float4*)(xr + c) = t; }
}

__device__ __forceinline__ int inproj_src_col(int c) {
    if (c < 1152) return c;
    if (c < 1536) return 1170 + (c - 1152);
    if (c < 3168) return c + 18;
    if (c < 3200) return (c - 3168 < 18) ? 1152 + (c - 3168) : -1;
    if (c < 3520) return c - 14;
    return -1;
}
template <int MODE>
__global__ void __launch_bounds__(256) nv_gemm(const bf16_t* A, int lda, const float* W, int ldw, int K,
                                             bf16_t* ACT, const float* cs64, const float* cs32,
                                             const float* xin, float* xout, const float* gate) {
    __shared__ float As[16][65]; __shared__ float Bs[16][65]; __shared__ float Cs[64][65];
    const int tid = threadIdx.x, tx = tid & 15, ty = tid >> 4;
    const int row0 = blockIdx.y * 64, col0 = blockIdx.x * 64;
    const int bc = tid & 63; int sc = (MODE == 0) ? inproj_src_col(col0 + bc) : col0 + bc;
    float acc[4][4] = {};
    for (int k0 = 0; k0 < K; k0 += 16) {
#pragma unroll
        for (int i = 0; i < 4; ++i) { int e = tid + 256 * i; int r = e >> 4, kk = e & 15; As[kk][r] = bf2f(A[(size_t)(row0 + r) * lda + k0 + kk]); }
#pragma unroll
        for (int i = 0; i < 4; ++i) { int kk = (tid >> 6) + 4 * i; Bs[kk][bc] = (sc >= 0) ? W[(size_t)(k0 + kk) * ldw + sc] : 0.f; }
        __syncthreads();
#pragma unroll
        for (int kk = 0; kk < 16; ++kk) { float a[4], b[4];
#pragma unroll
            for (int i = 0; i < 4; ++i) { a[i] = As[kk][ty * 4 + i]; b[i] = Bs[kk][tx * 4 + i]; }
#pragma unroll
            for (int i = 0; i < 4; ++i)
#pragma unroll
                for (int j = 0; j < 4; ++j) acc[i][j] += a[i] * b[j]; }
        __syncthreads();
    }
#pragma unroll
    for (int i = 0; i < 4; ++i)
#pragma unroll
        for (int j = 0; j < 4; ++j) Cs[ty * 4 + i][tx * 4 + j] = acc[i][j];
    __syncthreads();
    for (int e = tid; e < 64 * 64; e += 256) {
        int r = e >> 6, cc = e & 63; int m = row0 + r, c = col0 + cc; float v = Cs[r][cc];
        if (MODE == 1) { int b = m / SEQ; xout[(size_t)m * DM + c] = xin[(size_t)m * DM + c] + gate[(size_t)b * 3072 + c] * v; continue; }
        float o;
        if (c < 384 || (c >= A_KC && c < A_VC) || (c >= A_KS && c < A_VS) || (c >= A_KW && c < A_VW)) {
            int i = cc & 31; float cs = cs64[((size_t)m * 32 + i) * 2], sn = cs64[((size_t)m * 32 + i) * 2 + 1];
            float x1 = Cs[r][i], x2 = Cs[r][i + 32];
            o = (cc < 32) ? (x1 * cs - x2 * sn) : (x2 * cs + x1 * sn);
            if (c < 384) o *= QS_NSA;
        } else if (c < A_NZ) o = v;
        else if (c < A_SQ) o = silu_f(v);
        else if (c < A_SK) o = v * 0.125f;
        else if (c < A_SZ) o = v;
        else if (c < A_MCQ) o = silu_f(v);
        else if (c < A_MKR) o = v;
        else if (c < A_GATE) { int i = cc & 15; float cs = cs32[((size_t)m * 16 + i) * 2], sn = cs32[((size_t)m * 16 + i) * 2 + 1];
            float x1 = Cs[r][i], x2 = Cs[r][i + 16]; o = (cc < 16) ? (x1 * cs - x2 * sn) : (x2 * cs + x1 * sn); }
        else if (c < A_MZ) o = (c - A_GATE < 18) ? sigm_f(v) : 0.f;
        else if (c < 3520) o = silu_f(v);
        else o = 0.f;
        ACT[(size_t)m * ACTW + c] = f2bf(o);
    }
}

__global__ void nv_mla_up(const bf16_t* ACT, const float* qn, const float* wuq, const float* kvn, const float* wukv, bf16_t* MQ, bf16_t* MK, bf16_t* MV) {
    __shared__ float xq[192]; __shared__ float xkv[128]; __shared__ float red[2];
    int m = blockIdx.x, tid = threadIdx.x; const bf16_t* a = ACT + (size_t)m * ACTW;
    if (tid < 192) xq[tid] = bf2f(a[A_MCQ + tid]); if (tid < 128) xkv[tid] = bf2f(a[A_MCKV + tid]);
    __syncthreads();
    if (tid == 0) { float s = 0; for (int k = 0; k < 192; ++k) s += xq[k] * xq[k]; red[0] = rsqrtf(s / 192.f + 1e-6f); s = 0; for (int k = 0; k < 128; ++k) s += xkv[k] * xkv[k]; red[1] = rsqrtf(s / 128.f + 1e-6f); }
    __syncthreads();
    float rq = red[0], rkv = red[1];
    if (tid < 192) xq[tid] = xq[tid] * rq * qn[tid]; if (tid < 128) xkv[tid] = xkv[tid] * rkv * kvn[tid];
    __syncthreads();
    for (int j = tid; j < 480; j += 256) { int h = j / 96, e = j % 96;
        if (e < 64) { float s = 0; for (int k = 0; k < 192; ++k) s += xq[k] * wuq[(size_t)k * 480 + j]; MQ[(size_t)m * 480 + j] = f2bf(s * QS_MLA); }
        else if (e < 80) { int i = e - 64; float s1 = 0, s2 = 0; for (int k = 0; k < 192; ++k) { s1 += xq[k] * wuq[(size_t)k * 480 + j]; s2 += xq[k] * wuq[(size_t)k * 480 + j + 16]; }
            MQ[(size_t)m * 480 + h * 96 + 64 + i] = f2bf(s1); MQ[(size_t)m * 480 + h * 96 + 80 + i] = f2bf(s2); } }
    for (int j = tid; j < 640; j += 256) { int h = j / 128, e = j % 128; float s = 0; for (int k = 0; k < 128; ++k) s += xkv[k] * wukv[(size_t)k * 640 + j];
        if (e < 64) MK[(size_t)m * 480 + h * 96 + e] = f2bf(s); else MV[(size_t)m * 320 + h * 64 + e - 64] = f2bf(s); }
    for (int j = tid; j < 160; j += 256) { int h = j / 32, i = j % 32; MK[(size_t)m * 480 + h * 96 + 64 + i] = a[A_MKR + i]; }
}
__global__ void nv_mla_qrope(bf16_t* MQ, const float* cs32) {
    int idx = blockIdx.x * 256 + threadIdx.x; if (idx >= M * 80) return;
    int m = idx / 80, r = idx % 80, h = r / 16, i = r % 16;
    bf16_t* p = MQ + (size_t)m * 480 + h * 96 + 64; float x1 = bf2f(p[i]), x2 = bf2f(p[i + 16]);
    float cs = cs32[((size_t)m * 16 + i) * 2], sn = cs32[((size_t)m * 16 + i) * 2 + 1];
    p[i] = f2bf((x1 * cs - x2 * sn) * QS_MLA); p[i + 16] = f2bf((x2 * cs + x1 * sn) * QS_MLA);
}

__global__ void nv_cmp_hidden(const bf16_t* ACT, const float* ck_w1, const float* cv_w1, const float* posb, float* HID) {
    int n = blockIdx.x, bg = blockIdx.y, kv = blockIdx.z, u = threadIdx.x; int b = bg >> 1, g = bg & 1;
    const float* w1 = kv ? cv_w1 : ck_w1; const int col = (kv ? A_VC : A_KC) + g * 64;
    __shared__ float tok[2048];
    for (int e = u; e < 2048; e += 128) { int j = e >> 6, d = e & 63; tok[e] = bf2f(ACT[(size_t)(b * SEQ + 16 * n + j) * ACTW + col + d]); }
    __syncthreads();
    float acc = posb[kv * 128 + u];
    for (int k = 0; k < 2048; ++k) acc += tok[k] * w1[(size_t)k * 128 + u];
    HID[(((size_t)kv * 16 + bg) * 256 + n) * 128 + u] = silu_f(acc);
}
__global__ void nv_cmp_out(const float* HID, const float* ck_w2, const float* cv_w2, bf16_t* KC, bf16_t* VC) {
    int n = blockIdx.x, bg = blockIdx.y, kv = blockIdx.z, d = threadIdx.x;
    bf16_t* out = (kv ? VC : KC) + ((size_t)bg * 256 + n) * 64 + d;
    if (n >= NCMP) { *out = 0; return; }
    const float* w2 = kv ? cv_w2 : ck_w2; const float* h = HID + (((size_t)kv * 16 + bg) * 256 + n) * 128;
    float acc = 0; for (int u = 0; u < 128; ++u) acc += h[u] * w2[u * 64 + d];
    *out = f2bf(acc);
}

#define DOT64(res, qarr, kptr) do { const uint4* _kp = (const uint4*)(kptr); float _s = 0.f; \
    _Pragma("unroll") for (int _c = 0; _c < 8; ++_c) { uint4 _v = _kp[_c]; \
      _s += qarr[8*_c+0]*blo(_v.x) + qarr[8*_c+1]*bhi(_v.x) + qarr[8*_c+2]*blo(_v.y) + qarr[8*_c+3]*bhi(_v.y) \
          + qarr[8*_c+4]*blo(_v.z) + qarr[8*_c+5]*bhi(_v.z) + qarr[8*_c+6]*blo(_v.w) + qarr[8*_c+7]*bhi(_v.w); } res = _s; } while (0)
#define AXPY64(oarr, p, vptr) do { const uint4* _vp = (const uint4*)(vptr); \
    _Pragma("unroll") for (int _c = 0; _c < 8; ++_c) { uint4 _v = _vp[_c]; \
      oarr[8*_c+0] += p*blo(_v.x); oarr[8*_c+1] += p*bhi(_v.x); oarr[8*_c+2] += p*blo(_v.y); oarr[8*_c+3] += p*bhi(_v.y); \
      oarr[8*_c+4] += p*blo(_v.z); oarr[8*_c+5] += p*bhi(_v.z); oarr[8*_c+6] += p*blo(_v.w); oarr[8*_c+7] += p*bhi(_v.w); } } while (0)
#define LOADQ64(qarr, qptr) do { const uint4* _qp = (const uint4*)(qptr); \
    _Pragma("unroll") for (int _c = 0; _c < 8; ++_c) { uint4 _v = _qp[_c]; \
      qarr[8*_c+0] = blo(_v.x); qarr[8*_c+1] = bhi(_v.x); qarr[8*_c+2] = blo(_v.y); qarr[8*_c+3] = bhi(_v.y); \
      qarr[8*_c+4] = blo(_v.z); qarr[8*_c+5] = bhi(_v.z); qarr[8*_c+6] = blo(_v.w); qarr[8*_c+7] = bhi(_v.w); } } while (0)

__global__ void __launch_bounds__(64) nv_nsa_cmp(const bf16_t* ACT, const bf16_t* KC, const bf16_t* VC, bf16_t* OC, u64* SEL) {
    __shared__ float imp[64][64];
    const int tid = threadIdx.x, t = blockIdx.x * 64 + tid, bg = blockIdx.y, b = bg >> 1, g = bg & 1; const size_t m = (size_t)b * SEQ + t;
    for (int j = 0; j < 64; ++j) imp[j][tid] = 0.f;
    const bf16_t* kc = KC + (size_t)bg * 256 * 64; const bf16_t* vc = VC + (size_t)bg * 256 * 64;
    const int nvalid = (t >= 31) ? min(NCMP, (t - 31) / 16 + 1) : 0;
    for (int hh = 0; hh < 3; ++hh) {
        const int h = g * 3 + hh; float q[64]; LOADQ64(q, ACT + m * ACTW + A_NQ + h * 64);
        float mx = -3e38f;
        for (int n = 0; n < nvalid; ++n) { float s; DOT64(s, q, kc + n * 64); mx = fmaxf(mx, s); }
        float l = 0.f;
        for (int n = 0; n < nvalid; ++n) { float s; DOT64(s, q, kc + n * 64); l += exp2f(s - mx); }
        float o[64];
#pragma unroll
        for (int d = 0; d < 64; ++d) o[d] = 0.f;
        const float il = (nvalid > 0) ? 1.f / l : 0.f;
        for (int n = 0; n < nvalid; ++n) { float s; DOT64(s, q, kc + n * 64); float p = exp2f(s - mx) * il; AXPY64(o, p, vc + n * 64);
            imp[n >> 2][tid] += p; if ((n & 3) == 3 && (n >> 2) + 1 < 64) imp[(n >> 2) + 1][tid] += p; }
        const float gc = bf2f(ACT[m * ACTW + A_GATE + h * 3 + 0]);
#pragma unroll
        for (int d = 0; d < 64; ++d) OC[m * 384 + h * 64 + d] = f2bf(o[d] * gc);
    }
    const int cur = t >> 6; u64 mask = 0ull;
    for (int r = 0; r < 16; ++r) { float best = -3e38f; int bi = 0;
        for (int j = 0; j < 64; ++j) { if ((mask >> j) & 1ull) continue; const bool valid = (j * 64 <= t); const bool forced = (j == 0) || (j == cur) || (j == cur - 1);
            float v = valid ? (forced ? 1e9f : imp[j][tid]) : -1e9f; if (v > best) { best = v; bi = j; } }
        mask |= (1ull << bi); }
    u64 vmask = (cur >= 63) ? ~0ull : ((1ull << (cur + 1)) - 1ull);
    SEL[(size_t)bg * SEQ + t] = mask & vmask;
}

__global__ void __launch_bounds__(64) nv_nsa_sw(const bf16_t* ACT, const bf16_t* OC, const u64* SEL, bf16_t* MIX) {
    const int tid = threadIdx.x, t = blockIdx.x * 64 + tid, h = blockIdx.y, b = blockIdx.z, g = h / 3; const size_t m = (size_t)b * SEQ + t;
    float q[64]; LOADQ64(q, ACT + m * ACTW + A_NQ + h * 64);
    float out[64];
#pragma unroll
    for (int d = 0; d < 64; ++d) out[d] = bf2f(OC[m * 384 + h * 64 + d]);
    const u64 sel = SEL[((size_t)(b * 2 + g)) * SEQ + t];
    const bf16_t* base = ACT + (size_t)b * SEQ * ACTW;
    {
        float o[64];
#pragma unroll
        for (int d = 0; d < 64; ++d) o[d] = 0.f;
        float mx = -3e38f, l = 0.f;
        for (int j = 0; j < 64; ++j) { if (!((sel >> j) & 1ull)) continue;
            const int s1 = min(64 * j + 63, t);
            for (int s = 64 * j; s <= s1; ++s) { float sc; DOT64(sc, q, base + (size_t)s * ACTW + A_KS + g * 64);
                if (sc > mx) { float f = exp2f(mx - sc); l *= f;
#pragma unroll
                    for (int d = 0; d < 64; ++d) o[d] *= f;
                    mx = sc; }
                float p = exp2f(sc - mx); l += p; AXPY64(o, p, base + (size_t)s * ACTW + A_VS + g * 64); } }
        const float gs = bf2f(ACT[m * ACTW + A_GATE + h * 3 + 1]) / l;
#pragma unroll
        for (int d = 0; d < 64; ++d) out[d] += gs * o[d];
    }
    {
        float o[64];
#pragma unroll
        for (int d = 0; d < 64; ++d) o[d] = 0.f;
        float mx = -3e38f, l = 0.f;
        for (int s = max(0, t - 511); s <= t; ++s) { float sc; DOT64(sc, q, base + (size_t)s * ACTW + A_KW + g * 64);
            if (sc > mx) { float f = exp2f(mx - sc); l *= f;
#pragma unroll
                for (int d = 0; d < 64; ++d) o[d] *= f;
                mx = sc; }
            float p = exp2f(sc - mx); l += p; AXPY64(o, p, base + (size_t)s * ACTW + A_VW + g * 64); }
        const float gw = bf2f(ACT[m * ACTW + A_GATE + h * 3 + 2]) / l;
#pragma unroll
        for (int d = 0; d < 64; ++d) out[d] += gw * o[d];
    }
#pragma unroll
    for (int d = 0; d < 64; ++d) MIX[m * DM + h * 64 + d] = f2bf(out[d] * bf2f(ACT[m * ACTW + A_NZ + h * 64 + d]));
}

#ifndef SB_EARLY_EXIT
#define SB_EARLY_EXIT 0
#endif
__global__ void __launch_bounds__(64) nv_sb(const bf16_t* ACT, bf16_t* MIX) {
    const int tid = threadIdx.x, t = blockIdx.x * 64 + tid, h = blockIdx.y, b = blockIdx.z; const size_t m = (size_t)b * SEQ + t;
    float q[64]; LOADQ64(q, ACT + m * ACTW + A_SQ + h * 64);
    float o[64];
#pragma unroll
    for (int d = 0; d < 64; ++d) o[d] = 0.f;
    const bf16_t* base = ACT + (size_t)b * SEQ * ACTW; float R = 0.f;
    for (int s = t - 1; s >= 0; --s) { float z; DOT64(z, q, base + (size_t)s * ACTW + A_SK + h * 64);
        const float sp = fmaxf(z, 0.f) + log1pf(__expf(-fabsf(z)));
        const float a = __expf(z - sp - R); AXPY64(o, a, base + (size_t)s * ACTW + A_SV + h * 64); R += sp;
#if SB_EARLY_EXIT
        if (R >= 104.f) break;
#endif
    }
#pragma unroll
    for (int d = 0; d < 64; ++d) MIX[m * DM + 384 + h * 64 + d] = f2bf(o[d] * bf2f(ACT[m * ACTW + A_SZ + h * 64 + d]));
}

__global__ void __launch_bounds__(64) nv_mla(const bf16_t* ACT, const bf16_t* MQ, const bf16_t* MK, const bf16_t* MV, bf16_t* MIX) {
    const int tid = threadIdx.x, t = blockIdx.x * 64 + tid, h = blockIdx.y, b = blockIdx.z; const size_t m = (size_t)b * SEQ + t;
    float q[64], q2[32]; LOADQ64(q, MQ + m * 480 + h * 96);
    { const uint4* qp = (const uint4*)(MQ + m * 480 + h * 96 + 64);
#pragma unroll
      for (int c = 0; c < 4; ++c) { uint4 v = qp[c]; q2[8*c] = blo(v.x); q2[8*c+1] = bhi(v.x); q2[8*c+2] = blo(v.y); q2[8*c+3] = bhi(v.y); q2[8*c+4] = blo(v.z); q2[8*c+5] = bhi(v.z); q2[8*c+6] = blo(v.w); q2[8*c+7] = bhi(v.w); } }
    float o[64];
#pragma unroll
    for (int d = 0; d < 64; ++d) o[d] = 0.f;
    float mx = -3e38f, l = 0.f;
    for (int s = 0; s <= t; ++s) { const bf16_t* kp = MK + ((size_t)b * SEQ + s) * 480 + h * 96; float sc; DOT64(sc, q, kp);
        { const uint4* k2 = (const uint4*)(kp + 64);
#pragma unroll
          for (int c = 0; c < 4; ++c) { uint4 v = k2[c]; sc += q2[8*c]*blo(v.x) + q2[8*c+1]*bhi(v.x) + q2[8*c+2]*blo(v.y) + q2[8*c+3]*bhi(v.y) + q2[8*c+4]*blo(v.z) + q2[8*c+5]*bhi(v.z) + q2[8*c+6]*blo(v.w) + q2[8*c+7]*bhi(v.w); } }
        if (sc > mx) { float f = exp2f(mx - sc); l *= f;
#pragma unroll
            for (int d = 0; d < 64; ++d) o[d] *= f;
            mx = sc; }
        float p = exp2f(sc - mx); l += p; AXPY64(o, p, MV + ((size_t)b * SEQ + s) * 320 + h * 64); }
    const float il = 1.f / l;
#pragma unroll
    for (int d = 0; d < 64; ++d) MIX[m * DM + 704 + h * 64 + d] = f2bf(o[d] * il * bf2f(ACT[m * ACTW + A_MZ + h * 64 + d]));
}

extern "C" void kernel_launch(void* const* d_in, const int* in_sizes, int n_in, void* d_out, int out_size, void* d_ws, size_t ws_size, hipStream_t stream) {
    if (n_in != 19 || out_size != M * DM || ws_size < WS_END) { fprintf(stderr, "kernel_launch: unexpected shapes (n_in %d out %d ws %zu)\n", n_in, out_size, ws_size); return; }
    const float* x = (const float*)d_in[0]; const float* c = (const float*)d_in[1]; const int* pos = (const int*)d_in[2];
    const float* ada_w = (const float*)d_in[3]; const float* ada_b = (const float*)d_in[4]; const float* norm_g = (const float*)d_in[5];
    const float* w_in = (const float*)d_in[6]; const float* pos_k = (const float*)d_in[7]; const float* pos_v = (const float*)d_in[8];
    const float* ck_w1 = (const float*)d_in[9]; const float* ck_w2 = (const float*)d_in[10]; const float* cv_w1 = (const float*)d_in[11]; const float* cv_w2 = (const float*)d_in[12];
    const float* qn = (const float*)d_in[13]; const float* wuq = (const float*)d_in[14]; const float* kvn = (const float*)d_in[15]; const float* wukv = (const float*)d_in[16];
    const float* w_out = (const float*)d_in[17]; const float* fnorm = (const float*)d_in[18];
    char* ws = (char*)d_ws; float* out = (float*)d_out;
    float* mod = (float*)(ws + WS_MOD); float* cs64 = (float*)(ws + WS_CS64); float* cs32 = (float*)(ws + WS_CS32); float* posb = (float*)(ws + WS_POSB); float* HID = (float*)(ws + WS_HID);
    bf16_t* H = (bf16_t*)(ws + WS_H); bf16_t* MIX = (bf16_t*)(ws + WS_MIX); bf16_t* ACT = (bf16_t*)(ws + WS_ACT);
    bf16_t* MQ = (bf16_t*)(ws + WS_MQ); bf16_t* MK = (bf16_t*)(ws + WS_MK); bf16_t* MV = (bf16_t*)(ws + WS_MV); bf16_t* OC = (bf16_t*)(ws + WS_OC);
    bf16_t* KC = (bf16_t*)(ws + WS_KC); bf16_t* VC = (bf16_t*)(ws + WS_VC); u64* SEL = (u64*)(ws + WS_SEL);
    RopeInv inv{};
    for (int i = 0; i < 32; ++i) inv.i64[i] = (float)std::pow(10000.0, -(double)i / 32.0);
    for (int i = 0; i < 16; ++i) inv.i32[i] = (float)std::pow(10000.0, -(double)i / 16.0);

    nv_prep_mod<<<(DEPTH * NB * 3072 + 255) / 256, 256, 0, stream>>>(c, ada_w, ada_b, mod);
    nv_prep_rope<<<(M * 48 + 255) / 256, 256, 0, stream>>>(pos, inv, cs64, cs32);
    nv_prep_posb<<<2, 256, 0, stream>>>(pos_k, pos_v, ck_w1, cv_w1, posb);
    for (int l = 0; l < DEPTH; ++l) {
        const float* xin = (l == 0) ? x : out; const float* modl = mod + (size_t)l * NB * 3072;
        nv_norm_mod<<<M / 4, 256, 0, stream>>>(xin, norm_g + l * DM, modl, H);
        nv_gemm<0><<<dim3(ACTW / 64, M / 64), 256, 0, stream>>>(H, DM, w_in + (size_t)l * DM * D_IN, D_IN, DM, ACT, cs64, cs32, nullptr, nullptr, nullptr);
        nv_mla_up<<<M, 256, 0, stream>>>(ACT, qn + l * 192, wuq + (size_t)l * 192 * 480, kvn + l * 128, wukv + (size_t)l * 128 * 640, MQ, MK, MV);
        nv_mla_qrope<<<(M * 80 + 255) / 256, 256, 0, stream>>>(MQ, cs32);
        nv_cmp_hidden<<<dim3(NCMP, 16, 2), 128, 0, stream>>>(ACT, ck_w1 + (size_t)l * 2048 * 128, cv_w1 + (size_t)l * 2048 * 128, posb + l * 256, HID);
        nv_cmp_out<<<dim3(256, 16, 2), 64, 0, stream>>>(HID, ck_w2 + (size_t)l * 128 * 64, cv_w2 + (size_t)l * 128 * 64, KC, VC);
        nv_nsa_cmp<<<dim3(64, 16), 64, 0, stream>>>(ACT, KC, VC, OC, SEL);
        nv_nsa_sw<<<dim3(64, 6, 8), 64, 0, stream>>>(ACT, OC, SEL, MIX);
        nv_sb<<<dim3(64, 5, 8), 64, 0, stream>>>(ACT, MIX);
        nv_mla<<<dim3(64, 5, 8), 64, 0, stream>>>(ACT, MQ, MK, MV, MIX);
        nv_gemm<1><<<dim3(DM / 64, M / 64), 256, 0, stream>>>(MIX, DM, w_out + (size_t)l * DM * DM, DM, DM, nullptr, nullptr, nullptr, xin, out, modl + 2048);
    }
    nv_final_norm<<<M / 4, 256, 0, stream>>>(out, fnorm);
}
```

```cpp
#include <hip/hip_runtime.h>
#include <cstdio>
#include <cstdint>
#include <cmath>
#include <hip/hip_cooperative_groups.h>

typedef unsigned short bf16_t;
typedef unsigned long long u64;

constexpr int NB = 8, SEQ = 4096, DM = 1024, M = NB * SEQ, DEPTH = 2;
constexpr int D_IN = 3506;
constexpr int NCMP = 255;
constexpr int ACTW = 3584;
constexpr int A_NQ = 0, A_KC = 384, A_VC = 512, A_KS = 640, A_VS = 768, A_KW = 896, A_VW = 1024;
constexpr int A_NZ = 1152, A_SQ = 1536, A_SK = 1856, A_SV = 2176, A_SZ = 2496;
constexpr int A_MCQ = 2816, A_MCKV = 3008, A_MKR = 3136, A_GATE = 3168, A_MZ = 3200;
constexpr float LOG2E = 1.4426950408889634f;
constexpr float QS_NSA = 0.125f * LOG2E;
constexpr float QS_MLA = 0.10206207261596577f * LOG2E;

constexpr size_t MiB = 1u << 20;
constexpr size_t WS_CTL = 0;
constexpr size_t WS_MOD = 1 * MiB;
constexpr size_t WS_CS64 = 2 * MiB;
constexpr size_t WS_CS32 = 10 * MiB;
constexpr size_t WS_POSB = 14 * MiB;
constexpr size_t WS_POSBP = 14 * MiB + 512 * 1024;
constexpr size_t WS_HID = 15 * MiB;
constexpr size_t WS_WIN_T = 20 * MiB;
constexpr size_t WS_WOUT_T = 34 * MiB;
constexpr size_t WS_H = 64 * MiB;
constexpr size_t WS_MIX = 64 * MiB;
constexpr size_t WS_ACT = 128 * MiB;
constexpr size_t WS_MQ = 352 * MiB;
constexpr size_t WS_MK = 382 * MiB;
constexpr size_t WS_MV = 412 * MiB;
constexpr size_t WS_OC = 432 * MiB;
constexpr size_t WS_KC = 456 * MiB;
constexpr size_t WS_VC = 457 * MiB;
constexpr size_t WS_SEL = 458 * MiB;
constexpr size_t WS_END = 460 * MiB;

__device__ __forceinline__ float bf2f(bf16_t v) { return __uint_as_float(((unsigned)v) << 16); }
__device__ __forceinline__ bf16_t f2bf(float f) { unsigned u = __float_as_uint(f); return (bf16_t)((u + 0x7fffu + ((u >> 16) & 1u)) >> 16); }
__device__ __forceinline__ float blo(unsigned u) { return __uint_as_float(u << 16); }
__device__ __forceinline__ float bhi(unsigned u) { return __uint_as_float(u & 0xffff0000u); }
__device__ __forceinline__ float silu_f(float v) { return v / (1.f + __expf(-v)); }
__device__ __forceinline__ float sigm_f(float v) { return 1.f / (1.f + __expf(-v)); }

struct RopeInv { float i64[32]; float i32[16]; };


#define GAS __attribute__((address_space(1)))
#define LAS __attribute__((address_space(3)))
typedef unsigned v4u __attribute__((ext_vector_type(4)));
typedef float f32x4 __attribute__((ext_vector_type(4)));
#define RLX_AGENT __ATOMIC_RELAXED, __HIP_MEMORY_SCOPE_AGENT
#define LDS_WAIT() asm volatile("s_waitcnt lgkmcnt(0)" ::: "memory")
#define VM_WAIT() asm volatile("s_waitcnt vmcnt(0)" ::: "memory")
__device__ __forceinline__ unsigned pk2(float lo, float hi) { return (unsigned)f2bf(lo) | ((unsigned)f2bf(hi) << 16); }
namespace pg8 {
#define PG8_LAS __attribute__((address_space(3)))
typedef short bf16x8 __attribute__((ext_vector_type(8)));
typedef float f32x4 __attribute__((ext_vector_type(4)));
typedef unsigned u32x4 __attribute__((ext_vector_type(4)));
constexpr int BM = 256, BK = 64, HALF = 128, HTB = HALF * BK * 2  , STAGE_BYTES = 8 * HTB, NXCD = 8, WGM = 8;

__host__ __device__ __forceinline__ int lds_byte(int r, int c) { const int st = (r >> 4) * 2 + (c >> 5), rr = r & 15, cc = c & 31, ob = rr * 64 + cc * 2; return st * 1024 + (ob ^ (((ob >> 9) & 1) << 5)); }
__host__ __device__ __forceinline__ void stage_rc(int b, int& R, int& C) { const int st = b / 1024, sb = b % 1024, swz = sb ^ (((sb >> 9) & 1) << 5); R = (st >> 1) * 16 + swz / 64; C = (st & 1) * 32 + (swz % 64) / 2; }
__host__ __device__ __forceinline__ int perm32(int rho) { const int n = rho >> 4, i = rho & 15; return 8 * (i >> 2) + 4 * n + (i & 3); }

struct Unit { int pm, pn; };
struct Gemm { const bf16_t* A; const bf16_t* Bt; int lda, ldb, kstepA; size_t a_ts_hi, a_ts_lo; int M, N, K;
    __device__ __forceinline__ size_t a_off(int pm) const { return (size_t)(pm >> 1) * a_ts_hi + (size_t)(pm & 1) * a_ts_lo; } };
__host__ __device__ inline Gemm make_gemm(const bf16_t* A, int lda, const bf16_t* Bt, int ldb, int M, int N, int K) {
    Gemm g; g.A = A; g.Bt = Bt; g.lda = lda; g.ldb = ldb; g.kstepA = BK; g.a_ts_hi = (size_t)512 * lda * 2; g.a_ts_lo = (size_t)256 * lda * 2; g.M = M; g.N = N; g.K = K; return g; }

struct StaticOrder {
    int nM, nN, nwg, G, c;
    __host__ __device__ void init(int M, int N, int G_, int c_) { nM = M / BM; nN = N / BM; nwg = nM * nN; G = G_; c = c_; }
    __host__ __device__ bool next(int i, Unit& u) const {
        const long L = (long)i * G + c; if (L >= nwg) return false;
        int wgid = (int)L; { const int q = nwg / NXCD, r = nwg % NXCD, xcd = wgid % NXCD, off = wgid / NXCD; wgid = (xcd < r ? xcd * (q + 1) : r * (q + 1) + (xcd - r) * q) + off; }
        const int nig = WGM * nN, gid = wgid / nig, fm = gid * WGM, gsz = (nM - fm) < WGM ? (nM - fm) : WGM;
        u.pm = fm + ((wgid % nig) % gsz); u.pn = (wgid % nig) / gsz; return true;
    }
    __device__ __forceinline__ void a_ready(const Unit&) const {}
    __device__ __forceinline__ void done(const Unit&) const {}
};
__device__ __forceinline__ unsigned cvt_pk_bf16(float lo, float hi) { unsigned r; asm volatile("v_cvt_pk_bf16_f32 %0, %1, %2" : "=v"(r) : "v"(lo), "v"(hi)); return r; }

template <class Epi, class Sched, bool ALIGN_EPI = false, bool SP2 = false>
__device__ __forceinline__ void gemm_phase(PG8_LAS unsigned char* lds, const Gemm g, const Sched& S, const Epi& E) {
    int tid_ = threadIdx.x; asm volatile("" : "+v"(tid_));
    const int tid = tid_, wid = __builtin_amdgcn_readfirstlane(tid >> 6), lane = tid & 63, wr = wid >> 2, wc = wid & 3, fr = lane & 15, fq = lane >> 4;
    const int K = g.K, nt = K / BK;
    unsigned voffA[2], voffB[2];
#pragma unroll
    for (int i = 0; i < 2; ++i) { int R, C; stage_rc(tid * 16 + i * 8192, R, C); const int Rb = Epi::PERM ? ((R & ~31) + perm32(R & 31)) : R;
        voffA[i] = (unsigned)(R * g.lda + C) * 2u; voffB[i] = (unsigned)(Rb * g.ldb + C) * 2u; }
    const size_t kstepA = (size_t)g.kstepA * 2, kstepB = (size_t)(BK * 2);
    const size_t hstepA = (size_t)HALF * g.lda * 2, hstepB = (size_t)HALF * g.ldb * 2;
    const size_t tstepB = 2 * hstepB;
    const unsigned ldsw = (unsigned)wid * 1024u;
    const int aoff = lds_byte(wr * 64 + fr, fq * 8), boff = lds_byte(wc * 32 + fr, fq * 8);
#define PG8_SA(b, h) (((b) * 2 + (h)) * HTB)
#define PG8_SB(b, h) ((4 + (b) * 2 + (h)) * HTB)
#define PG8_STAGE(bufoff, gbase, voff) do { _Pragma("unroll") for (int _i = 0; _i < 2; ++_i) \
        __builtin_amdgcn_global_load_lds((const unsigned*)((const char*)(gbase) + (voff)[_i]), (PG8_LAS unsigned*)(lds + (bufoff) + ldsw + _i * 8192), 16, 0, 0); } while (0)
#define PG8_LDA(dst, b, h) do { _Pragma("unroll") for (int m = 0; m < 4; ++m) _Pragma("unroll") for (int k = 0; k < 2; ++k) dst[m][k] = *(const PG8_LAS bf16x8*)(lds + PG8_SA(b, h) + aoff + m * 2048 + k * 1024); } while (0)
#define PG8_LDB(dst, b, h) do { _Pragma("unroll") for (int n = 0; n < 2; ++n) _Pragma("unroll") for (int k = 0; k < 2; ++k) dst[n][k] = *(const PG8_LAS bf16x8*)(lds + PG8_SB(b, h) + boff + n * 2048 + k * 1024); } while (0)
#define PG8_MMA(ai, bj, At, Bt) do { __builtin_amdgcn_s_setprio(1); _Pragma("unroll") for (int m = 0; m < 4; ++m) _Pragma("unroll") for (int n = 0; n < 2; ++n) _Pragma("unroll") for (int k = 0; k < 2; ++k) \
        acc[ai][bj][m][n] = __builtin_amdgcn_mfma_f32_16x16x32_bf16(Bt[n][k], At[m][k], acc[ai][bj][m][n], 0, 0, 0); __builtin_amdgcn_s_setprio(0); } while (0)
#define PG8_WAIT_V(n) asm volatile("s_waitcnt vmcnt(" #n ")" ::: "memory")
#define PG8_WAIT_L(n) asm volatile("s_waitcnt lgkmcnt(" #n ")" ::: "memory")
#define PG8_BAR __builtin_amdgcn_s_barrier()
#define PG8_SCHED __builtin_amdgcn_sched_barrier(0)
    Unit cur, nxt; int ui = 0;
    if (!S.next(0, cur)) return;
    f32x4 acc[2][2][4][2];
#pragma unroll
    for (int a = 0; a < 2; ++a)
#pragma unroll
        for (int b = 0; b < 2; ++b)
#pragma unroll
            for (int m = 0; m < 4; ++m)
#pragma unroll
                for (int n = 0; n < 2; ++n) acc[a][b][m][n] = (f32x4){0.f, 0.f, 0.f, 0.f};
    bf16x8 At[4][2], B0[2][2], B1[2][2];
    const char* cA = (const char*)g.A + g.a_off(cur.pm); const char* cB = (const char*)g.Bt + (size_t)cur.pn * tstepB;
    S.a_ready(cur);
    if constexpr (SP2) {
        PG8_STAGE(PG8_SB(0, 0), cB, voffB); PG8_STAGE(PG8_SB(0, 1), cB + hstepB, voffB); PG8_STAGE(PG8_SA(0, 0), cA, voffA); PG8_STAGE(PG8_SA(0, 1), cA + hstepA, voffA);
        if (wr == 1) PG8_BAR;
        PG8_WAIT_V(2); PG8_BAR;
        PG8_STAGE(PG8_SB(1, 0), cB + kstepB, voffB); PG8_STAGE(PG8_SA(1, 0), cA + kstepA, voffA); PG8_STAGE(PG8_SB(1, 1), cB + hstepB + kstepB, voffB);
        PG8_WAIT_V(6); PG8_BAR;
    } else {
        PG8_STAGE(PG8_SB(0, 0), cB, voffB); PG8_STAGE(PG8_SA(0, 0), cA, voffA); PG8_STAGE(PG8_SB(0, 1), cB + hstepB, voffB); PG8_STAGE(PG8_SA(0, 1), cA + hstepA, voffA);
        if (wr == 1) PG8_BAR;
        PG8_WAIT_V(4); PG8_BAR;
        PG8_STAGE(PG8_SB(1, 0), cB + kstepB, voffB); PG8_STAGE(PG8_SA(1, 0), cA + kstepA, voffA); PG8_STAGE(PG8_SB(1, 1), cB + hstepB + kstepB, voffB);
        PG8_WAIT_V(6); PG8_BAR;
    }
    for (;;) {
        const bool has_next = S.next(ui + 1, nxt);
        const char* nA = has_next ? (const char*)g.A + g.a_off(nxt.pm) : cA; const char* nB = has_next ? (const char*)g.Bt + (size_t)nxt.pn * tstepB : cB;
        for (int t = 0; t < nt; t += 2) {
            const bool last = (t == nt - 2);
            const char* a1 = cA + (size_t)(t + 1) * kstepA;
            const char* a2 = last ? nA : cA + (size_t)(t + 2) * kstepA; const char* b2 = last ? nB : cB + (size_t)(t + 2) * kstepB;
            const char* a3 = a2 + kstepA; const char* b3 = b2 + kstepB;
            if (last && has_next) S.a_ready(nxt);
            if constexpr (SP2) {
            PG8_LDB(B0, 0, 0); PG8_LDB(B1, 0, 1); PG8_SCHED; PG8_LDA(At, 0, 0); PG8_STAGE(PG8_SA(1, 1), a1 + hstepA, voffA);
            PG8_WAIT_V(8); PG8_WAIT_L(0); PG8_BAR; PG8_MMA(0, 0, At, B0); PG8_MMA(0, 1, At, B1); PG8_BAR; PG8_SCHED;
            PG8_LDA(At, 0, 1); PG8_STAGE(PG8_SB(0, 0), b2, voffB); PG8_STAGE(PG8_SB(0, 1), b2 + hstepB, voffB); PG8_STAGE(PG8_SA(0, 0), a2, voffA);
            PG8_WAIT_V(8); PG8_WAIT_L(0); PG8_BAR; PG8_MMA(1, 0, At, B0); PG8_MMA(1, 1, At, B1); PG8_BAR; PG8_SCHED;
            PG8_LDB(B0, 1, 0); PG8_LDB(B1, 1, 1); PG8_SCHED; PG8_LDA(At, 1, 0); PG8_STAGE(PG8_SA(0, 1), a2 + hstepA, voffA);
            PG8_WAIT_V(8); PG8_WAIT_L(0); PG8_BAR; PG8_MMA(0, 0, At, B0); PG8_MMA(0, 1, At, B1); PG8_BAR; PG8_SCHED;
            PG8_LDA(At, 1, 1); PG8_STAGE(PG8_SB(1, 0), b3, voffB); PG8_STAGE(PG8_SB(1, 1), b3 + hstepB, voffB); PG8_STAGE(PG8_SA(1, 0), a3, voffA);
            PG8_WAIT_V(8); PG8_WAIT_L(0); PG8_BAR; PG8_MMA(1, 0, At, B0); PG8_MMA(1, 1, At, B1); PG8_BAR; PG8_SCHED;
            } else {
            PG8_LDB(B0, 0, 0); PG8_SCHED; PG8_LDA(At, 0, 0); PG8_STAGE(PG8_SA(1, 1), a1 + hstepA, voffA);
            PG8_WAIT_L(8); PG8_BAR; PG8_WAIT_L(0); PG8_MMA(0, 0, At, B0); PG8_BAR; PG8_SCHED;
            PG8_LDB(B1, 0, 1); PG8_STAGE(PG8_SB(0, 0), b2, voffB);
            PG8_BAR; PG8_WAIT_L(0); PG8_MMA(0, 1, At, B1); PG8_BAR;
            PG8_LDA(At, 0, 1); PG8_STAGE(PG8_SA(0, 0), a2, voffA);
            PG8_BAR; PG8_WAIT_L(0); PG8_MMA(1, 0, At, B0); PG8_BAR; PG8_SCHED;
            PG8_STAGE(PG8_SB(0, 1), b2 + hstepB, voffB);
            PG8_WAIT_V(6); PG8_BAR; PG8_MMA(1, 1, At, B1); PG8_BAR;
            PG8_LDB(B0, 1, 0); PG8_SCHED; PG8_LDA(At, 1, 0); PG8_STAGE(PG8_SA(0, 1), a2 + hstepA, voffA);
            PG8_WAIT_L(8); PG8_BAR; PG8_WAIT_L(0); PG8_MMA(0, 0, At, B0); PG8_BAR; PG8_SCHED;
            PG8_LDB(B1, 1, 1); PG8_STAGE(PG8_SB(1, 0), b3, voffB);
            PG8_BAR; PG8_WAIT_L(0); PG8_MMA(0, 1, At, B1); PG8_BAR;
            PG8_LDA(At, 1, 1); PG8_STAGE(PG8_SA(1, 0), a3, voffA);
            PG8_BAR; PG8_WAIT_L(0); PG8_MMA(1, 0, At, B0); PG8_BAR; PG8_SCHED;
            PG8_STAGE(PG8_SB(1, 1), b3 + hstepB, voffB);
            PG8_WAIT_V(6); PG8_BAR; PG8_MMA(1, 1, At, B1); PG8_BAR;
            }
        }
        if constexpr (ALIGN_EPI) { if (wr == 0) PG8_BAR; }
        if constexpr (!Epi::AFTER_DRAIN) { E(acc, cur, wr, wc, fr, fq); S.done(cur); }
        if (!has_next) break;
#pragma unroll
        for (int a = 0; a < 2; ++a)
#pragma unroll
            for (int b = 0; b < 2; ++b)
#pragma unroll
                for (int m = 0; m < 4; ++m)
#pragma unroll
                    for (int n = 0; n < 2; ++n) acc[a][b][m][n] = (f32x4){0.f, 0.f, 0.f, 0.f};
        cur = nxt; cA = nA; cB = nB; ++ui;
        if constexpr (ALIGN_EPI) { if (wr == 1) PG8_BAR; }
    }
    PG8_WAIT_V(0);
    if constexpr (!ALIGN_EPI) { if (wr == 0) PG8_BAR; }
    PG8_BAR;
    if constexpr (Epi::AFTER_DRAIN) { E.fused(acc, cur, wr, wc, fr, fq, lds, wid, lane); S.done(cur); }
#undef PG8_SA
#undef PG8_SB
#undef PG8_STAGE
#undef PG8_LDA
#undef PG8_LDB
#undef PG8_MMA
#undef PG8_WAIT_V
#undef PG8_WAIT_L
#undef PG8_BAR
#undef PG8_SCHED
}
}
#define XB_TMO      128
#define XB_XCNT(j)  (256  + 64 * (j))
#define XB_XSUB(j)  (1280 + 64 * (j))
#define XB_XGEN(j)  (2304 + 64 * (j))
#define XB_TOP      3328
#define XB_TOPGEN   3392
#define XCD_BAR_WORDS 3456
#define XB_SPIN_CAP (1u << 18)

__device__ __forceinline__ unsigned xb_ld(unsigned* p)              { return __hip_atomic_load(p, __ATOMIC_RELAXED, __HIP_MEMORY_SCOPE_AGENT); }
__device__ __forceinline__ unsigned xb_add(unsigned* p, unsigned v) { return __hip_atomic_fetch_add(p, v, __ATOMIC_RELAXED, __HIP_MEMORY_SCOPE_AGENT); }
__device__ __forceinline__ unsigned xb_xcc_id() { return (unsigned)__builtin_amdgcn_s_getreg((3 << 11) | 20) & 0xFu; }
#define XB_SPIN(cond, bar) do { unsigned _sp = 0; while (cond) { __builtin_amdgcn_s_sleep(1); \
    if ((++_sp & 255u) == 0u) { if (xb_ld(&(bar)[XB_TMO])) break; if (_sp > XB_SPIN_CAP) { atomicAdd(&(bar)[XB_TMO], 1u); break; } } } } while (0)

struct XcdBarrier {
    unsigned* bar; unsigned x;
    volatile LAS unsigned* st;
};

__device__ __forceinline__ XcdBarrier xcd_barrier_post(unsigned* bar, volatile LAS unsigned* st) {
    XcdBarrier b; b.bar = bar; b.x = xb_xcc_id(); b.st = st;
    if (threadIdx.x == 0) (void)xb_add(&bar[XB_XCNT(b.x)], 1u);
    return b;
}
__device__ __forceinline__ void xcd_barrier_complete(unsigned* bar, unsigned x, unsigned& nloc, unsigned& nx) {
    const unsigned G = gridDim.x * gridDim.y * gridDim.z;
    unsigned sum, cnt, mine, sp = 0u;
    for (;;) {
        sum = 0u; cnt = 0u; mine = 0u;
#pragma unroll
        for (unsigned j = 0; j < 16; ++j) { const unsigned c = xb_ld(&bar[XB_XCNT(j)]); sum += c; cnt += (c > 0u) ? 1u : 0u; mine = (j == x) ? c : mine; }
        if (sum == G) break;
        __builtin_amdgcn_s_sleep(1);
        if ((++sp & 255u) == 0u) { if (xb_ld(&bar[XB_TMO])) break; if (sp > XB_SPIN_CAP) { atomicAdd(&bar[XB_TMO], 1u); break; } }
    }
    nloc = mine > 0u ? mine : 1u; nx = cnt > 0u ? cnt : 1u;
}

__device__ __forceinline__ void xcd_barrier(const XcdBarrier& b) {
    asm volatile("s_waitcnt vmcnt(0)" ::: "memory");
    __syncthreads();
    if (threadIdx.x == 0) {
        unsigned* bar = b.bar;
        __builtin_amdgcn_s_waitcnt(0);
        unsigned nloc = b.st[0], nx = b.st[1];
        if (nloc == 0u) { xcd_barrier_complete(bar, b.x, nloc, nx); b.st[0] = nloc; b.st[1] = nx; }
        const unsigned old = xb_add(&bar[XB_XSUB(b.x)], 1u);
        const unsigned gen = old / nloc;
        if (old + 1u == (gen + 1u) * nloc) {
            __builtin_amdgcn_fence(__ATOMIC_RELEASE, "agent");
            asm volatile("s_waitcnt vmcnt(0)" ::: "memory");
            const unsigned og = xb_add(&bar[XB_TOP], 1u);
            const unsigned tg = og / nx;
            if (og + 1u == (tg + 1u) * nx) xb_add(&bar[XB_TOPGEN], 1u);
            else XB_SPIN(xb_ld(&bar[XB_TOPGEN]) == tg, bar);
            __builtin_amdgcn_fence(__ATOMIC_ACQUIRE, "agent");
            xb_add(&bar[XB_XGEN(b.x)], 1u);
            asm volatile("s_waitcnt vmcnt(0)" ::: "memory");
        } else {
            XB_SPIN(xb_ld(&bar[XB_XGEN(b.x)]) == gen, bar);
            __builtin_amdgcn_fence(__ATOMIC_ACQUIRE, "agent");
            asm volatile("s_waitcnt vmcnt(0)" ::: "memory");
        }
    }
    __syncthreads();
}
__global__ void nv_prep_mod(const float* c, const float* ada_w, const float* ada_b, float* mod) {
    int idx = blockIdx.x * 256 + threadIdx.x; if (idx >= DEPTH * NB * 3072) return;
    int col = idx % 3072, b = (idx / 3072) % NB, l = idx / (3072 * NB);
    float acc = ada_b[l * 3072 + col];
    for (int k = 0; k < DM; ++k) { float cv = c[b * DM + k]; acc += silu_f(cv) * ada_w[((size_t)l * DM + k) * 3072 + col]; }
    mod[idx] = acc;
}
__device__ __forceinline__ void sincos_rev(float ang, float& s, float& c) {
    double rev = (double)ang * 0.15915494309189535; rev -= rint(rev);
    float r = (float)rev; s = __builtin_amdgcn_sinf(r); c = __builtin_amdgcn_cosf(r);
}
__global__ void nv_prep_rope(const int* pos, RopeInv inv, float* cs64, float* cs32) {
    int idx = blockIdx.x * 256 + threadIdx.x; if (idx >= M * 48) return;
    int m = idx / 48, i = idx % 48; float p = (float)pos[m];
    if (i < 32) { float ang = p * inv.i64[i], s, c; sincos_rev(ang, s, c); cs64[((size_t)m * 32 + i) * 2] = c; cs64[((size_t)m * 32 + i) * 2 + 1] = s; }
    else { int j = i - 32; float ang = p * inv.i32[j], s, c; sincos_rev(ang, s, c); cs32[((size_t)m * 16 + j) * 2] = c; cs32[((size_t)m * 16 + j) * 2 + 1] = s; }
}
__global__ void nv_prep_posb(const float* pos_k, const float* pos_v, const float* ck_w1, const float* cv_w1, float* posb) {
    int idx = blockIdx.x * 256 + threadIdx.x; if (idx >= DEPTH * 2 * 128) return;
    int u = idx % 128, kv = (idx / 128) % 2, l = idx / 256;
    const float* pe = (kv ? pos_v : pos_k) + (size_t)l * 2048; const float* w1 = (kv ? cv_w1 : ck_w1) + (size_t)l * 2048 * 128;
    float acc = 0.f; for (int k = 0; k < 2048; ++k) acc += pe[k] * w1[(size_t)k * 128 + u];
    posb[idx] = acc;
}

__global__ void nv_norm_mod(const float* x, const float* g, const float* mod, bf16_t* H) {
    int row = blockIdx.x * 4 + (threadIdx.x >> 6), lane = threadIdx.x & 63; int b = row / SEQ;
    const float* xr = x + (size_t)row * DM; float v[16]; float ss = 0.f;
#pragma unroll
    for (int j = 0; j < 4; ++j) { float4 t = *(const float4*)(xr + j * 256 + lane * 4); v[4 * j] = t.x; v[4 * j + 1] = t.y; v[4 * j + 2] = t.z; v[4 * j + 3] = t.w; ss += t.x * t.x + t.y * t.y + t.z * t.z + t.w * t.w; }
#pragma unroll
    for (int o = 1; o < 64; o <<= 1) ss += __shfl_xor(ss, o);
    float r = rsqrtf(ss * (1.f / DM) + 1e-6f);
    const float* sh = mod + (size_t)b * 3072, * sc = sh + 1024;
#pragma unroll
    for (int j = 0; j < 4; ++j)
#pragma unroll
        for (int e = 0; e < 4; ++e) { int c = j * 256 + lane * 4 + e; float h = v[4 * j + e] * r * g[c] * (1.f + sc[c]) + sh[c]; H[(size_t)row * DM + c] = f2bf(h); }
}
__global__ void nv_final_norm(float* xo, const float* g) {
    int row = blockIdx.x * 4 + (threadIdx.x >> 6), lane = threadIdx.x & 63;
    float* xr = xo + (size_t)row * DM; float v[16]; float ss = 0.f;
#pragma unroll
    for (int j = 0; j < 4; ++j) { float4 t = *(const float4*)(xr + j * 256 + lane * 4); v[4 * j] = t.x; v[4 * j + 1] = t.y; v[4 * j + 2] = t.z; v[4 * j + 3] = t.w; ss += t.x * t.x + t.y * t.y + t.z * t.z + t.w * t.w; }
#pragma unroll
    for (int o = 1; o < 64; o <<= 1) ss += __shfl_xor(ss, o);
    float r = rsqrtf(ss * (1.f / DM) + 1e-6f);
#pragma unroll
    for (int j = 0; j < 4; ++j) { float4 t; int c = j * 256 + lane * 4; t.x = v[4 * j] * r * g[c]; t.y = v[4 * j + 1] * r * g[c + 1]; t.z = v[4 * j + 2] * r * g[c + 2]; t.w = v[4 * j + 3] * r * g[c + 3]; *(float4*)(xr + c) = t; }
}

__device__ __forceinline__ int inproj_src_col(int c) {
    if (c < 1152) return c;
    if (c < 1536) return 1170 + (c - 1152);
    if (c < 3168) return c + 18;
    if (c < 3200) return (c - 3168 < 18) ? 1152 + (c - 3168) : -1;
    if (c < 3520) return c - 14;
    return -1;
}
template <int MODE>
__global__ void __launch_bounds__(256) nv_gemm(const bf16_t* A, int lda, const float* W, int ldw, int K,
                                             bf16_t* ACT, const float* cs64, const float* cs32,
                                             const float* xin, float* xout, const float* gate) {
    __shared__ float As[16][65]; __shared__ float Bs[16][65]; __shared__ float Cs[64][65];
    const int tid = threadIdx.x, tx = tid & 15, ty = tid >> 4;
    const int row0 = blockIdx.y * 64, col0 = blockIdx.x * 64;
    const int bc = tid & 63; int sc = (MODE == 0) ? inproj_src_col(col0 + bc) : col0 + bc;
    float acc[4][4] = {};
    for (int k0 = 0; k0 < K; k0 += 16) {
#pragma unroll
        for (int i = 0; i < 4; ++i) { int e = tid + 256 * i; int r = e >> 4, kk = e & 15; As[kk][r] = bf2f(A[(size_t)(row0 + r) * lda + k0 + kk]); }
#pragma unroll
        for (int i = 0; i < 4; ++i) { int kk = (tid >> 6) + 4 * i; Bs[kk][bc] = (sc >= 0) ? W[(size_t)(k0 + kk) * ldw + sc] : 0.f; }
        __syncthreads();
#pragma unroll
        for (int kk = 0; kk < 16; ++kk) { float a[4], b[4];
#pragma unroll
            for (int i = 0; i < 4; ++i) { a[i] = As[kk][ty * 4 + i]; b[i] = Bs[kk][tx * 4 + i]; }
#pragma unroll
            for (int i = 0; i < 4; ++i)
#pragma unroll
                for (int j = 0; j < 4; ++j) acc[i][j] += a[i] * b[j]; }
        __syncthreads();
    }
#pragma unroll
    for (int i = 0; i < 4; ++i)
#pragma unroll
        for (int j = 0; j < 4; ++j) Cs[ty * 4 + i][tx * 4 + j] = acc[i][j];
    __syncthreads();
    for (int e = tid; e < 64 * 64; e += 256) {
        int r = e >> 6, cc = e & 63; int m = row0 + r, c = col0 + cc; float v = Cs[r][cc];
        if (MODE == 1) { int b = m / SEQ; xout[(size_t)m * DM + c] = xin[(size_t)m * DM + c] + gate[(size_t)b * 3072 + c] * v; continue; }
        float o;
        if (c < 384 || (c >= A_KC && c < A_VC) || (c >= A_KS && c < A_VS) || (c >= A_KW && c < A_VW)) {
            int i = cc & 31; float cs = cs64[((size_t)m * 32 + i) * 2], sn = cs64[((size_t)m * 32 + i) * 2 + 1];
            float x1 = Cs[r][i], x2 = Cs[r][i + 32];
            o = (cc < 32) ? (x1 * cs - x2 * sn) : (x2 * cs + x1 * sn);
            if (c < 384) o *= QS_NSA;
        } else if (c < A_NZ) o = v;
        else if (c < A_SQ) o = silu_f(v);
        else if (c < A_SK) o = v * 0.125f;
        else if (c < A_SZ) o = v;
        else if (c < A_MCQ) o = silu_f(v);
        else if (c < A_MKR) o = v;
        else if (c < A_GATE) { int i = cc & 15; float cs = cs32[((size_t)m * 16 + i) * 2], sn = cs32[((size_t)m * 16 + i) * 2 + 1];
            float x1 = Cs[r][i], x2 = Cs[r][i + 16]; o = (cc < 16) ? (x1 * cs - x2 * sn) : (x2 * cs + x1 * sn); }
        else if (c < A_MZ) o = (c - A_GATE < 18) ? sigm_f(v) : 0.f;
        else if (c < 3520) o = silu_f(v);
        else o = 0.f;
        ACT[(size_t)m * ACTW + c] = f2bf(o);
    }
}

__global__ void nv_mla_up(const bf16_t* ACT, const float* qn, const float* wuq, const float* kvn, const float* wukv, bf16_t* MQ, bf16_t* MK, bf16_t* MV) {
    __shared__ float xq[192]; __shared__ float xkv[128]; __shared__ float red[2];
    int m = blockIdx.x, tid = threadIdx.x; const bf16_t* a = ACT + (size_t)m * ACTW;
    if (tid < 192) xq[tid] = bf2f(a[A_MCQ + tid]); if (tid < 128) xkv[tid] = bf2f(a[A_MCKV + tid]);
    __syncthreads();
    if (tid == 0) { float s = 0; for (int k = 0; k < 192; ++k) s += xq[k] * xq[k]; red[0] = rsqrtf(s / 192.f + 1e-6f); s = 0; for (int k = 0; k < 128; ++k) s += xkv[k] * xkv[k]; red[1] = rsqrtf(s / 128.f + 1e-6f); }
    __syncthreads();
    float rq = red[0], rkv = red[1];
    if (tid < 192) xq[tid] = xq[tid] * rq * qn[tid]; if (tid < 128) xkv[tid] = xkv[tid] * rkv * kvn[tid];
    __syncthreads();
    for (int j = tid; j < 480; j += 256) { int h = j / 96, e = j % 96;
        if (e < 64) { float s = 0; for (int k = 0; k < 192; ++k) s += xq[k] * wuq[(size_t)k * 480 + j]; MQ[(size_t)m * 480 + j] = f2bf(s * QS_MLA); }
        else if (e < 80) { int i = e - 64; float s1 = 0, s2 = 0; for (int k = 0; k < 192; ++k) { s1 += xq[k] * wuq[(size_t)k * 480 + j]; s2 += xq[k] * wuq[(size_t)k * 480 + j + 16]; }
            MQ[(size_t)m * 480 + h * 96 + 64 + i] = f2bf(s1); MQ[(size_t)m * 480 + h * 96 + 80 + i] = f2bf(s2); } }
    for (int j = tid; j < 640; j += 256) { int h = j / 128, e = j % 128; float s = 0; for (int k = 0; k < 128; ++k) s += xkv[k] * wukv[(size_t)k * 640 + j];
        if (e < 64) MK[(size_t)m * 480 + h * 96 + e] = f2bf(s); else MV[(size_t)m * 320 + h * 64 + e - 64] = f2bf(s); }
    for (int j = tid; j < 160; j += 256) { int h = j / 32, i = j % 32; MK[(size_t)m * 480 + h * 96 + 64 + i] = a[A_MKR + i]; }
}
__global__ void nv_mla_qrope(bf16_t* MQ, const float* cs32) {
    int idx = blockIdx.x * 256 + threadIdx.x; if (idx >= M * 80) return;
    int m = idx / 80, r = idx % 80, h = r / 16, i = r % 16;
    bf16_t* p = MQ + (size_t)m * 480 + h * 96 + 64; float x1 = bf2f(p[i]), x2 = bf2f(p[i + 16]);
    float cs = cs32[((size_t)m * 16 + i) * 2], sn = cs32[((size_t)m * 16 + i) * 2 + 1];
    p[i] = f2bf((x1 * cs - x2 * sn) * QS_MLA); p[i + 16] = f2bf((x2 * cs + x1 * sn) * QS_MLA);
}

__global__ void nv_cmp_hidden(const bf16_t* ACT, const float* ck_w1, const float* cv_w1, const float* posb, float* HID) {
    int n = blockIdx.x, bg = blockIdx.y, kv = blockIdx.z, u = threadIdx.x; int b = bg >> 1, g = bg & 1;
    const float* w1 = kv ? cv_w1 : ck_w1; const int col = (kv ? A_VC : A_KC) + g * 64;
    __shared__ float tok[2048];
    for (int e = u; e < 2048; e += 128) { int j = e >> 6, d = e & 63; tok[e] = bf2f(ACT[(size_t)(b * SEQ + 16 * n + j) * ACTW + col + d]); }
    __syncthreads();
    float acc = posb[kv * 128 + u];
    for (int k = 0; k < 2048; ++k) acc += tok[k] * w1[(size_t)k * 128 + u];
    HID[(((size_t)kv * 16 + bg) * 256 + n) * 128 + u] = silu_f(acc);
}
__global__ void nv_cmp_out(const float* HID, const float* ck_w2, const float* cv_w2, bf16_t* KC, bf16_t* VC) {
    int n = blockIdx.x, bg = blockIdx.y, kv = blockIdx.z, d = threadIdx.x;
    bf16_t* out = (kv ? VC : KC) + ((size_t)bg * 256 + n) * 64 + d;
    if (n >= NCMP) { *out = 0; return; }
    const float* w2 = kv ? cv_w2 : ck_w2; const float* h = HID + (((size_t)kv * 16 + bg) * 256 + n) * 128;
    float acc = 0; for (int u = 0; u < 128; ++u) acc += h[u] * w2[u * 64 + d];
    *out = f2bf(acc);
}

#define DOT64(res, qarr, kptr) do { const uint4* _kp = (const uint4*)(kptr); float _s = 0.f; \
    _Pragma("unroll") for (int _c = 0; _c < 8; ++_c) { uint4 _v = _kp[_c]; \
      _s += qarr[8*_c+0]*blo(_v.x) + qarr[8*_c+1]*bhi(_v.x) + qarr[8*_c+2]*blo(_v.y) + qarr[8*_c+3]*bhi(_v.y) \
          + qarr[8*_c+4]*blo(_v.z) + qarr[8*_c+5]*bhi(_v.z) + qarr[8*_c+6]*blo(_v.w) + qarr[8*_c+7]*bhi(_v.w); } res = _s; } while (0)
#define AXPY64(oarr, p, vptr) do { const uint4* _vp = (const uint4*)(vptr); \
    _Pragma("unroll") for (int _c = 0; _c < 8; ++_c) { uint4 _v = _vp[_c]; \
      oarr[8*_c+0] += p*blo(_v.x); oarr[8*_c+1] += p*bhi(_v.x); oarr[8*_c+2] += p*blo(_v.y); oarr[8*_c+3] += p*bhi(_v.y); \
      oarr[8*_c+4] += p*blo(_v.z); oarr[8*_c+5] += p*bhi(_v.z); oarr[8*_c+6] += p*blo(_v.w); oarr[8*_c+7] += p*bhi(_v.w); } } while (0)
#define LOADQ64(qarr, qptr) do { const uint4* _qp = (const uint4*)(qptr); \
    _Pragma("unroll") for (int _c = 0; _c < 8; ++_c) { uint4 _v = _qp[_c]; \
      qarr[8*_c+0] = blo(_v.x); qarr[8*_c+1] = bhi(_v.x); qarr[8*_c+2] = blo(_v.y); qarr[8*_c+3] = bhi(_v.y); \
      qarr[8*_c+4] = blo(_v.z); qarr[8*_c+5] = bhi(_v.z); qarr[8*_c+6] = blo(_v.w); qarr[8*_c+7] = bhi(_v.w); } } while (0)

__global__ void __launch_bounds__(64) nv_nsa_cmp(const bf16_t* ACT, const bf16_t* KC, const bf16_t* VC, bf16_t* OC, u64* SEL) {
    __shared__ float imp[64][64];
    const int tid = threadIdx.x, t = blockIdx.x * 64 + tid, bg = blockIdx.y, b = bg >> 1, g = bg & 1; const size_t m = (size_t)b * SEQ + t;
    for (int j = 0; j < 64; ++j) imp[j][tid] = 0.f;
    const bf16_t* kc = KC + (size_t)bg * 256 * 64; const bf16_t* vc = VC + (size_t)bg * 256 * 64;
    const int nvalid = (t >= 31) ? min(NCMP, (t - 31) / 16 + 1) : 0;
    for (int hh = 0; hh < 3; ++hh) {
        const int h = g * 3 + hh; float q[64]; LOADQ64(q, ACT + m * ACTW + A_NQ + h * 64);
        float mx = -3e38f;
        for (int n = 0; n < nvalid; ++n) { float s; DOT64(s, q, kc + n * 64); mx = fmaxf(mx, s); }
        float l = 0.f;
        for (int n = 0; n < nvalid; ++n) { float s; DOT64(s, q, kc + n * 64); l += exp2f(s - mx); }
        float o[64];
#pragma unroll
        for (int d = 0; d < 64; ++d) o[d] = 0.f;
        const float il = (nvalid > 0) ? 1.f / l : 0.f;
        for (int n = 0; n < nvalid; ++n) { float s; DOT64(s, q, kc + n * 64); float p = exp2f(s - mx) * il; AXPY64(o, p, vc + n * 64);
            imp[n >> 2][tid] += p; if ((n & 3) == 3 && (n >> 2) + 1 < 64) imp[(n >> 2) + 1][tid] += p; }
        const float gc = bf2f(ACT[m * ACTW + A_GATE + h * 3 + 0]);
#pragma unroll
        for (int d = 0; d < 64; ++d) OC[m * 384 + h * 64 + d] = f2bf(o[d] * gc);
    }
    const int cur = t >> 6; u64 mask = 0ull;
    for (int r = 0; r < 16; ++r) { float best = -3e38f; int bi = 0;
        for (int j = 0; j < 64; ++j) { if ((mask >> j) & 1ull) continue; const bool valid = (j * 64 <= t); const bool forced = (j == 0) || (j == cur) || (j == cur - 1);
            float v = valid ? (forced ? 1e9f : imp[j][tid]) : -1e9f; if (v > best) { best = v; bi = j; } }
        mask |= (1ull << bi); }
    u64 vmask = (cur >= 63) ? ~0ull : ((1ull << (cur + 1)) - 1ull);
    SEL[(size_t)bg * SEQ + t] = mask & vmask;
}

__global__ void __launch_bounds__(64) nv_nsa_sw(const bf16_t* ACT, const bf16_t* OC, const u64* SEL, bf16_t* MIX) {
    const int tid = threadIdx.x, t = blockIdx.x * 64 + tid, h = blockIdx.y, b = blockIdx.z, g = h / 3; const size_t m = (size_t)b * SEQ + t;
    float q[64]; LOADQ64(q, ACT + m * ACTW + A_NQ + h * 64);
    float out[64];
#pragma unroll
    for (int d = 0; d < 64; ++d) out[d] = bf2f(OC[m * 384 + h * 64 + d]);
    const u64 sel = SEL[((size_t)(b * 2 + g)) * SEQ + t];
    const bf16_t* base = ACT + (size_t)b * SEQ * ACTW;
    {
        float o[64];
#pragma unroll
        for (int d = 0; d < 64; ++d) o[d] = 0.f;
        float mx = -3e38f, l = 0.f;
        for (int j = 0; j < 64; ++j) { if (!((sel >> j) & 1ull)) continue;
            const int s1 = min(64 * j + 63, t);
            for (int s = 64 * j; s <= s1; ++s) { float sc; DOT64(sc, q, base + (size_t)s * ACTW + A_KS + g * 64);
                if (sc > mx) { float f = exp2f(mx - sc); l *= f;
#pragma unroll
                    for (int d = 0; d < 64; ++d) o[d] *= f;
                    mx = sc; }
                float p = exp2f(sc - mx); l += p; AXPY64(o, p, base + (size_t)s * ACTW + A_VS + g * 64); } }
        const float gs = bf2f(ACT[m * ACTW + A_GATE + h * 3 + 1]) / l;
#pragma unroll
        for (int d = 0; d < 64; ++d) out[d] += gs * o[d];
    }
    {
        float o[64];
#pragma unroll
        for (int d = 0; d < 64; ++d) o[d] = 0.f;
        float mx = -3e38f, l = 0.f;
        for (int s = max(0, t - 511); s <= t; ++s) { float sc; DOT64(sc, q, base + (size_t)s * ACTW + A_KW + g * 64);
            if (sc > mx) { float f = exp2f(mx - sc); l *= f;
#pragma unroll
                for (int d = 0; d < 64; ++d) o[d] *= f;
                mx = sc; }
            float p = exp2f(sc - mx); l += p; AXPY64(o, p, base + (size_t)s * ACTW + A_VW + g * 64); }
        const float gw = bf2f(ACT[m * ACTW + A_GATE + h * 3 + 2]) / l;
#pragma unroll
        for (int d = 0; d < 64; ++d) out[d] += gw * o[d];
    }
#pragma unroll
    for (int d = 0; d < 64; ++d) MIX[m * DM + h * 64 + d] = f2bf(out[d] * bf2f(ACT[m * ACTW + A_NZ + h * 64 + d]));
}

#ifndef SB_EARLY_EXIT
#define SB_EARLY_EXIT 0
#endif
__global__ void __launch_bounds__(64) nv_sb(const bf16_t* ACT, bf16_t* MIX) {
    const int tid = threadIdx.x, t = blockIdx.x * 64 + tid, h = blockIdx.y, b = blockIdx.z; const size_t m = (size_t)b * SEQ + t;
    float q[64]; LOADQ64(q, ACT + m * ACTW + A_SQ + h * 64);
    float o[64];
#pragma unroll
    for (int d = 0; d < 64; ++d) o[d] = 0.f;
    const bf16_t* base = ACT + (size_t)b * SEQ * ACTW; float R = 0.f;
    for (int s = t - 1; s >= 0; --s) { float z; DOT64(z, q, base + (size_t)s * ACTW + A_SK + h * 64);
        const float sp = fmaxf(z, 0.f) + log1pf(__expf(-fabsf(z)));
        const float a = __expf(z - sp - R); AXPY64(o, a, base + (size_t)s * ACTW + A_SV + h * 64); R += sp;
#if SB_EARLY_EXIT
        if (R >= 104.f) break;
#endif
    }
#pragma unroll
    for (int d = 0; d < 64; ++d) MIX[m * DM + 384 + h * 64 + d] = f2bf(o[d] * bf2f(ACT[m * ACTW + A_SZ + h * 64 + d]));
}

__global__ void __launch_bounds__(64) nv_mla(const bf16_t* ACT, const bf16_t* MQ, const bf16_t* MK, const bf16_t* MV, bf16_t* MIX) {
    const int tid = threadIdx.x, t = blockIdx.x * 64 + tid, h = blockIdx.y, b = blockIdx.z; const size_t m = (size_t)b * SEQ + t;
    float q[64], q2[32]; LOADQ64(q, MQ + m * 480 + h * 96);
    { const uint4* qp = (const uint4*)(MQ + m * 480 + h * 96 + 64);
#pragma unroll
      for (int c = 0; c < 4; ++c) { uint4 v = qp[c]; q2[8*c] = blo(v.x); q2[8*c+1] = bhi(v.x); q2[8*c+2] = blo(v.y); q2[8*c+3] = bhi(v.y); q2[8*c+4] = blo(v.z); q2[8*c+5] = bhi(v.z); q2[8*c+6] = blo(v.w); q2[8*c+7] = bhi(v.w); } }
    float o[64];
#pragma unroll
    for (int d = 0; d < 64; ++d) o[d] = 0.f;
    float mx = -3e38f, l = 0.f;
    for (int s = 0; s <= t; ++s) { const bf16_t* kp = MK + ((size_t)b * SEQ + s) * 480 + h * 96; float sc; DOT64(sc, q, kp);
        { const uint4* k2 = (const uint4*)(kp + 64);
#pragma unroll
          for (int c = 0; c < 4; ++c) { uint4 v = k2[c]; sc += q2[8*c]*blo(v.x) + q2[8*c+1]*bhi(v.x) + q2[8*c+2]*blo(v.y) + q2[8*c+3]*bhi(v.y) + q2[8*c+4]*blo(v.z) + q2[8*c+5]*bhi(v.z) + q2[8*c+6]*blo(v.w) + q2[8*c+7]*bhi(v.w); } }
        if (sc > mx) { float f = exp2f(mx - sc); l *= f;
#pragma unroll
            for (int d = 0; d < 64; ++d) o[d] *= f;
            mx = sc; }
        float p = exp2f(sc - mx); l += p; AXPY64(o, p, MV + ((size_t)b * SEQ + s) * 320 + h * 64); }
    const float il = 1.f / l;
#pragma unroll
    for (int d = 0; d < 64; ++d) MIX[m * DM + 704 + h * 64 + d] = f2bf(o[d] * il * bf2f(ACT[m * ACTW + A_MZ + h * 64 + d]));
}

constexpr int NWAVES = 8;
constexpr int RING_BYTES = 131072;
constexpr int LDSCTL_OFF = RING_BYTES, MISC_OFF = LDSCTL_OFF + 320;
constexpr int LDS_BYTES = 147456;
constexpr int CW_BAR = 4096;
constexpr size_t CTL_ZERO_BYTES = 256 * 1024;

constexpr int PH_PRO = 0, PH_L0 = 1, PH_PER_LAYER = 6, PH_FINAL = 1 + 2 * PH_PER_LAYER, PH_COUNT = PH_FINAL + 1;
constexpr int PK_NORM = 0, PK_INPROJ = 1, PK_P3 = 2, PK_P4 = 3, PK_ATTN = 4, PK_OUTPROJ = 5;

struct Args { const void* in[19]; float* out; unsigned char* ws; RopeInv inv; int ph_lo, ph_hi; };

__device__ __forceinline__ float wave_sum(float v) {
#pragma unroll
    for (int o = 1; o < 64; o <<= 1) v += __shfl_xor(v, o);
    return v;
}

__device__ __forceinline__ int rope_head_base(int pn, int hh) {
    if (pn == 0) return 64 * hh;
    if (pn == 1) return (hh < 2) ? 256 + 64 * hh : 384 + 64 * (hh - 2);
    return (hh < 2) ? 640 + 64 * hh : 896 + 64 * (hh - 2);
}
__device__ __forceinline__ void gen_group(int L, int& base, int& op) {
    if (L < 4) { base = 512 + 32 * L; op = 0; }
    else if (L < 8) { base = 768 + 32 * (L - 4); op = 0; }
    else if (L < 12) { base = 1024 + 32 * (L - 8); op = 0; }
    else if (L < 22) { base = 1536 + 32 * (L - 12); op = 2; }
    else if (L < 42) { base = 1856 + 32 * (L - 22); op = 0; }
    else if (L < 48) { base = 2816 + 32 * (L - 42); op = 0; }
    else if (L < 60) { base = 1152 + 32 * (L - 48); op = 1; }
    else if (L < 70) { base = 2496 + 32 * (L - 60); op = 1; }
    else { base = 3200 + 32 * (L - 70); op = 1; }
}
__device__ __forceinline__ int phys_to_act(int pn, int p) {
    if (pn < 3) { const int f = p >> 7, hh = (p >> 5) & 3, i = p & 31; return rope_head_base(pn, hh) + 32 * f + i; }
    if (pn < 13) { int base, op; gen_group((pn - 3) * 8 + (p >> 5), base, op); return base + (p & 31); }
    const int bj = p >> 7, q = p & 127;
    if (q < 64) return A_MCKV + 64 * bj + q;
    if (q < 80) return A_MKR + 16 * bj + (q - 64);
    if (q < 96) { const int gi = 16 * bj + (q - 80); return gi < 18 ? A_GATE + gi : -1; }
    return -1;
}

struct EpiInProj {
    static constexpr bool PERM = true, AFTER_DRAIN = false;
    bf16_t* ACT; const float* cs64; const float* cs32;
    __device__ __forceinline__ void operator()(const pg8::f32x4 (&acc)[2][2][4][2], const pg8::Unit& u, int wr, int wc, int fr, int fq) const {
        using pg8::cvt_pk_bf16; typedef pg8::u32x4 u32x4;
        const int pn = u.pn; const int row0 = u.pm * 256 + wr * 64 + fr;
        if (pn < 3) {
            const int hb = rope_head_base(pn, wc) + 8 * fq; const float sc = (pn == 0 || (pn == 1 && wc < 2)) ? QS_NSA : 1.f;
#pragma unroll
            for (int ai = 0; ai < 2; ++ai)
#pragma unroll
                for (int m = 0; m < 4; ++m) {
                    const int row = row0 + ai * 128 + m * 16;
                    const f32x4* cp = (const f32x4*)(cs64 + ((size_t)row * 32 + 8 * fq) * 2);
                    const f32x4 t0 = cp[0], t1 = cp[1], t2 = cp[2], t3 = cp[3];
                    const f32x4 a0 = acc[ai][0][m][0], a1 = acc[ai][0][m][1], b0 = acc[ai][1][m][0], b1 = acc[ai][1][m][1];
                    float o1[8], o2[8];
                    o1[0] = a0[0] * t0[0] - b0[0] * t0[1]; o2[0] = b0[0] * t0[0] + a0[0] * t0[1];
                    o1[1] = a0[1] * t0[2] - b0[1] * t0[3]; o2[1] = b0[1] * t0[2] + a0[1] * t0[3];
                    o1[2] = a0[2] * t1[0] - b0[2] * t1[1]; o2[2] = b0[2] * t1[0] + a0[2] * t1[1];
                    o1[3] = a0[3] * t1[2] - b0[3] * t1[3]; o2[3] = b0[3] * t1[2] + a0[3] * t1[3];
                    o1[4] = a1[0] * t2[0] - b1[0] * t2[1]; o2[4] = b1[0] * t2[0] + a1[0] * t2[1];
                    o1[5] = a1[1] * t2[2] - b1[1] * t2[3]; o2[5] = b1[1] * t2[2] + a1[1] * t2[3];
                    o1[6] = a1[2] * t3[0] - b1[2] * t3[1]; o2[6] = b1[2] * t3[0] + a1[2] * t3[1];
                    o1[7] = a1[3] * t3[2] - b1[3] * t3[3]; o2[7] = b1[3] * t3[2] + a1[3] * t3[3];
                    u32x4 w1, w2;
                    w1.x = cvt_pk_bf16(o1[0] * sc, o1[1] * sc); w1.y = cvt_pk_bf16(o1[2] * sc, o1[3] * sc); w1.z = cvt_pk_bf16(o1[4] * sc, o1[5] * sc); w1.w = cvt_pk_bf16(o1[6] * sc, o1[7] * sc);
                    w2.x = cvt_pk_bf16(o2[0] * sc, o2[1] * sc); w2.y = cvt_pk_bf16(o2[2] * sc, o2[3] * sc); w2.z = cvt_pk_bf16(o2[4] * sc, o2[5] * sc); w2.w = cvt_pk_bf16(o2[6] * sc, o2[7] * sc);
                    bf16_t* rp = ACT + (size_t)row * ACTW + hb;
                    *(u32x4*)rp = w1; *(u32x4*)(rp + 32) = w2;
                }
        } else if (pn < 13) {
#pragma unroll
            for (int bj = 0; bj < 2; ++bj) {
                int base, op; gen_group((pn - 3) * 8 + bj * 4 + wc, base, op);
#pragma unroll
                for (int ai = 0; ai < 2; ++ai)
#pragma unroll
                    for (int m = 0; m < 4; ++m) {
                        const int row = row0 + ai * 128 + m * 16;
                        f32x4 v0 = acc[ai][bj][m][0], v1 = acc[ai][bj][m][1];
                        if (op == 1) {
#pragma unroll
                            for (int e = 0; e < 4; ++e) { v0[e] = silu_f(v0[e]); v1[e] = silu_f(v1[e]); }
                        } else if (op == 2) { v0 = v0 * 0.125f; v1 = v1 * 0.125f; }
                        u32x4 w; w.x = cvt_pk_bf16(v0[0], v0[1]); w.y = cvt_pk_bf16(v0[2], v0[3]); w.z = cvt_pk_bf16(v1[0], v1[1]); w.w = cvt_pk_bf16(v1[2], v1[3]);
                        *(u32x4*)(ACT + (size_t)row * ACTW + base + 8 * fq) = w;
                    }
            }
        } else {
            if (wc < 2) {
#pragma unroll
                for (int bj = 0; bj < 2; ++bj)
#pragma unroll
                    for (int ai = 0; ai < 2; ++ai)
#pragma unroll
                        for (int m = 0; m < 4; ++m) {
                            const int row = row0 + ai * 128 + m * 16;
                            const f32x4 v0 = acc[ai][bj][m][0], v1 = acc[ai][bj][m][1];
                            u32x4 w; w.x = cvt_pk_bf16(v0[0], v0[1]); w.y = cvt_pk_bf16(v0[2], v0[3]); w.z = cvt_pk_bf16(v1[0], v1[1]); w.w = cvt_pk_bf16(v1[2], v1[3]);
                            *(u32x4*)(ACT + (size_t)row * ACTW + A_MCKV + 64 * bj + 32 * wc + 8 * fq) = w;
                        }
            } else if (wc == 2) {
#pragma unroll
                for (int ai = 0; ai < 2; ++ai)
#pragma unroll
                    for (int m = 0; m < 4; ++m) {
                        const int row = row0 + ai * 128 + m * 16;
                        const f32x4 a0 = acc[ai][0][m][0], a1 = acc[ai][0][m][1], b0 = acc[ai][1][m][0], b1 = acc[ai][1][m][1];
                        if (fq < 2) {
                            const f32x4* cp = (const f32x4*)(cs32 + ((size_t)row * 16 + 8 * fq) * 2);
                            const f32x4 t0 = cp[0], t1 = cp[1], t2 = cp[2], t3 = cp[3];
                            float o1[8], o2[8];
                            o1[0] = a0[0] * t0[0] - b0[0] * t0[1]; o2[0] = b0[0] * t0[0] + a0[0] * t0[1];
                            o1[1] = a0[1] * t0[2] - b0[1] * t0[3]; o2[1] = b0[1] * t0[2] + a0[1] * t0[3];
                            o1[2] = a0[2] * t1[0] - b0[2] * t1[1]; o2[2] = b0[2] * t1[0] + a0[2] * t1[1];
                            o1[3] = a0[3] * t1[2] - b0[3] * t1[3]; o2[3] = b0[3] * t1[2] + a0[3] * t1[3];
                            o1[4] = a1[0] * t2[0] - b1[0] * t2[1]; o2[4] = b1[0] * t2[0] + a1[0] * t2[1];
                            o1[5] = a1[1] * t2[2] - b1[1] * t2[3]; o2[5] = b1[1] * t2[2] + a1[1] * t2[3];
                            o1[6] = a1[2] * t3[0] - b1[2] * t3[1]; o2[6] = b1[2] * t3[0] + a1[2] * t3[1];
                            o1[7] = a1[3] * t3[2] - b1[3] * t3[3]; o2[7] = b1[3] * t3[2] + a1[3] * t3[3];
                            u32x4 w1, w2;
                            w1.x = cvt_pk_bf16(o1[0], o1[1]); w1.y = cvt_pk_bf16(o1[2], o1[3]); w1.z = cvt_pk_bf16(o1[4], o1[5]); w1.w = cvt_pk_bf16(o1[6], o1[7]);
                            w2.x = cvt_pk_bf16(o2[0], o2[1]); w2.y = cvt_pk_bf16(o2[2], o2[3]); w2.z = cvt_pk_bf16(o2[4], o2[5]); w2.w = cvt_pk_bf16(o2[6], o2[7]);
                            bf16_t* rp = ACT + (size_t)row * ACTW + A_MKR + 8 * fq;
                            *(u32x4*)rp = w1; *(u32x4*)(rp + 16) = w2;
                        } else {
                            const int g0 = 8 * (fq - 2);
                            float ga[8], gb[8];
#pragma unroll
                            for (int e = 0; e < 4; ++e) { ga[e] = a0[e]; ga[4 + e] = a1[e]; gb[e] = b0[e]; gb[4 + e] = b1[e]; }
#pragma unroll
                            for (int e = 0; e < 8; ++e) { ga[e] = (g0 + e < 18) ? sigm_f(ga[e]) : 0.f; gb[e] = (16 + g0 + e < 18) ? sigm_f(gb[e]) : 0.f; }
                            u32x4 w1, w2;
                            w1.x = cvt_pk_bf16(ga[0], ga[1]); w1.y = cvt_pk_bf16(ga[2], ga[3]); w1.z = cvt_pk_bf16(ga[4], ga[5]); w1.w = cvt_pk_bf16(ga[6], ga[7]);
                            w2.x = cvt_pk_bf16(gb[0], gb[1]); w2.y = cvt_pk_bf16(gb[2], gb[3]); w2.z = cvt_pk_bf16(gb[4], gb[5]); w2.w = cvt_pk_bf16(gb[6], gb[7]);
                            bf16_t* rp = ACT + (size_t)row * ACTW + A_GATE + g0;
                            *(u32x4*)rp = w1; *(u32x4*)(rp + 16) = w2;
                        }
                    }
            }
        }
    }
};

struct EpiOutProj {
    static constexpr bool PERM = false, AFTER_DRAIN = false;
    const float* xin; float* xout; const float* gate;
    __device__ __forceinline__ void operator()(const pg8::f32x4 (&acc)[2][2][4][2], const pg8::Unit& u, int wr, int wc, int fr, int fq) const {
        const int col0 = u.pn * 256 + wc * 32 + 4 * fq;
#pragma unroll
        for (int ai = 0; ai < 2; ++ai)
#pragma unroll
            for (int m = 0; m < 4; ++m) {
                const int row = u.pm * 256 + ai * 128 + wr * 64 + m * 16 + fr; const int b = row / SEQ;
                const size_t off = (size_t)row * DM + col0; const float* gp = gate + (size_t)b * 3072 + col0;
#pragma unroll
                for (int bj = 0; bj < 2; ++bj)
#pragma unroll
                    for (int n = 0; n < 2; ++n) {
                        const f32x4 g4 = *(const f32x4*)(gp + bj * 128 + n * 16); const f32x4 xi = *(const f32x4*)(xin + off + bj * 128 + n * 16);
                        *(f32x4*)(xout + off + bj * 128 + n * 16) = xi + g4 * acc[ai][bj][m][n];
                    }
            }
    }
};

__device__ __forceinline__ void tr_item(const float* W, int ldw, int srccol, bf16_t* WT, int K, int wt_row0, int k0, LAS float* scr, int lane) {
#pragma unroll 8
    for (int i = 0; i < 32; ++i) { const int kk = 2 * i + (lane >> 5); scr[kk * 33 + (lane & 31)] = (srccol >= 0) ? W[(size_t)(k0 + kk) * ldw + srccol] : 0.f; }
    LDS_WAIT(); asm volatile("" ::: "memory");
    const int c = lane & 7;
#pragma unroll
    for (int j = 0; j < 4; ++j) { const int n = (lane >> 3) + 8 * j; const LAS float* s = scr + (8 * c) * 33 + n;
        v4u o; o.x = pk2(s[0 * 33], s[1 * 33]); o.y = pk2(s[2 * 33], s[3 * 33]); o.z = pk2(s[4 * 33], s[5 * 33]); o.w = pk2(s[6 * 33], s[7 * 33]);
        *(v4u*)(WT + (size_t)(wt_row0 + n) * K + k0 + 8 * c) = o; }
    LDS_WAIT(); asm volatile("" ::: "memory");
}

struct MK {
    LAS unsigned char* lds; int tid, lane, wave, G, bid; float* out; unsigned char* ws;
};
#define ARGF(A, i) ((const float*)(A).in[i])

__device__ __forceinline__ void ph_prologue(MK& F, const Args& A) {
    const RopeInv& inv = A.inv;
    float* mod = (float*)(F.ws + WS_MOD);
    {
        LAS float* red = (LAS float*)F.lds;
        for (int item = F.bid; item < DEPTH * 48; item += F.G) {
            const int l = item / 48, col = (item % 48) * 64 + F.lane;
            float acc[NB];
#pragma unroll
            for (int b = 0; b < NB; ++b) acc[b] = 0.f;
            const float* cvec = ARGF(A, 1); const float* adab = ARGF(A, 4);
            const float* wp = ARGF(A, 3) + ((size_t)l * DM + F.wave * 128) * 3072 + col;
            for (int k = 0; k < 128; ++k) { const float w = wp[(size_t)k * 3072];
#pragma unroll
                for (int b = 0; b < NB; ++b) { const float cv = cvec[b * DM + F.wave * 128 + k]; acc[b] += silu_f(cv) * w; } }
#pragma unroll
            for (int b = 0; b < NB; ++b) red[(F.wave * NB + b) * 64 + F.lane] = acc[b];
            __syncthreads();
            { const int b = F.tid >> 6; float s = adab[l * 3072 + col];
#pragma unroll
              for (int w = 0; w < 8; ++w) s += red[(w * NB + b) * 64 + F.lane];
              mod[((size_t)l * NB + b) * 3072 + col] = s; }
            __syncthreads();
        }
    }
    const int gw = F.bid * NWAVES + F.wave, NGW = F.G * NWAVES;
    {
        LAS float* scr = (LAS float*)(F.lds + F.wave * 16384);
        bf16_t* WIN_T = (bf16_t*)(F.ws + WS_WIN_T); bf16_t* WOUT_T = (bf16_t*)(F.ws + WS_WOUT_T);
        constexpr int I_IN = 16 * 112, I_OUT = 16 * 32, NIT = DEPTH * (I_IN + I_OUT);
        for (int it = gw; it < NIT; it += NGW) {
            int r = it; const int l = r / (I_IN + I_OUT); r -= l * (I_IN + I_OUT);
            if (r < I_IN) { const int kb = r / 112, nb = r % 112; const int prow = nb * 32 + (F.lane & 31); const int act = phys_to_act(prow >> 8, prow & 255); const int src = (act < 0) ? -1 : inproj_src_col(act);
                tr_item(ARGF(A, 6) + (size_t)l * DM * D_IN, D_IN, src, WIN_T + (size_t)l * 3584 * DM, DM, nb * 32, kb * 64, scr, F.lane); }
            else { r -= I_IN; const int kb = r / 32, nb = r % 32;
                tr_item(ARGF(A, 17) + (size_t)l * DM * DM, DM, nb * 32 + (F.lane & 31), WOUT_T + (size_t)l * DM * DM, DM, nb * 32, kb * 64, scr, F.lane); }
        }
    }
    {
        float* cs64 = (float*)(F.ws + WS_CS64); float* cs32 = (float*)(F.ws + WS_CS32);
        for (int idx = F.bid * 512 + F.tid; idx < M * 48; idx += F.G * 512) {
            const int m = idx / 48, i = idx % 48; const float p = (float)((const int*)A.in[2])[m]; float s, c;
            if (i < 32) { sincos_rev(p * inv.i64[i], s, c); *(float2*)(cs64 + ((size_t)m * 32 + i) * 2) = make_float2(c, s); }
            else { const int j = i - 32; sincos_rev(p * inv.i32[j], s, c); *(float2*)(cs32 + ((size_t)m * 16 + j) * 2) = make_float2(c, s); }
        }
    }
}

__device__ __forceinline__ void ph_norm_mod(MK& F, const Args& A, const float* xin, int l) {
    const float* g = ARGF(A, 5) + l * DM; const float* mod = (const float*)(F.ws + WS_MOD) + (size_t)l * NB * 3072; bf16_t* H = (bf16_t*)(F.ws + WS_H);
    const int gw = F.bid * NWAVES + F.wave, NGW = F.G * NWAVES;
    for (int row = gw; row < M; row += NGW) {
        const int b = row / SEQ; const f32x4* xr = (const f32x4*)(xin + (size_t)row * DM) + F.lane; f32x4 v[4]; float ss = 0.f;
#pragma unroll
        for (int j = 0; j < 4; ++j) { v[j] = xr[64 * j]; ss += (v[j].x * v[j].x + v[j].y * v[j].y) + (v[j].z * v[j].z + v[j].w * v[j].w); }
        const float r = rsqrtf(wave_sum(ss) * (1.f / DM) + 1e-6f);
        const float* sh = mod + (size_t)b * 3072; const float* sc = sh + 1024;
#pragma unroll
        for (int j = 0; j < 4; ++j) { const int c = 256 * j + 4 * F.lane; const f32x4 g4 = *(const f32x4*)(g + c), s4 = *(const f32x4*)(sc + c), h4 = *(const f32x4*)(sh + c);
            const f32x4 h = v[j] * r * g4 * (s4 + 1.f) + h4;
            uint2 o; o.x = pk2(h.x, h.y); o.y = pk2(h.z, h.w); *(uint2*)(H + (size_t)row * DM + c) = o; }
    }
}
__device__ __forceinline__ void ph_final_norm(MK& F, const Args& A) {
    const float* fnorm = ARGF(A, 18);
    const int gw = F.bid * NWAVES + F.wave, NGW = F.G * NWAVES;
    for (int row = gw; row < M; row += NGW) {
        f32x4* xr = (f32x4*)(F.out + (size_t)row * DM) + F.lane; f32x4 v[4]; float ss = 0.f;
#pragma unroll
        for (int j = 0; j < 4; ++j) { v[j] = xr[64 * j]; ss += (v[j].x * v[j].x + v[j].y * v[j].y) + (v[j].z * v[j].z + v[j].w * v[j].w); }
        const float r = rsqrtf(wave_sum(ss) * (1.f / DM) + 1e-6f);
#pragma unroll
        for (int j = 0; j < 4; ++j) { const f32x4 g4 = *(const f32x4*)(fnorm + 256 * j + 4 * F.lane); xr[64 * j] = v[j] * r * g4; }
    }
}

__global__ void __launch_bounds__(NWAVES * 64, 2) mk_fwd(Args args) {
    extern __shared__ __attribute__((aligned(16))) unsigned char lds[];
    MK F;
    F.lds = (LAS unsigned char*)lds; F.tid = threadIdx.x; F.lane = F.tid & 63; F.wave = __builtin_amdgcn_readfirstlane(F.tid >> 6); F.G = gridDim.x; F.bid = blockIdx.x;
    F.out = args.out; F.ws = args.ws;
    for (int u = F.tid; u < (LDS_BYTES - LDSCTL_OFF) / 4; u += NWAVES * 64) ((LAS unsigned*)(F.lds + LDSCTL_OFF))[u] = 0u;
    __syncthreads();
    cooperative_groups::grid_group grid = cooperative_groups::this_grid();
    const int lo = args.ph_lo, hi = args.ph_hi;
    for (int ph = lo; ph < hi; ++ph) {
        { int bid_ = blockIdx.x; asm volatile("" : "+s"(bid_)); F.bid = bid_; int t_ = threadIdx.x; asm volatile("" : "+v"(t_)); F.tid = t_; F.lane = t_ & 63; F.wave = __builtin_amdgcn_readfirstlane(t_ >> 6); }
        if (ph == PH_PRO) ph_prologue(F, args);
        else if (ph == PH_FINAL) ph_final_norm(F, args);
        else {
            const int l = (ph - PH_L0) / PH_PER_LAYER, k = (ph - PH_L0) % PH_PER_LAYER;
            const float* xin = (l == 0) ? ARGF(args, 0) : F.out;
            if (k == PK_NORM) ph_norm_mod(F, args, xin, l);
            else if (k == PK_INPROJ) {
                pg8::Gemm g = pg8::make_gemm((const bf16_t*)(F.ws + WS_H), DM, (const bf16_t*)(F.ws + WS_WIN_T) + (size_t)l * 3584 * DM, DM, M, 3584, DM);
                pg8::StaticOrder S; S.init(M, 3584, F.G, F.bid);
                EpiInProj E{(bf16_t*)(F.ws + WS_ACT), (const float*)(F.ws + WS_CS64), (const float*)(F.ws + WS_CS32)};
                pg8::gemm_phase<EpiInProj, pg8::StaticOrder, true, true>(F.lds, g, S, E);
            } else if (k == PK_OUTPROJ) {
                pg8::Gemm g = pg8::make_gemm((const bf16_t*)(F.ws + WS_MIX), DM, (const bf16_t*)(F.ws + WS_WOUT_T) + (size_t)l * DM * DM, DM, M, DM, DM);
                pg8::StaticOrder S; S.init(M, DM, F.G, F.bid);
                EpiOutProj E{xin, F.out, (const float*)(F.ws + WS_MOD) + (size_t)l * NB * 3072 + 2048};
                pg8::gemm_phase<EpiOutProj, pg8::StaticOrder, true, true>(F.lds, g, S, E);
            }
        }
        if (ph + 1 < hi) grid.sync();
    }
}
static int g_grid = 0;
static void launch_mk(Args a, int lo, int hi, hipStream_t stream) {
    a.ph_lo = lo; a.ph_hi = hi;
    if (hi - lo > 1) { void* params[] = {&a}; hipLaunchCooperativeKernel((const void*)mk_fwd, dim3(g_grid), dim3(NWAVES * 64), params, LDS_BYTES, stream); }
    else hipLaunchKernelGGL(mk_fwd, dim3(g_grid), dim3(NWAVES * 64), LDS_BYTES, stream, a);
}
extern "C" void kernel_launch(void* const* d_in, const int* in_sizes, int n_in, void* d_out, int out_size, void* d_ws, size_t ws_size, hipStream_t stream) {
    if (n_in != 19 || out_size != M * DM || ws_size < WS_END) { fprintf(stderr, "kernel_launch: unexpected shapes (n_in %d out %d ws %zu)\n", n_in, out_size, ws_size); return; }
    if (g_grid == 0) {
        int dev = 0, cus = 0, per_cu = 0;
        hipGetDevice(&dev); hipDeviceGetAttribute(&cus, hipDeviceAttributeMultiprocessorCount, dev);
        hipFuncSetAttribute((const void*)mk_fwd, hipFuncAttributeMaxDynamicSharedMemorySize, LDS_BYTES);
        hipOccupancyMaxActiveBlocksPerMultiprocessor(&per_cu, (const void*)mk_fwd, NWAVES * 64, LDS_BYTES);
        if (per_cu < 1) { fprintf(stderr, "kernel_launch: occupancy query says %d blocks per CU\n", per_cu); per_cu = 1; }
        g_grid = cus;
        (void)hipGetLastError();
    }
    const float* c = (const float*)d_in[1];
    const float* pos_k = (const float*)d_in[7]; const float* pos_v = (const float*)d_in[8];
    const float* ck_w1 = (const float*)d_in[9]; const float* ck_w2 = (const float*)d_in[10]; const float* cv_w1 = (const float*)d_in[11]; const float* cv_w2 = (const float*)d_in[12];
    const float* qn = (const float*)d_in[13]; const float* wuq = (const float*)d_in[14]; const float* kvn = (const float*)d_in[15]; const float* wukv = (const float*)d_in[16];
    char* ws = (char*)d_ws; (void)c;
    float* cs32 = (float*)(ws + WS_CS32); float* posb = (float*)(ws + WS_POSB); float* HID = (float*)(ws + WS_HID);
    bf16_t* MIX = (bf16_t*)(ws + WS_MIX); bf16_t* ACT = (bf16_t*)(ws + WS_ACT);
    bf16_t* MQ = (bf16_t*)(ws + WS_MQ); bf16_t* MK_ = (bf16_t*)(ws + WS_MK); bf16_t* MV = (bf16_t*)(ws + WS_MV); bf16_t* OC = (bf16_t*)(ws + WS_OC);
    bf16_t* KC = (bf16_t*)(ws + WS_KC); bf16_t* VC = (bf16_t*)(ws + WS_VC); u64* SEL = (u64*)(ws + WS_SEL);
    Args a{};
    for (int i = 0; i < 19; ++i) a.in[i] = d_in[i];
    a.out = (float*)d_out; a.ws = (unsigned char*)d_ws;
    for (int i = 0; i < 32; ++i) a.inv.i64[i] = (float)std::pow(10000.0, -(double)i / 32.0);
    for (int i = 0; i < 16; ++i) a.inv.i32[i] = (float)std::pow(10000.0, -(double)i / 16.0);
    hipMemsetAsync(ws + WS_CTL, 0, CTL_ZERO_BYTES, stream);

    launch_mk(a, PH_PRO, PH_PRO + 1, stream);
    nv_prep_posb<<<2, 256, 0, stream>>>(pos_k, pos_v, ck_w1, cv_w1, posb);
    for (int l = 0; l < DEPTH; ++l) {
        const int p0 = PH_L0 + l * PH_PER_LAYER;
        launch_mk(a, p0 + PK_NORM, p0 + PK_NORM + 1, stream);
        launch_mk(a, p0 + PK_INPROJ, p0 + PK_INPROJ + 1, stream);
        nv_mla_up<<<M, 256, 0, stream>>>(ACT, qn + l * 192, wuq + (size_t)l * 192 * 480, kvn + l * 128, wukv + (size_t)l * 128 * 640, MQ, MK_, MV);
        nv_mla_qrope<<<(M * 80 + 255) / 256, 256, 0, stream>>>(MQ, cs32);
        nv_cmp_hidden<<<dim3(NCMP, 16, 2), 128, 0, stream>>>(ACT, ck_w1 + (size_t)l * 2048 * 128, cv_w1 + (size_t)l * 2048 * 128, posb + l * 256, HID);
        nv_cmp_out<<<dim3(256, 16, 2), 64, 0, stream>>>(HID, ck_w2 + (size_t)l * 128 * 64, cv_w2 + (size_t)l * 128 * 64, KC, VC);
        nv_nsa_cmp<<<dim3(64, 16), 64, 0, stream>>>(ACT, KC, VC, OC, SEL);
        nv_nsa_sw<<<dim3(64, 6, 8), 64, 0, stream>>>(ACT, OC, SEL, MIX);
        nv_sb<<<dim3(64, 5, 8), 64, 0, stream>>>(ACT, MIX);
        nv_mla<<<dim3(64, 5, 8), 64, 0, stream>>>(ACT, MQ, MK_, MV, MIX);
        launch_mk(a, p0 + PK_OUTPROJ, p0 + PK_OUTPROJ + 1, stream);
    }
    launch_mk(a, PH_FINAL, PH_FINAL + 1, stream);
}
```

```cpp
#include <hip/hip_runtime.h>
#include <cstdio>
#include <cstdint>
#include <cmath>
#include <hip/hip_cooperative_groups.h>

typedef unsigned short bf16_t;
typedef unsigned long long u64;

constexpr int NB = 8, SEQ = 4096, DM = 1024, M = NB * SEQ, DEPTH = 2;
constexpr int D_IN = 3506;
constexpr int NCMP = 255;
constexpr int ACTW = 3584;
constexpr int A_NQ = 0, A_KC = 384, A_VC = 512, A_KS = 640, A_VS = 768, A_KW = 896, A_VW = 1024;
constexpr int A_NZ = 1152, A_SQ = 1536, A_SK = 1856, A_SV = 2176, A_SZ = 2496;
constexpr int A_MCQ = 2816, A_MCKV = 3008, A_MKR = 3136, A_GATE = 3168, A_MZ = 3200;
constexpr float LOG2E = 1.4426950408889634f;
constexpr float QS_NSA = 0.125f * LOG2E;
constexpr float QS_MLA = 0.10206207261596577f * LOG2E;

constexpr size_t MiB = 1u << 20;
constexpr size_t WS_CTL = 0;
constexpr size_t WS_MOD = 1 * MiB;
constexpr size_t WS_CS64 = 2 * MiB;
constexpr size_t WS_CS32 = 10 * MiB;
constexpr size_t WS_POSB = 14 * MiB;
constexpr size_t WS_POSBP = 14 * MiB + 512 * 1024;
constexpr size_t WS_HID = 15 * MiB;
constexpr size_t WS_WIN_T = 20 * MiB;
constexpr size_t WS_WOUT_T = 34 * MiB;
constexpr size_t WS_H = 64 * MiB;
constexpr size_t WS_MIX = 64 * MiB;
constexpr size_t WS_ACT = 128 * MiB;
constexpr size_t WS_MQ = 352 * MiB;
constexpr size_t WS_MK = 382 * MiB;
constexpr size_t WS_MV = 412 * MiB;
constexpr size_t WS_OC = 432 * MiB;
constexpr size_t WS_KC = 456 * MiB;
constexpr size_t WS_VC = 457 * MiB;
constexpr size_t WS_SEL = 458 * MiB;
constexpr size_t WS_END = 460 * MiB;

__device__ __forceinline__ float bf2f(bf16_t v) { return __uint_as_float(((unsigned)v) << 16); }
__device__ __forceinline__ bf16_t f2bf(float f) { unsigned u = __float_as_uint(f); return (bf16_t)((u + 0x7fffu + ((u >> 16) & 1u)) >> 16); }
__device__ __forceinline__ float blo(unsigned u) { return __uint_as_float(u << 16); }
__device__ __forceinline__ float bhi(unsigned u) { return __uint_as_float(u & 0xffff0000u); }
__device__ __forceinline__ float silu_f(float v) { return v / (1.f + __expf(-v)); }
__device__ __forceinline__ float sigm_f(float v) { return 1.f / (1.f + __expf(-v)); }

struct RopeInv { float i64[32]; float i32[16]; };


#define GAS __attribute__((address_space(1)))
#define LAS __attribute__((address_space(3)))
typedef unsigned v4u __attribute__((ext_vector_type(4)));
typedef float f32x4 __attribute__((ext_vector_type(4)));
#define RLX_AGENT __ATOMIC_RELAXED, __HIP_MEMORY_SCOPE_AGENT
#define LDS_WAIT() asm volatile("s_waitcnt lgkmcnt(0)" ::: "memory")
#define VM_WAIT() asm volatile("s_waitcnt vmcnt(0)" ::: "memory")
__device__ __forceinline__ unsigned pk2(float lo, float hi) { return (unsigned)f2bf(lo) | ((unsigned)f2bf(hi) << 16); }
namespace pg8 {
#define PG8_LAS __attribute__((address_space(3)))
typedef short bf16x8 __attribute__((ext_vector_type(8)));
typedef float f32x4 __attribute__((ext_vector_type(4)));
typedef unsigned u32x4 __attribute__((ext_vector_type(4)));
constexpr int BM = 256, BK = 64, HALF = 128, HTB = HALF * BK * 2  , STAGE_BYTES = 8 * HTB, NXCD = 8, WGM = 8;

__host__ __device__ __forceinline__ int lds_byte(int r, int c) { const int st = (r >> 4) * 2 + (c >> 5), rr = r & 15, cc = c & 31, ob = rr * 64 + cc * 2; return st * 1024 + (ob ^ (((ob >> 9) & 1) << 5)); }
__host__ __device__ __forceinline__ void stage_rc(int b, int& R, int& C) { const int st = b / 1024, sb = b % 1024, swz = sb ^ (((sb >> 9) & 1) << 5); R = (st >> 1) * 16 + swz / 64; C = (st & 1) * 32 + (swz % 64) / 2; }
__host__ __device__ __forceinline__ int perm32(int rho) { const int n = rho >> 4, i = rho & 15; return 8 * (i >> 2) + 4 * n + (i & 3); }

struct Unit { int pm, pn; };
struct Gemm { const bf16_t* A; const bf16_t* Bt; int lda, ldb, kstepA; size_t a_ts_hi, a_ts_lo; int M, N, K;
    __device__ __forceinline__ size_t a_off(int pm) const { return (size_t)(pm >> 1) * a_ts_hi + (size_t)(pm & 1) * a_ts_lo; } };
__host__ __device__ inline Gemm make_gemm(const bf16_t* A, int lda, const bf16_t* Bt, int ldb, int M, int N, int K) {
    Gemm g; g.A = A; g.Bt = Bt; g.lda = lda; g.ldb = ldb; g.kstepA = BK; g.a_ts_hi = (size_t)512 * lda * 2; g.a_ts_lo = (size_t)256 * lda * 2; g.M = M; g.N = N; g.K = K; return g; }

struct StaticOrder {
    int nM, nN, nwg, G, c;
    __host__ __device__ void init(int M, int N, int G_, int c_) { nM = M / BM; nN = N / BM; nwg = nM * nN; G = G_; c = c_; }
    __host__ __device__ bool next(int i, Unit& u) const {
        const long L = (long)i * G + c; if (L >= nwg) return false;
        int wgid = (int)L; { const int q = nwg / NXCD, r = nwg % NXCD, xcd = wgid % NXCD, off = wgid / NXCD; wgid = (xcd < r ? xcd * (q + 1) : r * (q + 1) + (xcd - r) * q) + off; }
        const int nig = WGM * nN, gid = wgid / nig, fm = gid * WGM, gsz = (nM - fm) < WGM ? (nM - fm) : WGM;
        u.pm = fm + ((wgid % nig) % gsz); u.pn = (wgid % nig) / gsz; return true;
    }
    __device__ __forceinline__ void a_ready(const Unit&) const {}
    __device__ __forceinline__ void done(const Unit&) const {}
};
__device__ __forceinline__ unsigned cvt_pk_bf16(float lo, float hi) { unsigned r; asm volatile("v_cvt_pk_bf16_f32 %0, %1, %2" : "=v"(r) : "v"(lo), "v"(hi)); return r; }

template <class Epi, class Sched, bool ALIGN_EPI = false, bool SP2 = false>
__device__ __forceinline__ void gemm_phase(PG8_LAS unsigned char* lds, const Gemm g, const Sched& S, const Epi& E) {
    int tid_ = threadIdx.x; asm volatile("" : "+v"(tid_));
    const int tid = tid_, wid = __builtin_amdgcn_readfirstlane(tid >> 6), lane = tid & 63, wr = wid >> 2, wc = wid & 3, fr = lane & 15, fq = lane >> 4;
    const int K = g.K, nt = K / BK;
    unsigned voffA[2], voffB[2];
#pragma unroll
    for (int i = 0; i < 2; ++i) { int R, C; stage_rc(tid * 16 + i * 8192, R, C); const int Rb = Epi::PERM ? ((R & ~31) + perm32(R & 31)) : R;
        voffA[i] = (unsigned)(R * g.lda + C) * 2u; voffB[i] = (unsigned)(Rb * g.ldb + C) * 2u; }
    const size_t kstepA = (size_t)g.kstepA * 2, kstepB = (size_t)(BK * 2);
    const size_t hstepA = (size_t)HALF * g.lda * 2, hstepB = (size_t)HALF * g.ldb * 2;
    const size_t tstepB = 2 * hstepB;
    const unsigned ldsw = (unsigned)wid * 1024u;
    const int aoff = lds_byte(wr * 64 + fr, fq * 8), boff = lds_byte(wc * 32 + fr, fq * 8);
#define PG8_SA(b, h) (((b) * 2 + (h)) * HTB)
#define PG8_SB(b, h) ((4 + (b) * 2 + (h)) * HTB)
#define PG8_STAGE(bufoff, gbase, voff) do { _Pragma("unroll") for (int _i = 0; _i < 2; ++_i) \
        __builtin_amdgcn_global_load_lds((const unsigned*)((const char*)(gbase) + (voff)[_i]), (PG8_LAS unsigned*)(lds + (bufoff) + ldsw + _i * 8192), 16, 0, 0); } while (0)
#define PG8_LDA(dst, b, h) do { _Pragma("unroll") for (int m = 0; m < 4; ++m) _Pragma("unroll") for (int k = 0; k < 2; ++k) dst[m][k] = *(const PG8_LAS bf16x8*)(lds + PG8_SA(b, h) + aoff + m * 2048 + k * 1024); } while (0)
#define PG8_LDB(dst, b, h) do { _Pragma("unroll") for (int n = 0; n < 2; ++n) _Pragma("unroll") for (int k = 0; k < 2; ++k) dst[n][k] = *(const PG8_LAS bf16x8*)(lds + PG8_SB(b, h) + boff + n * 2048 + k * 1024); } while (0)
#define PG8_MMA(ai, bj, At, Bt) do { __builtin_amdgcn_s_setprio(1); _Pragma("unroll") for (int m = 0; m < 4; ++m) _Pragma("unroll") for (int n = 0; n < 2; ++n) _Pragma("unroll") for (int k = 0; k < 2; ++k) \
        acc[ai][bj][m][n] = __builtin_amdgcn_mfma_f32_16x16x32_bf16(Bt[n][k], At[m][k], acc[ai][bj][m][n], 0, 0, 0); __builtin_amdgcn_s_setprio(0); } while (0)
#define PG8_WAIT_V(n) asm volatile("s_waitcnt vmcnt(" #n ")" ::: "memory")
#define PG8_WAIT_L(n) asm volatile("s_waitcnt lgkmcnt(" #n ")" ::: "memory")
#define PG8_BAR __builtin_amdgcn_s_barrier()
#define PG8_SCHED __builtin_amdgcn_sched_barrier(0)
    Unit cur, nxt; int ui = 0;
    if (!S.next(0, cur)) return;
    f32x4 acc[2][2][4][2];
#pragma unroll
    for (int a = 0; a < 2; ++a)
#pragma unroll
        for (int b = 0; b < 2; ++b)
#pragma unroll
            for (int m = 0; m < 4; ++m)
#pragma unroll
                for (int n = 0; n < 2; ++n) acc[a][b][m][n] = (f32x4){0.f, 0.f, 0.f, 0.f};
    bf16x8 At[4][2], B0[2][2], B1[2][2];
    const char* cA = (const char*)g.A + g.a_off(cur.pm); const char* cB = (const char*)g.Bt + (size_t)cur.pn * tstepB;
    S.a_ready(cur);
    if constexpr (SP2) {
        PG8_STAGE(PG8_SB(0, 0), cB, voffB); PG8_STAGE(PG8_SB(0, 1), cB + hstepB, voffB); PG8_STAGE(PG8_SA(0, 0), cA, voffA); PG8_STAGE(PG8_SA(0, 1), cA + hstepA, voffA);
        if (wr == 1) PG8_BAR;
        PG8_WAIT_V(2); PG8_BAR;
        PG8_STAGE(PG8_SB(1, 0), cB + kstepB, voffB); PG8_STAGE(PG8_SA(1, 0), cA + kstepA, voffA); PG8_STAGE(PG8_SB(1, 1), cB + hstepB + kstepB, voffB);
        PG8_WAIT_V(6); PG8_BAR;
    } else {
        PG8_STAGE(PG8_SB(0, 0), cB, voffB); PG8_STAGE(PG8_SA(0, 0), cA, voffA); PG8_STAGE(PG8_SB(0, 1), cB + hstepB, voffB); PG8_STAGE(PG8_SA(0, 1), cA + hstepA, voffA);
        if (wr == 1) PG8_BAR;
        PG8_WAIT_V(4); PG8_BAR;
        PG8_STAGE(PG8_SB(1, 0), cB + kstepB, voffB); PG8_STAGE(PG8_SA(1, 0), cA + kstepA, voffA); PG8_STAGE(PG8_SB(1, 1), cB + hstepB + kstepB, voffB);
        PG8_WAIT_V(6); PG8_BAR;
    }
    for (;;) {
        const bool has_next = S.next(ui + 1, nxt);
        const char* nA = has_next ? (const char*)g.A + g.a_off(nxt.pm) : cA; const char* nB = has_next ? (const char*)g.Bt + (size_t)nxt.pn * tstepB : cB;
        for (int t = 0; t < nt; t += 2) {
            const bool last = (t == nt - 2);
            const char* a1 = cA + (size_t)(t + 1) * kstepA;
            const char* a2 = last ? nA : cA + (size_t)(t + 2) * kstepA; const char* b2 = last ? nB : cB + (size_t)(t + 2) * kstepB;
            const char* a3 = a2 + kstepA; const char* b3 = b2 + kstepB;
            if (last && has_next) S.a_ready(nxt);
            if constexpr (SP2) {
            PG8_LDB(B0, 0, 0); PG8_LDB(B1, 0, 1); PG8_SCHED; PG8_LDA(At, 0, 0); PG8_STAGE(PG8_SA(1, 1), a1 + hstepA, voffA);
            PG8_WAIT_V(8); PG8_WAIT_L(0); PG8_BAR; PG8_MMA(0, 0, At, B0); PG8_MMA(0, 1, At, B1); PG8_BAR; PG8_SCHED;
            PG8_LDA(At, 0, 1); PG8_STAGE(PG8_SB(0, 0), b2, voffB); PG8_STAGE(PG8_SB(0, 1), b2 + hstepB, voffB); PG8_STAGE(PG8_SA(0, 0), a2, voffA);
            PG8_WAIT_V(8); PG8_WAIT_L(0); PG8_BAR; PG8_MMA(1, 0, At, B0); PG8_MMA(1, 1, At, B1); PG8_BAR; PG8_SCHED;
            PG8_LDB(B0, 1, 0); PG8_LDB(B1, 1, 1); PG8_SCHED; PG8_LDA(At, 1, 0); PG8_STAGE(PG8_SA(0, 1), a2 + hstepA, voffA);
            PG8_WAIT_V(8); PG8_WAIT_L(0); PG8_BAR; PG8_MMA(0, 0, At, B0); PG8_MMA(0, 1, At, B1); PG8_BAR; PG8_SCHED;
            PG8_LDA(At, 1, 1); PG8_STAGE(PG8_SB(1, 0), b3, voffB); PG8_STAGE(PG8_SB(1, 1), b3 + hstepB, voffB); PG8_STAGE(PG8_SA(1, 0), a3, voffA);
            PG8_WAIT_V(8); PG8_WAIT_L(0); PG8_BAR; PG8_MMA(1, 0, At, B0); PG8_MMA(1, 1, At, B1); PG8_BAR; PG8_SCHED;
            } else {
            PG8_LDB(B0, 0, 0); PG8_SCHED; PG8_LDA(At, 0, 0); PG8_STAGE(PG8_SA(1, 1), a1 + hstepA, voffA);
            PG8_WAIT_L(8); PG8_BAR; PG8_WAIT_L(0); PG8_MMA(0, 0, At, B0); PG8_BAR; PG8_SCHED;
            PG8_LDB(B1, 0, 1); PG8_STAGE(PG8_SB(0, 0), b2, voffB);
            PG8_BAR; PG8_WAIT_L(0); PG8_MMA(0, 1, At, B1); PG8_BAR;
            PG8_LDA(At, 0, 1); PG8_STAGE(PG8_SA(0, 0), a2, voffA);
            PG8_BAR; PG8_WAIT_L(0); PG8_MMA(1, 0, At, B0); PG8_BAR; PG8_SCHED;
            PG8_STAGE(PG8_SB(0, 1), b2 + hstepB, voffB);
            PG8_WAIT_V(6); PG8_BAR; PG8_MMA(1, 1, At, B1); PG8_BAR;
            PG8_LDB(B0, 1, 0); PG8_SCHED; PG8_LDA(At, 1, 0); PG8_STAGE(PG8_SA(0, 1), a2 + hstepA, voffA);
            PG8_WAIT_L(8); PG8_BAR; PG8_WAIT_L(0); PG8_MMA(0, 0, At, B0); PG8_BAR; PG8_SCHED;
            PG8_LDB(B1, 1, 1); PG8_STAGE(PG8_SB(1, 0), b3, voffB);
            PG8_BAR; PG8_WAIT_L(0); PG8_MMA(0, 1, At, B1); PG8_BAR;
            PG8_LDA(At, 1, 1); PG8_STAGE(PG8_SA(1, 0), a3, voffA);
            PG8_BAR; PG8_WAIT_L(0); PG8_MMA(1, 0, At, B0); PG8_BAR; PG8_SCHED;
            PG8_STAGE(PG8_SB(1, 1), b3 + hstepB, voffB);
            PG8_WAIT_V(6); PG8_BAR; PG8_MMA(1, 1, At, B1); PG8_BAR;
            }
        }
        if constexpr (ALIGN_EPI) { if (wr == 0) PG8_BAR; }
        if constexpr (!Epi::AFTER_DRAIN) { E(acc, cur, wr, wc, fr, fq); S.done(cur); }
        if (!has_next) break;
#pragma unroll
        for (int a = 0; a < 2; ++a)
#pragma unroll
            for (int b = 0; b < 2; ++b)
#pragma unroll
                for (int m = 0; m < 4; ++m)
#pragma unroll
                    for (int n = 0; n < 2; ++n) acc[a][b][m][n] = (f32x4){0.f, 0.f, 0.f, 0.f};
        cur = nxt; cA = nA; cB = nB; ++ui;
        if constexpr (ALIGN_EPI) { if (wr == 1) PG8_BAR; }
    }
    PG8_WAIT_V(0);
    if constexpr (!ALIGN_EPI) { if (wr == 0) PG8_BAR; }
    PG8_BAR;
    if constexpr (Epi::AFTER_DRAIN) { E.fused(acc, cur, wr, wc, fr, fq, lds, wid, lane); S.done(cur); }
#undef PG8_SA
#undef PG8_SB
#undef PG8_STAGE
#undef PG8_LDA
#undef PG8_LDB
#undef PG8_MMA
#undef PG8_WAIT_V
#undef PG8_WAIT_L
#undef PG8_BAR
#undef PG8_SCHED
}
}
#define XB_TMO      128
#define XB_XCNT(j)  (256  + 64 * (j))
#define XB_XSUB(j)  (1280 + 64 * (j))
#define XB_XGEN(j)  (2304 + 64 * (j))
#define XB_TOP      3328
#define XB_TOPGEN   3392
#define XCD_BAR_WORDS 3456
#define XB_SPIN_CAP (1u << 18)

__device__ __forceinline__ unsigned xb_ld(unsigned* p)              { return __hip_atomic_load(p, __ATOMIC_RELAXED, __HIP_MEMORY_SCOPE_AGENT); }
__device__ __forceinline__ unsigned xb_add(unsigned* p, unsigned v) { return __hip_atomic_fetch_add(p, v, __ATOMIC_RELAXED, __HIP_MEMORY_SCOPE_AGENT); }
__device__ __forceinline__ unsigned xb_xcc_id() { return (unsigned)__builtin_amdgcn_s_getreg((3 << 11) | 20) & 0xFu; }
#define XB_SPIN(cond, bar) do { unsigned _sp = 0; while (cond) { __builtin_amdgcn_s_sleep(1); \
    if ((++_sp & 255u) == 0u) { if (xb_ld(&(bar)[XB_TMO])) break; if (_sp > XB_SPIN_CAP) { atomicAdd(&(bar)[XB_TMO], 1u); break; } } } } while (0)

struct XcdBarrier {
    unsigned* bar; unsigned x;
    volatile LAS unsigned* st;
};

__device__ __forceinline__ XcdBarrier xcd_barrier_post(unsigned* bar, volatile LAS unsigned* st) {
    XcdBarrier b; b.bar = bar; b.x = xb_xcc_id(); b.st = st;
    if (threadIdx.x == 0) (void)xb_add(&bar[XB_XCNT(b.x)], 1u);
    return b;
}
__device__ __forceinline__ void xcd_barrier_complete(unsigned* bar, unsigned x, unsigned& nloc, unsigned& nx) {
    const unsigned G = gridDim.x * gridDim.y * gridDim.z;
    unsigned sum, cnt, mine, sp = 0u;
    for (;;) {
        sum = 0u; cnt = 0u; mine = 0u;
#pragma unroll
        for (unsigned j = 0; j < 16; ++j) { const unsigned c = xb_ld(&bar[XB_XCNT(j)]); sum += c; cnt += (c > 0u) ? 1u : 0u; mine = (j == x) ? c : mine; }
        if (sum == G) break;
        __builtin_amdgcn_s_sleep(1);
        if ((++sp & 255u) == 0u) { if (xb_ld(&bar[XB_TMO])) break; if (sp > XB_SPIN_CAP) { atomicAdd(&bar[XB_TMO], 1u); break; } }
    }
    nloc = mine > 0u ? mine : 1u; nx = cnt > 0u ? cnt : 1u;
}

__device__ __forceinline__ void xcd_barrier(const XcdBarrier& b) {
    asm volatile("s_waitcnt vmcnt(0)" ::: "memory");
    __syncthreads();
    if (threadIdx.x == 0) {
        unsigned* bar = b.bar;
        __builtin_amdgcn_s_waitcnt(0);
        unsigned nloc = b.st[0], nx = b.st[1];
        if (nloc == 0u) { xcd_barrier_complete(bar, b.x, nloc, nx); b.st[0] = nloc; b.st[1] = nx; }
        const unsigned old = xb_add(&bar[XB_XSUB(b.x)], 1u);
        const unsigned gen = old / nloc;
        if (old + 1u == (gen + 1u) * nloc) {
            __builtin_amdgcn_fence(__ATOMIC_RELEASE, "agent");
            asm volatile("s_waitcnt vmcnt(0)" ::: "memory");
            const unsigned og = xb_add(&bar[XB_TOP], 1u);
            const unsigned tg = og / nx;
            if (og + 1u == (tg + 1u) * nx) xb_add(&bar[XB_TOPGEN], 1u);
            else XB_SPIN(xb_ld(&bar[XB_TOPGEN]) == tg, bar);
            __builtin_amdgcn_fence(__ATOMIC_ACQUIRE, "agent");
            xb_add(&bar[XB_XGEN(b.x)], 1u);
            asm volatile("s_waitcnt vmcnt(0)" ::: "memory");
        } else {
            XB_SPIN(xb_ld(&bar[XB_XGEN(b.x)]) == gen, bar);
            __builtin_amdgcn_fence(__ATOMIC_ACQUIRE, "agent");
            asm volatile("s_waitcnt vmcnt(0)" ::: "memory");
        }
    }
    __syncthreads();
}
__global__ void nv_prep_mod(const float* c, const float* ada_w, const float* ada_b, float* mod) {
    int idx = blockIdx.x * 256 + threadIdx.x; if (idx >= DEPTH * NB * 3072) return;
    int col = idx % 3072, b = (idx / 3072) % NB, l = idx / (3072 * NB);
    float acc = ada_b[l * 3072 + col];
    for (int k = 0; k < DM; ++k) { float cv = c[b * DM + k]; acc += silu_f(cv) * ada_w[((size_t)l * DM + k) * 3072 + col]; }
    mod[idx] = acc;
}
__device__ __forceinline__ void sincos_rev(float ang, float& s, float& c) {
    double rev = (double)ang * 0.15915494309189535; rev -= rint(rev);
    float r = (float)rev; s = __builtin_amdgcn_sinf(r); c = __builtin_amdgcn_cosf(r);
}
__global__ void nv_prep_rope(const int* pos, RopeInv inv, float* cs64, float* cs32) {
    int idx = blockIdx.x * 256 + threadIdx.x; if (idx >= M * 48) return;
    int m = idx / 48, i = idx % 48; float p = (float)pos[m];
    if (i < 32) { float ang = p * inv.i64[i], s, c; sincos_rev(ang, s, c); cs64[((size_t)m * 32 + i) * 2] = c; cs64[((size_t)m * 32 + i) * 2 + 1] = s; }
    else { int j = i - 32; float ang = p * inv.i32[j], s, c; sincos_rev(ang, s, c); cs32[((size_t)m * 16 + j) * 2] = c; cs32[((size_t)m * 16 + j) * 2 + 1] = s; }
}
__global__ void nv_prep_posb(const float* pos_k, const float* pos_v, const float* ck_w1, const float* cv_w1, float* posb) {
    int idx = blockIdx.x * 256 + threadIdx.x; if (idx >= DEPTH * 2 * 128) return;
    int u = idx % 128, kv = (idx / 128) % 2, l = idx / 256;
    const float* pe = (kv ? pos_v : pos_k) + (size_t)l * 2048; const float* w1 = (kv ? cv_w1 : ck_w1) + (size_t)l * 2048 * 128;
    float acc = 0.f; for (int k = 0; k < 2048; ++k) acc += pe[k] * w1[(size_t)k * 128 + u];
    posb[idx] = acc;
}

__global__ void nv_norm_mod(const float* x, const float* g, const float* mod, bf16_t* H) {
    int row = blockIdx.x * 4 + (threadIdx.x >> 6), lane = threadIdx.x & 63; int b = row / SEQ;
    const float* xr = x + (size_t)row * DM; float v[16]; float ss = 0.f;
#pragma unroll
    for (int j = 0; j < 4; ++j) { float4 t = *(const float4*)(xr + j * 256 + lane * 4); v[4 * j] = t.x; v[4 * j + 1] = t.y; v[4 * j + 2] = t.z; v[4 * j + 3] = t.w; ss += t.x * t.x + t.y * t.y + t.z * t.z + t.w * t.w; }
#pragma unroll
    for (int o = 1; o < 64; o <<= 1) ss += __shfl_xor(ss, o);
    float r = rsqrtf(ss * (1.f / DM) + 1e-6f);
    const float* sh = mod + (size_t)b * 3072, * sc = sh + 1024;
#pragma unroll
    for (int j = 0; j < 4; ++j)
#pragma unroll
        for (int e = 0; e < 4; ++e) { int c = j * 256 + lane * 4 + e; float h = v[4 * j + e] * r * g[c] * (1.f + sc[c]) + sh[c]; H[(size_t)row * DM + c] = f2bf(h); }
}
__global__ void nv_final_norm(float* xo, const float* g) {
    int row = blockIdx.x * 4 + (threadIdx.x >> 6), lane = threadIdx.x & 63;
    float* xr = xo + (size_t)row * DM; float v[16]; float ss = 0.f;
#pragma unroll
    for (int j = 0; j < 4; ++j) { float4 t = *(const float4*)(xr + j * 256 + lane * 4); v[4 * j] = t.x; v[4 * j + 1] = t.y; v[4 * j + 2] = t.z; v[4 * j + 3] = t.w; ss += t.x * t.x + t.y * t.y + t.z * t.z + t.w * t.w; }
#pragma unroll
    for (int o = 1; o < 64; o <<= 1) ss += __shfl_xor(ss, o);
    float r = rsqrtf(ss * (1.f / DM) + 1e-6f);
#pragma unroll
    for (int j = 0; j < 4; ++j) { float4 t; int c = j * 256 + lane * 4; t.x = v[4 * j] * r * g[c]; t.y = v[4 * j + 1] * r * g[c + 1]; t.z = v[4 * j + 2] * r * g[c + 2]; t.w = v[4 * j + 3] * r * g[c + 3]; *(float4*)(xr + c) = t; }
}

__device__ __forceinline__ int inproj_src_col(int c) {
    if (c < 1152) return c;
    if (c < 1536) return 1170 + (c - 1152);
    if (c < 3168) return c + 18;
    if (c < 3200) return (c - 3168 < 18) ? 1152 + (c - 3168) : -1;
    if (c < 3520) return c - 14;
    return -1;
}
template <int MODE>
__global__ void __launch_bounds__(256) nv_gemm(const bf16_t* A, int lda, const float* W, int ldw, int K,
                                             bf16_t* ACT, const float* cs64, const float* cs32,
                                             const float* xin, float* xout, const float* gate) {
    __shared__ float As[16][65]; __shared__ float Bs[16][65]; __shared__ float Cs[64][65];
    const int tid = threadIdx.x, tx = tid & 15, ty = tid >> 4;
    const int row0 = blockIdx.y * 64, col0 = blockIdx.x * 64;
    const int bc = tid & 63; int sc = (MODE == 0) ? inproj_src_col(col0 + bc) : col0 + bc;
    float acc[4][4] = {};
    for (int k0 = 0; k0 < K; k0 += 16) {
#pragma unroll
        for (int i = 0; i < 4; ++i) { int e = tid + 256 * i; int r = e >> 4, kk = e & 15; As[kk][r] = bf2f(A[(size_t)(row0 + r) * lda + k0 + kk]); }
#pragma unroll
        for (int i = 0; i < 4; ++i) { int kk = (tid >> 6) + 4 * i; Bs[kk][bc] = (sc >= 0) ? W[(size_t)(k0 + kk) * ldw + sc] : 0.f; }
        __syncthreads();
#pragma unroll
        for (int kk = 0; kk < 16; ++kk) { float a[4], b[4];
#pragma unroll
            for (int i = 0; i < 4; ++i) { a[i] = As[kk][ty * 4 + i]; b[i] = Bs[kk][tx * 4 + i]; }
#pragma unroll
            for (int i = 0; i < 4; ++i)
#pragma unroll
                for (int j = 0; j < 4; ++j) acc[i][j] += a[i] * b[j]; }
        __syncthreads();
    }
#pragma unroll
    for (int i = 0; i < 4; ++i)
#pragma unroll
        for (int j = 0; j < 4; ++j) Cs[ty * 4 + i][tx * 4 + j] = acc[i][j];
    __syncthreads();
    for (int e = tid; e < 64 * 64; e += 256) {
        int r = e >> 6, cc = e & 63; int m = row0 + r, c = col0 + cc; float v = Cs[r][cc];
        if (MODE == 1) { int b = m / SEQ; xout[(size_t)m * DM + c] = xin[(size_t)m * DM + c] + gate[(size_t)b * 3072 + c] * v; continue; }
        float o;
        if (c < 384 || (c >= A_KC && c < A_VC) || (c >= A_KS && c < A_VS) || (c >= A_KW && c < A_VW)) {
            int i = cc & 31; float cs = cs64[((size_t)m * 32 + i) * 2], sn = cs64[((size_t)m * 32 + i) * 2 + 1];
            float x1 = Cs[r][i], x2 = Cs[r][i + 32];
            o = (cc < 32) ? (x1 * cs - x2 * sn) : (x2 * cs + x1 * sn);
            if (c < 384) o *= QS_NSA;
        } else if (c < A_NZ) o = v;
        else if (c < A_SQ) o = silu_f(v);
        else if (c < A_SK) o = v * 0.125f;
        else if (c < A_SZ) o = v;
        else if (c < A_MCQ) o = silu_f(v);
        else if (c < A_MKR) o = v;
        else if (c < A_GATE) { int i = cc & 15; float cs = cs32[((size_t)m * 16 + i) * 2], sn = cs32[((size_t)m * 16 + i) * 2 + 1];
            float x1 = Cs[r][i], x2 = Cs[r][i + 16]; o = (cc < 16) ? (x1 * cs - x2 * sn) : (x2 * cs + x1 * sn); }
        else if (c < A_MZ) o = (c - A_GATE < 18) ? sigm_f(v) : 0.f;
        else if (c < 3520) o = silu_f(v);
        else o = 0.f;
        ACT[(size_t)m * ACTW + c] = f2bf(o);
    }
}

__global__ void nv_mla_up(const bf16_t* ACT, const float* qn, const float* wuq, const float* kvn, const float* wukv, bf16_t* MQ, bf16_t* MK, bf16_t* MV) {
    __shared__ float xq[192]; __shared__ float xkv[128]; __shared__ float red[2];
    int m = blockIdx.x, tid = threadIdx.x; const bf16_t* a = ACT + (size_t)m * ACTW;
    if (tid < 192) xq[tid] = bf2f(a[A_MCQ + tid]); if (tid < 128) xkv[tid] = bf2f(a[A_MCKV + tid]);
    __syncthreads();
    if (tid == 0) { float s = 0; for (int k = 0; k < 192; ++k) s += xq[k] * xq[k]; red[0] = rsqrtf(s / 192.f + 1e-6f); s = 0; for (int k = 0; k < 128; ++k) s += xkv[k] * xkv[k]; red[1] = rsqrtf(s / 128.f + 1e-6f); }
    __syncthreads();
    float rq = red[0], rkv = red[1];
    if (tid < 192) xq[tid] = xq[tid] * rq * qn[tid]; if (tid < 128) xkv[tid] = xkv[tid] * rkv * kvn[tid];
    __syncthreads();
    for (int j = tid; j < 480; j += 256) { int h = j / 96, e = j % 96;
        if (e < 64) { float s = 0; for (int k = 0; k < 192; ++k) s += xq[k] * wuq[(size_t)k * 480 + j]; MQ[(size_t)m * 480 + j] = f2bf(s * QS_MLA); }
        else if (e < 80) { int i = e - 64; float s1 = 0, s2 = 0; for (int k = 0; k < 192; ++k) { s1 += xq[k] * wuq[(size_t)k * 480 + j]; s2 += xq[k] * wuq[(size_t)k * 480 + j + 16]; }
            MQ[(size_t)m * 480 + h * 96 + 64 + i] = f2bf(s1); MQ[(size_t)m * 480 + h * 96 + 80 + i] = f2bf(s2); } }
    for (int j = tid; j < 640; j += 256) { int h = j / 128, e = j % 128; float s = 0; for (int k = 0; k < 128; ++k) s += xkv[k] * wukv[(size_t)k * 640 + j];
        if (e < 64) MK[(size_t)m * 480 + h * 96 + e] = f2bf(s); else MV[(size_t)m * 320 + h * 64 + e - 64] = f2bf(s); }
    for (int j = tid; j < 160; j += 256) { int h = j / 32, i = j % 32; MK[(size_t)m * 480 + h * 96 + 64 + i] = a[A_MKR + i]; }
}
__global__ void nv_mla_qrope(bf16_t* MQ, const float* cs32) {
    int idx = blockIdx.x * 256 + threadIdx.x; if (idx >= M * 80) return;
    int m = idx / 80, r = idx % 80, h = r / 16, i = r % 16;
    bf16_t* p = MQ + (size_t)m * 480 + h * 96 + 64; float x1 = bf2f(p[i]), x2 = bf2f(p[i + 16]);
    float cs = cs32[((size_t)m * 16 + i) * 2], sn = cs32[((size_t)m * 16 + i) * 2 + 1];
    p[i] = f2bf((x1 * cs - x2 * sn) * QS_MLA); p[i + 16] = f2bf((x2 * cs + x1 * sn) * QS_MLA);
}

__global__ void nv_cmp_hidden(const bf16_t* ACT, const float* ck_w1, const float* cv_w1, const float* posb, float* HID) {
    int n = blockIdx.x, bg = blockIdx.y, kv = blockIdx.z, u = threadIdx.x; int b = bg >> 1, g = bg & 1;
    const float* w1 = kv ? cv_w1 : ck_w1; const int col = (kv ? A_VC : A_KC) + g * 64;
    __shared__ float tok[2048];
    for (int e = u; e < 2048; e += 128) { int j = e >> 6, d = e & 63; tok[e] = bf2f(ACT[(size_t)(b * SEQ + 16 * n + j) * ACTW + col + d]); }
    __syncthreads();
    float acc = posb[kv * 128 + u];
    for (int k = 0; k < 2048; ++k) acc += tok[k] * w1[(size_t)k * 128 + u];
    HID[(((size_t)kv * 16 + bg) * 256 + n) * 128 + u] = silu_f(acc);
}
__global__ void nv_cmp_out(const float* HID, const float* ck_w2, const float* cv_w2, bf16_t* KC, bf16_t* VC) {
    int n = blockIdx.x, bg = blockIdx.y, kv = blockIdx.z, d = threadIdx.x;
    bf16_t* out = (kv ? VC : KC) + ((size_t)bg * 256 + n) * 64 + d;
    if (n >= NCMP) { *out = 0; return; }
    const float* w2 = kv ? cv_w2 : ck_w2; const float* h = HID + (((size_t)kv * 16 + bg) * 256 + n) * 128;
    float acc = 0; for (int u = 0; u < 128; ++u) acc += h[u] * w2[u * 64 + d];
    *out = f2bf(acc);
}

#define DOT64(res, qarr, kptr) do { const uint4* _kp = (const uint4*)(kptr); float _s = 0.f; \
    _Pragma("unroll") for (int _c = 0; _c < 8; ++_c) { uint4 _v = _kp[_c]; \
      _s += qarr[8*_c+0]*blo(_v.x) + qarr[8*_c+1]*bhi(_v.x) + qarr[8*_c+2]*blo(_v.y) + qarr[8*_c+3]*bhi(_v.y) \
          + qarr[8*_c+4]*blo(_v.z) + qarr[8*_c+5]*bhi(_v.z) + qarr[8*_c+6]*blo(_v.w) + qarr[8*_c+7]*bhi(_v.w); } res = _s; } while (0)
#define AXPY64(oarr, p, vptr) do { const uint4* _vp = (const uint4*)(vptr); \
    _Pragma("unroll") for (int _c = 0; _c < 8; ++_c) { uint4 _v = _vp[_c]; \
      oarr[8*_c+0] += p*blo(_v.x); oarr[8*_c+1] += p*bhi(_v.x); oarr[8*_c+2] += p*blo(_v.y); oarr[8*_c+3] += p*bhi(_v.y); \
      oarr[8*_c+4] += p*blo(_v.z); oarr[8*_c+5] += p*bhi(_v.z); oarr[8*_c+6] += p*blo(_v.w); oarr[8*_c+7] += p*bhi(_v.w); } } while (0)
#define LOADQ64(qarr, qptr) do { const uint4* _qp = (const uint4*)(qptr); \
    _Pragma("unroll") for (int _c = 0; _c < 8; ++_c) { uint4 _v = _qp[_c]; \
      qarr[8*_c+0] = blo(_v.x); qarr[8*_c+1] = bhi(_v.x); qarr[8*_c+2] = blo(_v.y); qarr[8*_c+3] = bhi(_v.y); \
      qarr[8*_c+4] = blo(_v.z); qarr[8*_c+5] = bhi(_v.z); qarr[8*_c+6] = blo(_v.w); qarr[8*_c+7] = bhi(_v.w); } } while (0)

__global__ void __launch_bounds__(64) nv_nsa_cmp(const bf16_t* ACT, const bf16_t* KC, const bf16_t* VC, bf16_t* OC, u64* SEL) {
    __shared__ float imp[64][64];
    const int tid = threadIdx.x, t = blockIdx.x * 64 + tid, bg = blockIdx.y, b = bg >> 1, g = bg & 1; const size_t m = (size_t)b * SEQ + t;
    for (int j = 0; j < 64; ++j) imp[j][tid] = 0.f;
    const bf16_t* kc = KC + (size_t)bg * 256 * 64; const bf16_t* vc = VC + (size_t)bg * 256 * 64;
    const int nvalid = (t >= 31) ? min(NCMP, (t - 31) / 16 + 1) : 0;
    for (int hh = 0; hh < 3; ++hh) {
        const int h = g * 3 + hh; float q[64]; LOADQ64(q, ACT + m * ACTW + A_NQ + h * 64);
        float mx = -3e38f;
        for (int n = 0; n < nvalid; ++n) { float s; DOT64(s, q, kc + n * 64); mx = fmaxf(mx, s); }
        float l = 0.f;
        for (int n = 0; n < nvalid; ++n) { float s; DOT64(s, q, kc + n * 64); l += exp2f(s - mx); }
        float o[64];
#pragma unroll
        for (int d = 0; d < 64; ++d) o[d] = 0.f;
        const float il = (nvalid > 0) ? 1.f / l : 0.f;
        for (int n = 0; n < nvalid; ++n) { float s; DOT64(s, q, kc + n * 64); float p = exp2f(s - mx) * il; AXPY64(o, p, vc + n * 64);
            imp[n >> 2][tid] += p; if ((n & 3) == 3 && (n >> 2) + 1 < 64) imp[(n >> 2) + 1][tid] += p; }
        const float gc = bf2f(ACT[m * ACTW + A_GATE + h * 3 + 0]);
#pragma unroll
        for (int d = 0; d < 64; ++d) OC[m * 384 + h * 64 + d] = f2bf(o[d] * gc);
    }
    const int cur = t >> 6; u64 mask = 0ull;
    for (int r = 0; r < 16; ++r) { float best = -3e38f; int bi = 0;
        for (int j = 0; j < 64; ++j) { if ((mask >> j) & 1ull) continue; const bool valid = (j * 64 <= t); const bool forced = (j == 0) || (j == cur) || (j == cur - 1);
            float v = valid ? (forced ? 1e9f : imp[j][tid]) : -1e9f; if (v > best) { best = v; bi = j; } }
        mask |= (1ull << bi); }
    u64 vmask = (cur >= 63) ? ~0ull : ((1ull << (cur + 1)) - 1ull);
    SEL[(size_t)bg * SEQ + t] = mask & vmask;
}

__global__ void __launch_bounds__(64) nv_nsa_sw(const bf16_t* ACT, const bf16_t* OC, const u64* SEL, bf16_t* MIX) {
    const int tid = threadIdx.x, t = blockIdx.x * 64 + tid, h = blockIdx.y, b = blockIdx.z, g = h / 3; const size_t m = (size_t)b * SEQ + t;
    float q[64]; LOADQ64(q, ACT + m * ACTW + A_NQ + h * 64);
    float out[64];
#pragma unroll
    for (int d = 0; d < 64; ++d) out[d] = bf2f(OC[m * 384 + h * 64 + d]);
    const u64 sel = SEL[((size_t)(b * 2 + g)) * SEQ + t];
    const bf16_t* base = ACT + (size_t)b * SEQ * ACTW;
    {
        float o[64];
#pragma unroll
        for (int d = 0; d < 64; ++d) o[d] = 0.f;
        float mx = -3e38f, l = 0.f;
        for (int j = 0; j < 64; ++j) { if (!((sel >> j) & 1ull)) continue;
            const int s1 = min(64 * j + 63, t);
            for (int s = 64 * j; s <= s1; ++s) { float sc; DOT64(sc, q, base + (size_t)s * ACTW + A_KS + g * 64);
                if (sc > mx) { float f = exp2f(mx - sc); l *= f;
#pragma unroll
                    for (int d = 0; d < 64; ++d) o[d] *= f;
                    mx = sc; }
                float p = exp2f(sc - mx); l += p; AXPY64(o, p, base + (size_t)s * ACTW + A_VS + g * 64); } }
        const float gs = bf2f(ACT[m * ACTW + A_GATE + h * 3 + 1]) / l;
#pragma unroll
        for (int d = 0; d < 64; ++d) out[d] += gs * o[d];
    }
    {
        float o[64];
#pragma unroll
        for (int d = 0; d < 64; ++d) o[d] = 0.f;
        float mx = -3e38f, l = 0.f;
        for (int s = max(0, t - 511); s <= t; ++s) { float sc; DOT64(sc, q, base + (size_t)s * ACTW + A_KW + g * 64);
            if (sc > mx) { float f = exp2f(mx - sc); l *= f;
#pragma unroll
                for (int d = 0; d < 64; ++d) o[d] *= f;
                mx = sc; }
            float p = exp2f(sc - mx); l += p; AXPY64(o, p, base + (size_t)s * ACTW + A_VW + g * 64); }
        const float gw = bf2f(ACT[m * ACTW + A_GATE + h * 3 + 2]) / l;
#pragma unroll
        for (int d = 0; d < 64; ++d) out[d] += gw * o[d];
    }
#pragma unroll
    for (int d = 0; d < 64; ++d) MIX[m * DM + h * 64 + d] = f2bf(out[d] * bf2f(ACT[m * ACTW + A_NZ + h * 64 + d]));
}

#ifndef SB_EARLY_EXIT
#define SB_EARLY_EXIT 0
#endif
__global__ void __launch_bounds__(64) nv_sb(const bf16_t* ACT, bf16_t* MIX) {
    const int tid = threadIdx.x, t = blockIdx.x * 64 + tid, h = blockIdx.y, b = blockIdx.z; const size_t m = (size_t)b * SEQ + t;
    float q[64]; LOADQ64(q, ACT + m * ACTW + A_SQ + h * 64);
    float o[64];
#pragma unroll
    for (int d = 0; d < 64; ++d) o[d] = 0.f;
    const bf16_t* base = ACT + (size_t)b * SEQ * ACTW; float R = 0.f;
    for (int s = t - 1; s >= 0; --s) { float z; DOT64(z, q, base + (size_t)s * ACTW + A_SK + h * 64);
        const float sp = fmaxf(z, 0.f) + log1pf(__expf(-fabsf(z)));
        const float a = __expf(z - sp - R); AXPY64(o, a, base + (size_t)s * ACTW + A_SV + h * 64); R += sp;
#if SB_EARLY_EXIT
        if (R >= 104.f) break;
#endif
    }
#pragma unroll
    for (int d = 0; d < 64; ++d) MIX[m * DM + 384 + h * 64 + d] = f2bf(o[d] * bf2f(ACT[m * ACTW + A_SZ + h * 64 + d]));
}

__global__ void __launch_bounds__(64) nv_mla(const bf16_t* ACT, const bf16_t* MQ, const bf16_t* MK, const bf16_t* MV, bf16_t* MIX) {
    const int tid = threadIdx.x, t = blockIdx.x * 64 + tid, h = blockIdx.y, b = blockIdx.z; const size_t m = (size_t)b * SEQ + t;
    float q[64], q2[32]; LOADQ64(q, MQ + m * 480 + h * 96);
    { const uint4* qp = (const uint4*)(MQ + m * 480 + h * 96 + 64);
#pragma unroll
      for (int c = 0; c < 4; ++c) { uint4 v = qp[c]; q2[8*c] = blo(v.x); q2[8*c+1] = bhi(v.x); q2[8*c+2] = blo(v.y); q2[8*c+3] = bhi(v.y); q2[8*c+4] = blo(v.z); q2[8*c+5] = bhi(v.z); q2[8*c+6] = blo(v.w); q2[8*c+7] = bhi(v.w); } }
    float o[64];
#pragma unroll
    for (int d = 0; d < 64; ++d) o[d] = 0.f;
    float mx = -3e38f, l = 0.f;
    for (int s = 0; s <= t; ++s) { const bf16_t* kp = MK + ((size_t)b * SEQ + s) * 480 + h * 96; float sc; DOT64(sc, q, kp);
        { const uint4* k2 = (const uint4*)(kp + 64);
#pragma unroll
          for (int c = 0; c < 4; ++c) { uint4 v = k2[c]; sc += q2[8*c]*blo(v.x) + q2[8*c+1]*bhi(v.x) + q2[8*c+2]*blo(v.y) + q2[8*c+3]*bhi(v.y) + q2[8*c+4]*blo(v.z) + q2[8*c+5]*bhi(v.z) + q2[8*c+6]*blo(v.w) + q2[8*c+7]*bhi(v.w); } }
        if (sc > mx) { float f = exp2f(mx - sc); l *= f;
#pragma unroll
            for (int d = 0; d < 64; ++d) o[d] *= f;
            mx = sc; }
        float p = exp2f(sc - mx); l += p; AXPY64(o, p, MV + ((size_t)b * SEQ + s) * 320 + h * 64); }
    const float il = 1.f / l;
#pragma unroll
    for (int d = 0; d < 64; ++d) MIX[m * DM + 704 + h * 64 + d] = f2bf(o[d] * il * bf2f(ACT[m * ACTW + A_MZ + h * 64 + d]));
}

namespace fa {
typedef short bf16x8 __attribute__((ext_vector_type(8)));
typedef short s16x4 __attribute__((ext_vector_type(4)));
typedef float f32x16 __attribute__((ext_vector_type(16)));
typedef unsigned u32x4 __attribute__((ext_vector_type(4)));
typedef __attribute__((address_space(3))) const char* lds_cptr;
typedef __attribute__((address_space(3))) char* lds_ptr;
#define FA_LAS __attribute__((address_space(3)))

constexpr int STAGE_B = 20480, KIMG = 0, VIMG = 12288;
constexpr int L_WSF = 2 * STAGE_B, L_MISC = L_WSF + 2048, L_OST = L_MISC + 2048, OST_RS = 68, OST_WB = 32 * OST_RS * 4;
constexpr int L_END = L_OST + 8 * OST_WB;
static_assert(L_END <= 131072, "attention LDS map");
constexpr float NEG_INF = -INFINITY;
constexpr float THR = 6.0f;

__device__ __forceinline__ float ex2(float x) { return __builtin_amdgcn_exp2f(x); }
__device__ __forceinline__ int crow(int r, int hi) { return (r & 3) + 8 * (r >> 2) + 4 * hi; }
__device__ __forceinline__ unsigned cvtpk(float lo, float hi) { typedef float f2 __attribute__((ext_vector_type(2))); typedef __bf16 b2 __attribute__((ext_vector_type(2))); f2 v = {lo, hi}; b2 b = __builtin_convertvector(v, b2); return __builtin_bit_cast(unsigned, b); }
__device__ __forceinline__ float partner(float v) { return __shfl_xor(v, 32); }

struct KVSrc { const bf16_t* K; const bf16_t* V; int kpitch, vpitch; };
struct StageRegs { u32x4 k0, k1, v; };

template <int NKC>
__device__ __forceinline__ void stage_load(StageRegs& R, const KVSrc& s, int key0, int tid, int wave, int lane) {
    R.k0 = *(const u32x4*)(s.K + (size_t)(key0 + (tid & 63)) * s.kpitch + (tid >> 6) * 8);
    if (NKC == 12) { if (tid < 256) R.k1 = *(const u32x4*)(s.K + (size_t)(key0 + (tid & 63)) * s.kpitch + (8 + (tid >> 6)) * 8); }
    R.v = *(const u32x4*)(s.V + (size_t)(key0 + 16 * (wave & 3) + (lane >> 2)) * s.vpitch + 32 * (wave >> 2) + 8 * (lane & 3));
}
template <int NKC>
__device__ __forceinline__ void stage_write(const StageRegs& R, lds_ptr st, int tid, int wave, int lane) {
    *(FA_LAS u32x4*)(st + KIMG + (tid >> 6) * 1024 + (tid & 63) * 16) = R.k0;
    if (NKC == 12) { if (tid < 256) *(FA_LAS u32x4*)(st + KIMG + (8 + (tid >> 6)) * 1024 + (tid & 63) * 16) = R.k1; }
    *(FA_LAS u32x4*)(st + VIMG + wave * 1024 + lane * 16) = R.v;
}

template <int NK>
__device__ __forceinline__ void qkt(f32x16& p0, f32x16& p1, lds_cptr Kimg, const bf16x8* qr, int r32, int hi) {
    lds_cptr kb = Kimg + hi * 1024 + r32 * 16;
    f32x16 z = {}; p0 = z; p1 = z;
#pragma unroll
    for (int d0 = 0; d0 < NK; ++d0) {
        const bf16x8 b0 = *(const FA_LAS bf16x8*)(kb + d0 * 2048), b1 = *(const FA_LAS bf16x8*)(kb + d0 * 2048 + 512);
        p0 = __builtin_amdgcn_mfma_f32_32x32x16_bf16(b0, qr[d0], p0, 0, 0, 0); p1 = __builtin_amdgcn_mfma_f32_32x32x16_bf16(b1, qr[d0], p1, 0, 0, 0);
    }
}
typedef short v4i16_t __attribute__((ext_vector_type(4)));
__device__ __forceinline__ s16x4 vtr(lds_cptr p) { return __builtin_bit_cast(s16x4, __builtin_amdgcn_ds_read_tr16_b64_v4i16((FA_LAS v4i16_t*)p)); }
__device__ __forceinline__ void pv(f32x16* o, lds_cptr vp, const u32x4& w0, const u32x4& w1, const u32x4& w2, const u32x4& w3) {
    const bf16x8 pa[4] = {__builtin_bit_cast(bf16x8, w0), __builtin_bit_cast(bf16x8, w1), __builtin_bit_cast(bf16x8, w2), __builtin_bit_cast(bf16x8, w3)};
#pragma unroll
    for (int d0 = 0; d0 < 2; ++d0)
#pragma unroll
        for (int ks = 0; ks < 4; ++ks) {
            const s16x4 lo = vtr(vp + d0 * 4096 + ks * 1024), hi_ = vtr(vp + d0 * 4096 + ks * 1024 + 512);
            const bf16x8 vf = {lo[0], lo[1], lo[2], lo[3], hi_[0], hi_[1], hi_[2], hi_[3]};
            o[d0] = __builtin_amdgcn_mfma_f32_32x32x16_bf16(pa[ks], vf, o[d0], 0, 0, 0);
        }
}
__device__ __forceinline__ float rowmax32(const f32x16& p0, const f32x16& p1) {
    float a = fmaxf(p0[0], p1[0]);
#pragma unroll
    for (int r = 1; r < 16; ++r) a = fmaxf(a, fmaxf(p0[r], p1[r]));
    return fmaxf(a, partner(a));
}

constexpr int MK_CAUSAL = 0, MK_SEL = 1, MK_WIN = 2;

template <int MKIND, int NK, int NKC>
__device__ __forceinline__ void softmax_branch(f32x16 (&o)[2], float& l, lds_ptr lds, const KVSrc& src, const bf16x8* qr, int t_lo, int t_hi, int qidx  ,
                                               int wrow0  , u64 selmask, int tid, int wave, int lane) {
    const int r32 = lane & 31, hi = lane >> 5;
    FA_LAS float* wsf = (FA_LAS float*)(lds + L_WSF) + wave * 64;
    lds_cptr vlane = (lds_cptr)lds + VIMG + ((lane >> 4) & 1) * 32 + (lane & 3) * 8 + (4 * hi + ((lane & 15) >> 2)) * 64;
    float m = NEG_INF; l = 0.f; { f32x16 z = {}; o[0] = z; o[1] = z; }
    StageRegs R;
    stage_load<NKC>(R, src, t_lo * 64, tid, wave, lane);
    stage_write<NKC>(R, lds, tid, wave, lane);
    __syncthreads();
    for (int t = t_lo; t <= t_hi; ++t) {
        const int cur = (t - t_lo) & 1; lds_ptr st = lds + cur * STAGE_B; lds_ptr stn = lds + (cur ^ 1) * STAGE_B;
        if (t < t_hi) stage_load<NKC>(R, src, (t + 1) * 64, tid, wave, lane);
        bool need;
        if (MKIND == MK_CAUSAL) need = (64 * t <= wrow0 + 31);
        else if (MKIND == MK_SEL) need = (64 * t <= wrow0 + 31) && __any((int)((selmask >> t) & 1ull));
        else need = (64 * t <= wrow0 + 31) && (64 * t + 63 > wrow0 - 512);
        if (need) {
            f32x16 p0, p1;
            qkt<NK>(p0, p1, (lds_cptr)st + KIMG, qr, r32, hi);
            if (64 * t + 63 > wrow0) {
                const int kb = 64 * t + 4 * hi;
#pragma unroll
                for (int r = 0; r < 16; ++r) { const int kv = kb + (r & 3) + 8 * (r >> 2); if (kv > qidx) p0[r] = NEG_INF; if (kv + 32 > qidx) p1[r] = NEG_INF; }
            }
            if (MKIND == MK_WIN) { if (64 * t <= wrow0 + 31 - 512) {
                const int kb = 64 * t + 4 * hi;
#pragma unroll
                for (int r = 0; r < 16; ++r) { const int kv = kb + (r & 3) + 8 * (r >> 2); if (kv <= qidx - 512) p0[r] = NEG_INF; if (kv + 32 <= qidx - 512) p1[r] = NEG_INF; }
            } }
            float rm = rowmax32(p0, p1);
            bool rowon = true;
            if (MKIND == MK_SEL) { rowon = ((selmask >> t) & 1ull) != 0ull; rm = rowon ? rm : NEG_INF; }
            if (__any(rm > m + THR)) {
                const float mn = fmaxf(m, rm); const float f = (mn == NEG_INF) ? 1.f : ex2(m - mn);
                l *= f; m = mn; if (hi == 0) wsf[r32] = f;
                asm volatile("s_waitcnt lgkmcnt(0)" ::: "memory");
#pragma unroll
                for (int g = 0; g < 4; ++g) { const f32x4 fv = *(const FA_LAS f32x4*)(wsf + 8 * g + 4 * hi);
#pragma unroll
                    for (int e = 0; e < 4; ++e) { o[0][4 * g + e] *= fv[e]; o[1][4 * g + e] *= fv[e]; } }
            }
            const float mu = rowon ? ((m == NEG_INF) ? 0.f : m) : INFINITY;
            float s = 0.f;
#pragma unroll
            for (int r = 0; r < 16; ++r) { p0[r] = ex2(p0[r] - mu); p1[r] = ex2(p1[r] - mu); s += p0[r] + p1[r]; }
            l += s;
            u32x4 w0, w1, w2, w3;
            w0.x = cvtpk(p0[0], p0[1]); w0.y = cvtpk(p0[2], p0[3]); w0.z = cvtpk(p0[4], p0[5]); w0.w = cvtpk(p0[6], p0[7]);
            w1.x = cvtpk(p0[8], p0[9]); w1.y = cvtpk(p0[10], p0[11]); w1.z = cvtpk(p0[12], p0[13]); w1.w = cvtpk(p0[14], p0[15]);
            w2.x = cvtpk(p1[0], p1[1]); w2.y = cvtpk(p1[2], p1[3]); w2.z = cvtpk(p1[4], p1[5]); w2.w = cvtpk(p1[6], p1[7]);
            w3.x = cvtpk(p1[8], p1[9]); w3.y = cvtpk(p1[10], p1[11]); w3.z = cvtpk(p1[12], p1[13]); w3.w = cvtpk(p1[14], p1[15]);
            pv(o, vlane + cur * STAGE_B, w0, w1, w2, w3);
        }
        if (t < t_hi) stage_write<NKC>(R, stn, tid, wave, lane);
        __syncthreads();
    }
}

__device__ __forceinline__ void add_scaled(f32x16 (&acc)[2], const f32x16 (&o)[2], float fac, FA_LAS float* wsf, int r32, int hi) {
    asm volatile("s_waitcnt lgkmcnt(0)" ::: "memory");
    if (hi == 0) wsf[r32] = fac;
    asm volatile("s_waitcnt lgkmcnt(0)" ::: "memory");
#pragma unroll
    for (int g = 0; g < 4; ++g) { const f32x4 fv = *(const FA_LAS f32x4*)(wsf + 8 * g + 4 * hi);
#pragma unroll
        for (int e = 0; e < 4; ++e) { acc[0][4 * g + e] += o[0][4 * g + e] * fv[e]; acc[1][4 * g + e] += o[1][4 * g + e] * fv[e]; } }
}
__device__ __forceinline__ void store_rows(const f32x16 (&acc)[2], lds_ptr lds, int wave, int lane, bf16_t* mixrow0  , const bf16_t* addrow0, int addpitch, const bf16_t* mulrow0, int mulpitch) {
    const int r32 = lane & 31, hi = lane >> 5;
    FA_LAS float* stg = (FA_LAS float*)(lds + L_OST + wave * OST_WB);
#pragma unroll
    for (int r = 0; r < 16; ++r) { const int q = crow(r, hi); stg[q * OST_RS + r32] = acc[0][r]; stg[q * OST_RS + 32 + r32] = acc[1][r]; }
    asm volatile("s_waitcnt lgkmcnt(0)" ::: "memory");
#pragma unroll
    for (int i = 0; i < 4; ++i) {
        const int row = i * 8 + (lane >> 3), ch = lane & 7;
        const f32x4 a = *(const FA_LAS f32x4*)(stg + row * OST_RS + ch * 8), b = *(const FA_LAS f32x4*)(stg + row * OST_RS + ch * 8 + 4);
        float v[8] = {a[0], a[1], a[2], a[3], b[0], b[1], b[2], b[3]};
        if (addrow0) { const uint4 ad = *(const uint4*)(addrow0 + (size_t)row * addpitch + ch * 8);
            v[0] += blo(ad.x); v[1] += bhi(ad.x); v[2] += blo(ad.y); v[3] += bhi(ad.y); v[4] += blo(ad.z); v[5] += bhi(ad.z); v[6] += blo(ad.w); v[7] += bhi(ad.w); }
        const uint4 mu = *(const uint4*)(mulrow0 + (size_t)row * mulpitch + ch * 8);
        v[0] *= blo(mu.x); v[1] *= bhi(mu.x); v[2] *= blo(mu.y); v[3] *= bhi(mu.y); v[4] *= blo(mu.z); v[5] *= bhi(mu.z); v[6] *= blo(mu.w); v[7] *= bhi(mu.w);
        uint4 ov; ov.x = cvtpk(v[0], v[1]); ov.y = cvtpk(v[2], v[3]); ov.z = cvtpk(v[4], v[5]); ov.w = cvtpk(v[6], v[7]);
        *(uint4*)(mixrow0 + (size_t)row * DM + ch * 8) = ov;
    }
    asm volatile("s_waitcnt lgkmcnt(0)" ::: "memory");
}

__device__ __forceinline__ void unit_mla(unsigned char* ws, lds_ptr lds, int b, int h, int qb, int tid, int wave, int lane) {
    const int r32 = lane & 31, hi = lane >> 5; const int q0 = qb * 256, wrow0 = q0 + 32 * wave, qidx = wrow0 + r32; const size_t m0 = (size_t)b * SEQ;
    const bf16_t* MQ = (const bf16_t*)(ws + WS_MQ); const bf16_t* MKp = (const bf16_t*)(ws + WS_MK); const bf16_t* MV = (const bf16_t*)(ws + WS_MV); const bf16_t* ACT = (const bf16_t*)(ws + WS_ACT); bf16_t* MIX = (bf16_t*)(ws + WS_MIX);
    bf16x8 qr[6];
#pragma unroll
    for (int d0 = 0; d0 < 6; ++d0) qr[d0] = *(const bf16x8*)(MQ + (m0 + qidx) * 480 + h * 96 + d0 * 16 + hi * 8);
    KVSrc src{MKp + m0 * 480 + h * 96, MV + m0 * 320 + h * 64, 480, 320};
    f32x16 o[2]; float l;
    softmax_branch<MK_CAUSAL, 6, 12>(o, l, lds, src, qr, 0, (q0 + 255) >> 6, qidx, wrow0, 0ull, tid, wave, lane);
    l += partner(l);
    FA_LAS float* wsf = (FA_LAS float*)(lds + L_WSF) + wave * 64;
    f32x16 acc[2]; { f32x16 z = {}; acc[0] = z; acc[1] = z; }
    add_scaled(acc, o, 1.f / l, wsf, r32, hi);
    store_rows(acc, lds, wave, lane, MIX + (m0 + wrow0) * DM + 704 + h * 64, nullptr, 0, ACT + (m0 + wrow0) * ACTW + A_MZ + h * 64, ACTW);
}
__device__ __forceinline__ void unit_nsa(unsigned char* ws, lds_ptr lds, int b, int h, int qb, int tid, int wave, int lane) {
    const int r32 = lane & 31, hi = lane >> 5; const int q0 = qb * 256, wrow0 = q0 + 32 * wave, qidx = wrow0 + r32, g = h / 3; const size_t m0 = (size_t)b * SEQ;
    const bf16_t* ACT = (const bf16_t*)(ws + WS_ACT); const bf16_t* OC = (const bf16_t*)(ws + WS_OC); const u64* SEL = (const u64*)(ws + WS_SEL); bf16_t* MIX = (bf16_t*)(ws + WS_MIX);
    bf16x8 qr[4];
#pragma unroll
    for (int d0 = 0; d0 < 4; ++d0) qr[d0] = *(const bf16x8*)(ACT + (m0 + qidx) * ACTW + A_NQ + h * 64 + d0 * 16 + hi * 8);
    const u64 sel = SEL[(size_t)(b * 2 + g) * SEQ + qidx];
    const float gs = bf2f(ACT[(m0 + qidx) * ACTW + A_GATE + h * 3 + 1]), gw = bf2f(ACT[(m0 + qidx) * ACTW + A_GATE + h * 3 + 2]);
    FA_LAS float* wsf = (FA_LAS float*)(lds + L_WSF) + wave * 64;
    f32x16 acc[2]; { f32x16 z = {}; acc[0] = z; acc[1] = z; }
    {
        KVSrc src{ACT + m0 * ACTW + A_KS + g * 64, ACT + m0 * ACTW + A_VS + g * 64, ACTW, ACTW};
        f32x16 o[2]; float l;
        softmax_branch<MK_SEL, 4, 8>(o, l, lds, src, qr, 0, (q0 + 255) >> 6, qidx, wrow0, sel, tid, wave, lane);
        l += partner(l);
        add_scaled(acc, o, gs / l, wsf, r32, hi);
    }
    {
        KVSrc src{ACT + m0 * ACTW + A_KW + g * 64, ACT + m0 * ACTW + A_VW + g * 64, ACTW, ACTW};
        f32x16 o[2]; float l; const int tlo = (q0 >= 512) ? ((q0 - 512) >> 6) : 0;
        softmax_branch<MK_WIN, 4, 8>(o, l, lds, src, qr, tlo, (q0 + 255) >> 6, qidx, wrow0, 0ull, tid, wave, lane);
        l += partner(l);
        add_scaled(acc, o, gw / l, wsf, r32, hi);
    }
    store_rows(acc, lds, wave, lane, MIX + (m0 + wrow0) * DM + h * 64, OC + (m0 + wrow0) * 384 + h * 64, 384, ACT + (m0 + wrow0) * ACTW + A_NZ + h * 64, ACTW);
}

constexpr float SB_CUT = 104.0f;
__device__ __forceinline__ void unit_sb(unsigned char* ws, lds_ptr lds, int b, int h, int qb, int tid, int wave, int lane) {
    const int r32 = lane & 31, hi = lane >> 5; const int q0 = qb * 256, wrow0 = q0 + 32 * wave, qidx = wrow0 + r32; const size_t m0 = (size_t)b * SEQ;
    const bf16_t* ACT = (const bf16_t*)(ws + WS_ACT); bf16_t* MIX = (bf16_t*)(ws + WS_MIX);
    bf16x8 qr[4];
#pragma unroll
    for (int d0 = 0; d0 < 4; ++d0) qr[d0] = *(const bf16x8*)(ACT + (m0 + qidx) * ACTW + A_SQ + h * 64 + d0 * 16 + hi * 8);
    KVSrc src{ACT + m0 * ACTW + A_SK + h * 64, ACT + m0 * ACTW + A_SV + h * 64, ACTW, ACTW};
    FA_LAS unsigned* flags = (FA_LAS unsigned*)(lds + L_MISC) + 16;
    lds_cptr vlane = (lds_cptr)lds + VIMG + ((lane >> 4) & 1) * 32 + (lane & 3) * 8 + (4 * hi + ((lane & 15) >> 2)) * 64;
    f32x16 o[2]; { f32x16 z = {}; o[0] = z; o[1] = z; }
    float R = 0.f;
    const int t_hi = (q0 + 255) >> 6;
    StageRegs SR;
    stage_load<8>(SR, src, t_hi * 64, tid, wave, lane);
    stage_write<8>(SR, lds, tid, wave, lane);
    __syncthreads();
    for (int t = t_hi; t >= 0; --t) {
        const int it = t_hi - t, cur = it & 1; lds_ptr st = lds + cur * STAGE_B; lds_ptr stn = lds + (cur ^ 1) * STAGE_B;
        if (t > 0) stage_load<8>(SR, src, (t - 1) * 64, tid, wave, lane);
        const bool mydone = __all(R >= SB_CUT) != 0;
        const bool need = (64 * t < wrow0 + 31) && !mydone;
        if (need) {
            f32x16 p0, p1;
            qkt<4>(p0, p1, (lds_cptr)st + KIMG, qr, r32, hi);
            const bool diag = (64 * t + 63 >= wrow0);
            const int kb = 64 * t + 4 * hi;
            f32x16 s0, s1;
#pragma unroll
            for (int r = 0; r < 16; ++r) {
                const float z0 = p0[r], z1 = p1[r];
                float a0 = fmaxf(z0, 0.f) + 0.6931471805599453f * __log2f(1.f + ex2(-fabsf(z0) * LOG2E));
                float a1 = fmaxf(z1, 0.f) + 0.6931471805599453f * __log2f(1.f + ex2(-fabsf(z1) * LOG2E));
                if (diag) { const int kv = kb + (r & 3) + 8 * (r >> 2); if (kv >= qidx) a0 = 0.f; if (kv + 32 >= qidx) a1 = 0.f; }
                s0[r] = a0; s1[r] = a1;
            }
            float T[8];
#pragma unroll
            for (int i = 0; i < 4; ++i) {
                s0[4 * i + 2] += s0[4 * i + 3]; s0[4 * i + 1] += s0[4 * i + 2]; s0[4 * i] += s0[4 * i + 1]; T[i] = s0[4 * i];
                s1[4 * i + 2] += s1[4 * i + 3]; s1[4 * i + 1] += s1[4 * i + 2]; s1[4 * i] += s1[4 * i + 1]; T[4 + i] = s1[4 * i];
            }
            float TP[8];
#pragma unroll
            for (int i = 0; i < 8; ++i) TP[i] = partner(T[i]);
            float accS = R, suf[8];
#pragma unroll
            for (int i = 7; i >= 0; --i) { suf[i] = accS + (hi == 0 ? TP[i] : 0.f); accS += T[i] + TP[i]; }
            R = accS;
#pragma unroll
            for (int r = 0; r < 16; ++r) {
                float a0 = ex2((p0[r] - (s0[r] + suf[r >> 2])) * LOG2E), a1 = ex2((p1[r] - (s1[r] + suf[4 + (r >> 2)])) * LOG2E);
                if (diag) { const int kv = kb + (r & 3) + 8 * (r >> 2); if (kv >= qidx) a0 = 0.f; if (kv + 32 >= qidx) a1 = 0.f; }
                p0[r] = a0; p1[r] = a1;
            }
            u32x4 w0, w1, w2, w3;
            w0.x = cvtpk(p0[0], p0[1]); w0.y = cvtpk(p0[2], p0[3]); w0.z = cvtpk(p0[4], p0[5]); w0.w = cvtpk(p0[6], p0[7]);
            w1.x = cvtpk(p0[8], p0[9]); w1.y = cvtpk(p0[10], p0[11]); w1.z = cvtpk(p0[12], p0[13]); w1.w = cvtpk(p0[14], p0[15]);
            w2.x = cvtpk(p1[0], p1[1]); w2.y = cvtpk(p1[2], p1[3]); w2.z = cvtpk(p1[4], p1[5]); w2.w = cvtpk(p1[6], p1[7]);
            w3.x = cvtpk(p1[8], p1[9]); w3.y = cvtpk(p1[10], p1[11]); w3.z = cvtpk(p1[12], p1[13]); w3.w = cvtpk(p1[14], p1[15]);
            pv(o, vlane + cur * STAGE_B, w0, w1, w2, w3);
        }
        const bool fin = (__all(R >= SB_CUT) != 0) || (t == 0);
        if (lane == 0) flags[cur * 8 + wave] = fin ? 1u : 0u;
        if (t > 0) stage_write<8>(SR, stn, tid, wave, lane);
        __syncthreads();
        unsigned alld = 1u;
#pragma unroll
        for (int w = 0; w < 8; ++w) alld &= flags[cur * 8 + w];
        if (alld) break;
    }
    __syncthreads();
    f32x16 acc[2]; acc[0] = o[0]; acc[1] = o[1];
    store_rows(acc, lds, wave, lane, MIX + (m0 + wrow0) * DM + 384 + h * 64, nullptr, 0, ACT + (m0 + wrow0) * ACTW + A_SZ + h * 64, ACTW);
}

constexpr int N_HEAVY = 16 * 88, N_UNITS = N_HEAVY + 16 * 40;
__device__ __forceinline__ void attn_phase(unsigned char* ws, lds_ptr lds, unsigned* qctr, int tid, int wave, int lane) {
    FA_LAS int* ubox = (FA_LAS int*)(lds + L_MISC);
    for (;;) {
        if (tid == 0) ubox[0] = (int)atomicAdd(qctr, 1u);
        __syncthreads();
        const int u = ubox[0];
        __syncthreads();
        if (u >= N_UNITS) break;
        if (u < N_HEAVY) { const int qb = 15 - u / 88, r = u % 88;
            if (r < 48) unit_nsa(ws, lds, r / 6, r % 6, qb, tid, wave, lane);
            else unit_mla(ws, lds, (r - 48) / 5, (r - 48) % 5, qb, tid, wave, lane);
        } else { const int v = u - N_HEAVY; unit_sb(ws, lds, (v % 40) / 5, v % 5, 15 - v / 40, tid, wave, lane); }
        __syncthreads();
    }
}
}
constexpr int NWAVES = 8;
constexpr int RING_BYTES = 131072;
constexpr int LDSCTL_OFF = RING_BYTES, MISC_OFF = LDSCTL_OFF + 320;
constexpr int LDS_BYTES = 147456;
constexpr int CW_BAR = 4096;
constexpr size_t CTL_ZERO_BYTES = 256 * 1024;
constexpr int CW_Q = 1024;

constexpr int PH_PRO = 0, PH_L0 = 1, PH_PER_LAYER = 6, PH_FINAL = 1 + 2 * PH_PER_LAYER, PH_COUNT = PH_FINAL + 1;
constexpr int PK_NORM = 0, PK_INPROJ = 1, PK_P3 = 2, PK_P4 = 3, PK_ATTN = 4, PK_OUTPROJ = 5;

struct Args { const void* in[19]; float* out; unsigned char* ws; RopeInv inv; int ph_lo, ph_hi; };

__device__ __forceinline__ float wave_sum(float v) {
#pragma unroll
    for (int o = 1; o < 64; o <<= 1) v += __shfl_xor(v, o);
    return v;
}

__device__ __forceinline__ int rope_head_base(int pn, int hh) {
    if (pn == 0) return 64 * hh;
    if (pn == 1) return (hh < 2) ? 256 + 64 * hh : 384 + 64 * (hh - 2);
    return (hh < 2) ? 640 + 64 * hh : 896 + 64 * (hh - 2);
}
__device__ __forceinline__ void gen_group(int L, int& base, int& op) {
    if (L < 4) { base = 512 + 32 * L; op = 0; }
    else if (L < 8) { base = 768 + 32 * (L - 4); op = 0; }
    else if (L < 12) { base = 1024 + 32 * (L - 8); op = 0; }
    else if (L < 22) { base = 1536 + 32 * (L - 12); op = 2; }
    else if (L < 42) { base = 1856 + 32 * (L - 22); op = 0; }
    else if (L < 48) { base = 2816 + 32 * (L - 42); op = 0; }
    else if (L < 60) { base = 1152 + 32 * (L - 48); op = 1; }
    else if (L < 70) { base = 2496 + 32 * (L - 60); op = 1; }
    else { base = 3200 + 32 * (L - 70); op = 1; }
}
__device__ __forceinline__ int phys_to_act(int pn, int p) {
    if (pn < 3) { const int f = p >> 7, hh = (p >> 5) & 3, i = p & 31; return rope_head_base(pn, hh) + 32 * f + i; }
    if (pn < 13) { int base, op; gen_group((pn - 3) * 8 + (p >> 5), base, op); return base + (p & 31); }
    const int bj = p >> 7, q = p & 127;
    if (q < 64) return A_MCKV + 64 * bj + q;
    if (q < 80) return A_MKR + 16 * bj + (q - 64);
    if (q < 96) { const int gi = 16 * bj + (q - 80); return gi < 18 ? A_GATE + gi : -1; }
    return -1;
}

struct EpiInProj {
    static constexpr bool PERM = true, AFTER_DRAIN = false;
    bf16_t* ACT; const float* cs64; const float* cs32;
    __device__ __forceinline__ void operator()(const pg8::f32x4 (&acc)[2][2][4][2], const pg8::Unit& u, int wr, int wc, int fr, int fq) const {
        using pg8::cvt_pk_bf16; typedef pg8::u32x4 u32x4;
        const int pn = u.pn; const int row0 = u.pm * 256 + wr * 64 + fr;
        if (pn < 3) {
            const int hb = rope_head_base(pn, wc) + 8 * fq; const float sc = (pn == 0 || (pn == 1 && wc < 2)) ? QS_NSA : 1.f;
#pragma unroll
            for (int ai = 0; ai < 2; ++ai)
#pragma unroll
                for (int m = 0; m < 4; ++m) {
                    const int row = row0 + ai * 128 + m * 16;
                    const f32x4* cp = (const f32x4*)(cs64 + ((size_t)row * 32 + 8 * fq) * 2);
                    const f32x4 t0 = cp[0], t1 = cp[1], t2 = cp[2], t3 = cp[3];
                    const f32x4 a0 = acc[ai][0][m][0], a1 = acc[ai][0][m][1], b0 = acc[ai][1][m][0], b1 = acc[ai][1][m][1];
                    float o1[8], o2[8];
                    o1[0] = a0[0] * t0[0] - b0[0] * t0[1]; o2[0] = b0[0] * t0[0] + a0[0] * t0[1];
                    o1[1] = a0[1] * t0[2] - b0[1] * t0[3]; o2[1] = b0[1] * t0[2] + a0[1] * t0[3];
                    o1[2] = a0[2] * t1[0] - b0[2] * t1[1]; o2[2] = b0[2] * t1[0] + a0[2] * t1[1];
                    o1[3] = a0[3] * t1[2] - b0[3] * t1[3]; o2[3] = b0[3] * t1[2] + a0[3] * t1[3];
                    o1[4] = a1[0] * t2[0] - b1[0] * t2[1]; o2[4] = b1[0] * t2[0] + a1[0] * t2[1];
                    o1[5] = a1[1] * t2[2] - b1[1] * t2[3]; o2[5] = b1[1] * t2[2] + a1[1] * t2[3];
                    o1[6] = a1[2] * t3[0] - b1[2] * t3[1]; o2[6] = b1[2] * t3[0] + a1[2] * t3[1];
                    o1[7] = a1[3] * t3[2] - b1[3] * t3[3]; o2[7] = b1[3] * t3[2] + a1[3] * t3[3];
                    u32x4 w1, w2;
                    w1.x = cvt_pk_bf16(o1[0] * sc, o1[1] * sc); w1.y = cvt_pk_bf16(o1[2] * sc, o1[3] * sc); w1.z = cvt_pk_bf16(o1[4] * sc, o1[5] * sc); w1.w = cvt_pk_bf16(o1[6] * sc, o1[7] * sc);
                    w2.x = cvt_pk_bf16(o2[0] * sc, o2[1] * sc); w2.y = cvt_pk_bf16(o2[2] * sc, o2[3] * sc); w2.z = cvt_pk_bf16(o2[4] * sc, o2[5] * sc); w2.w = cvt_pk_bf16(o2[6] * sc, o2[7] * sc);
                    bf16_t* rp = ACT + (size_t)row * ACTW + hb;
                    *(u32x4*)rp = w1; *(u32x4*)(rp + 32) = w2;
                }
        } else if (pn < 13) {
#pragma unroll
            for (int bj = 0; bj < 2; ++bj) {
                int base, op; gen_group((pn - 3) * 8 + bj * 4 + wc, base, op);
#pragma unroll
                for (int ai = 0; ai < 2; ++ai)
#pragma unroll
                    for (int m = 0; m < 4; ++m) {
                        const int row = row0 + ai * 128 + m * 16;
                        f32x4 v0 = acc[ai][bj][m][0], v1 = acc[ai][bj][m][1];
                        if (op == 1) {
#pragma unroll
                            for (int e = 0; e < 4; ++e) { v0[e] = silu_f(v0[e]); v1[e] = silu_f(v1[e]); }
                        } else if (op == 2) { v0 = v0 * 0.125f; v1 = v1 * 0.125f; }
                        u32x4 w; w.x = cvt_pk_bf16(v0[0], v0[1]); w.y = cvt_pk_bf16(v0[2], v0[3]); w.z = cvt_pk_bf16(v1[0], v1[1]); w.w = cvt_pk_bf16(v1[2], v1[3]);
                        *(u32x4*)(ACT + (size_t)row * ACTW + base + 8 * fq) = w;
                    }
            }
        } else {
            if (wc < 2) {
#pragma unroll
                for (int bj = 0; bj < 2; ++bj)
#pragma unroll
                    for (int ai = 0; ai < 2; ++ai)
#pragma unroll
                        for (int m = 0; m < 4; ++m) {
                            const int row = row0 + ai * 128 + m * 16;
                            const f32x4 v0 = acc[ai][bj][m][0], v1 = acc[ai][bj][m][1];
                            u32x4 w; w.x = cvt_pk_bf16(v0[0], v0[1]); w.y = cvt_pk_bf16(v0[2], v0[3]); w.z = cvt_pk_bf16(v1[0], v1[1]); w.w = cvt_pk_bf16(v1[2], v1[3]);
                            *(u32x4*)(ACT + (size_t)row * ACTW + A_MCKV + 64 * bj + 32 * wc + 8 * fq) = w;
                        }
            } else if (wc == 2) {
#pragma unroll
                for (int ai = 0; ai < 2; ++ai)
#pragma unroll
                    for (int m = 0; m < 4; ++m) {
                        const int row = row0 + ai * 128 + m * 16;
                        const f32x4 a0 = acc[ai][0][m][0], a1 = acc[ai][0][m][1], b0 = acc[ai][1][m][0], b1 = acc[ai][1][m][1];
                        if (fq < 2) {
                            const f32x4* cp = (const f32x4*)(cs32 + ((size_t)row * 16 + 8 * fq) * 2);
                            const f32x4 t0 = cp[0], t1 = cp[1], t2 = cp[2], t3 = cp[3];
                            float o1[8], o2[8];
                            o1[0] = a0[0] * t0[0] - b0[0] * t0[1]; o2[0] = b0[0] * t0[0] + a0[0] * t0[1];
                            o1[1] = a0[1] * t0[2] - b0[1] * t0[3]; o2[1] = b0[1] * t0[2] + a0[1] * t0[3];
                            o1[2] = a0[2] * t1[0] - b0[2] * t1[1]; o2[2] = b0[2] * t1[0] + a0[2] * t1[1];
                            o1[3] = a0[3] * t1[2] - b0[3] * t1[3]; o2[3] = b0[3] * t1[2] + a0[3] * t1[3];
                            o1[4] = a1[0] * t2[0] - b1[0] * t2[1]; o2[4] = b1[0] * t2[0] + a1[0] * t2[1];
                            o1[5] = a1[1] * t2[2] - b1[1] * t2[3]; o2[5] = b1[1] * t2[2] + a1[1] * t2[3];
                            o1[6] = a1[2] * t3[0] - b1[2] * t3[1]; o2[6] = b1[2] * t3[0] + a1[2] * t3[1];
                            o1[7] = a1[3] * t3[2] - b1[3] * t3[3]; o2[7] = b1[3] * t3[2] + a1[3] * t3[3];
                            u32x4 w1, w2;
                            w1.x = cvt_pk_bf16(o1[0], o1[1]); w1.y = cvt_pk_bf16(o1[2], o1[3]); w1.z = cvt_pk_bf16(o1[4], o1[5]); w1.w = cvt_pk_bf16(o1[6], o1[7]);
                            w2.x = cvt_pk_bf16(o2[0], o2[1]); w2.y = cvt_pk_bf16(o2[2], o2[3]); w2.z = cvt_pk_bf16(o2[4], o2[5]); w2.w = cvt_pk_bf16(o2[6], o2[7]);
                            bf16_t* rp = ACT + (size_t)row * ACTW + A_MKR + 8 * fq;
                            *(u32x4*)rp = w1; *(u32x4*)(rp + 16) = w2;
                        } else {
                            const int g0 = 8 * (fq - 2);
                            float ga[8], gb[8];
#pragma unroll
                            for (int e = 0; e < 4; ++e) { ga[e] = a0[e]; ga[4 + e] = a1[e]; gb[e] = b0[e]; gb[4 + e] = b1[e]; }
#pragma unroll
                            for (int e = 0; e < 8; ++e) { ga[e] = (g0 + e < 18) ? sigm_f(ga[e]) : 0.f; gb[e] = (16 + g0 + e < 18) ? sigm_f(gb[e]) : 0.f; }
                            u32x4 w1, w2;
                            w1.x = cvt_pk_bf16(ga[0], ga[1]); w1.y = cvt_pk_bf16(ga[2], ga[3]); w1.z = cvt_pk_bf16(ga[4], ga[5]); w1.w = cvt_pk_bf16(ga[6], ga[7]);
                            w2.x = cvt_pk_bf16(gb[0], gb[1]); w2.y = cvt_pk_bf16(gb[2], gb[3]); w2.z = cvt_pk_bf16(gb[4], gb[5]); w2.w = cvt_pk_bf16(gb[6], gb[7]);
                            bf16_t* rp = ACT + (size_t)row * ACTW + A_GATE + g0;
                            *(u32x4*)rp = w1; *(u32x4*)(rp + 16) = w2;
                        }
                    }
            }
        }
    }
};

struct EpiOutProj {
    static constexpr bool PERM = false, AFTER_DRAIN = false;
    const float* xin; float* xout; const float* gate;
    __device__ __forceinline__ void operator()(const pg8::f32x4 (&acc)[2][2][4][2], const pg8::Unit& u, int wr, int wc, int fr, int fq) const {
        const int col0 = u.pn * 256 + wc * 32 + 4 * fq;
#pragma unroll
        for (int ai = 0; ai < 2; ++ai)
#pragma unroll
            for (int m = 0; m < 4; ++m) {
                const int row = u.pm * 256 + ai * 128 + wr * 64 + m * 16 + fr; const int b = row / SEQ;
                const size_t off = (size_t)row * DM + col0; const float* gp = gate + (size_t)b * 3072 + col0;
#pragma unroll
                for (int bj = 0; bj < 2; ++bj)
#pragma unroll
                    for (int n = 0; n < 2; ++n) {
                        const f32x4 g4 = *(const f32x4*)(gp + bj * 128 + n * 16); const f32x4 xi = *(const f32x4*)(xin + off + bj * 128 + n * 16);
                        *(f32x4*)(xout + off + bj * 128 + n * 16) = xi + g4 * acc[ai][bj][m][n];
                    }
            }
    }
};

__device__ __forceinline__ void tr_item(const float* W, int ldw, int srccol, bf16_t* WT, int K, int wt_row0, int k0, LAS float* scr, int lane) {
#pragma unroll 8
    for (int i = 0; i < 32; ++i) { const int kk = 2 * i + (lane >> 5); scr[kk * 33 + (lane & 31)] = (srccol >= 0) ? W[(size_t)(k0 + kk) * ldw + srccol] : 0.f; }
    LDS_WAIT(); asm volatile("" ::: "memory");
    const int c = lane & 7;
#pragma unroll
    for (int j = 0; j < 4; ++j) { const int n = (lane >> 3) + 8 * j; const LAS float* s = scr + (8 * c) * 33 + n;
        v4u o; o.x = pk2(s[0 * 33], s[1 * 33]); o.y = pk2(s[2 * 33], s[3 * 33]); o.z = pk2(s[4 * 33], s[5 * 33]); o.w = pk2(s[6 * 33], s[7 * 33]);
        *(v4u*)(WT + (size_t)(wt_row0 + n) * K + k0 + 8 * c) = o; }
    LDS_WAIT(); asm volatile("" ::: "memory");
}

struct MK {
    LAS unsigned char* lds; int tid, lane, wave, G, bid; float* out; unsigned char* ws;
};
#define ARGF(A, i) ((const float*)(A).in[i])

__device__ __forceinline__ void ph_prologue(MK& F, const Args& A) {
    const RopeInv& inv = A.inv;
    float* mod = (float*)(F.ws + WS_MOD);
    {
        LAS float* red = (LAS float*)F.lds;
        for (int item = F.bid; item < DEPTH * 48; item += F.G) {
            const int l = item / 48, col = (item % 48) * 64 + F.lane;
            float acc[NB];
#pragma unroll
            for (int b = 0; b < NB; ++b) acc[b] = 0.f;
            const float* cvec = ARGF(A, 1); const float* adab = ARGF(A, 4);
            const float* wp = ARGF(A, 3) + ((size_t)l * DM + F.wave * 128) * 3072 + col;
            for (int k = 0; k < 128; ++k) { const float w = wp[(size_t)k * 3072];
#pragma unroll
                for (int b = 0; b < NB; ++b) { const float cv = cvec[b * DM + F.wave * 128 + k]; acc[b] += silu_f(cv) * w; } }
#pragma unroll
            for (int b = 0; b < NB; ++b) red[(F.wave * NB + b) * 64 + F.lane] = acc[b];
            __syncthreads();
            { const int b = F.tid >> 6; float s = adab[l * 3072 + col];
#pragma unroll
              for (int w = 0; w < 8; ++w) s += red[(w * NB + b) * 64 + F.lane];
              mod[((size_t)l * NB + b) * 3072 + col] = s; }
            __syncthreads();
        }
    }
    const int gw = F.bid * NWAVES + F.wave, NGW = F.G * NWAVES;
    {
        LAS float* scr = (LAS float*)(F.lds + F.wave * 16384);
        bf16_t* WIN_T = (bf16_t*)(F.ws + WS_WIN_T); bf16_t* WOUT_T = (bf16_t*)(F.ws + WS_WOUT_T);
        constexpr int I_IN = 16 * 112, I_OUT = 16 * 32, NIT = DEPTH * (I_IN + I_OUT);
        for (int it = gw; it < NIT; it += NGW) {
            int r = it; const int l = r / (I_IN + I_OUT); r -= l * (I_IN + I_OUT);
            if (r < I_IN) { const int kb = r / 112, nb = r % 112; const int prow = nb * 32 + (F.lane & 31); const int act = phys_to_act(prow >> 8, prow & 255); const int src = (act < 0) ? -1 : inproj_src_col(act);
                tr_item(ARGF(A, 6) + (size_t)l * DM * D_IN, D_IN, src, WIN_T + (size_t)l * 3584 * DM, DM, nb * 32, kb * 64, scr, F.lane); }
            else { r -= I_IN; const int kb = r / 32, nb = r % 32;
                tr_item(ARGF(A, 17) + (size_t)l * DM * DM, DM, nb * 32 + (F.lane & 31), WOUT_T + (size_t)l * DM * DM, DM, nb * 32, kb * 64, scr, F.lane); }
        }
    }
    {
        float* cs64 = (float*)(F.ws + WS_CS64); float* cs32 = (float*)(F.ws + WS_CS32);
        for (int idx = F.bid * 512 + F.tid; idx < M * 48; idx += F.G * 512) {
            const int m = idx / 48, i = idx % 48; const float p = (float)((const int*)A.in[2])[m]; float s, c;
            if (i < 32) { sincos_rev(p * inv.i64[i], s, c); *(float2*)(cs64 + ((size_t)m * 32 + i) * 2) = make_float2(c, s); }
            else { const int j = i - 32; sincos_rev(p * inv.i32[j], s, c); *(float2*)(cs32 + ((size_t)m * 16 + j) * 2) = make_float2(c, s); }
        }
    }
}

__device__ __forceinline__ void ph_norm_mod(MK& F, const Args& A, const float* xin, int l) {
    const float* g = ARGF(A, 5) + l * DM; const float* mod = (const float*)(F.ws + WS_MOD) + (size_t)l * NB * 3072; bf16_t* H = (bf16_t*)(F.ws + WS_H);
    const int gw = F.bid * NWAVES + F.wave, NGW = F.G * NWAVES;
    for (int row = gw; row < M; row += NGW) {
        const int b = row / SEQ; const f32x4* xr = (const f32x4*)(xin + (size_t)row * DM) + F.lane; f32x4 v[4]; float ss = 0.f;
#pragma unroll
        for (int j = 0; j < 4; ++j) { v[j] = xr[64 * j]; ss += (v[j].x * v[j].x + v[j].y * v[j].y) + (v[j].z * v[j].z + v[j].w * v[j].w); }
        const float r = rsqrtf(wave_sum(ss) * (1.f / DM) + 1e-6f);
        const float* sh = mod + (size_t)b * 3072; const float* sc = sh + 1024;
#pragma unroll
        for (int j = 0; j < 4; ++j) { const int c = 256 * j + 4 * F.lane; const f32x4 g4 = *(const f32x4*)(g + c), s4 = *(const f32x4*)(sc + c), h4 = *(const f32x4*)(sh + c);
            const f32x4 h = v[j] * r * g4 * (s4 + 1.f) + h4;
            uint2 o; o.x = pk2(h.x, h.y); o.y = pk2(h.z, h.w); *(uint2*)(H + (size_t)row * DM + c) = o; }
    }
}
__device__ __forceinline__ void ph_final_norm(MK& F, const Args& A) {
    const float* fnorm = ARGF(A, 18);
    const int gw = F.bid * NWAVES + F.wave, NGW = F.G * NWAVES;
    for (int row = gw; row < M; row += NGW) {
        f32x4* xr = (f32x4*)(F.out + (size_t)row * DM) + F.lane; f32x4 v[4]; float ss = 0.f;
#pragma unroll
        for (int j = 0; j < 4; ++j) { v[j] = xr[64 * j]; ss += (v[j].x * v[j].x + v[j].y * v[j].y) + (v[j].z * v[j].z + v[j].w * v[j].w); }
        const float r = rsqrtf(wave_sum(ss) * (1.f / DM) + 1e-6f);
#pragma unroll
        for (int j = 0; j < 4; ++j) { const f32x4 g4 = *(const f32x4*)(fnorm + 256 * j + 4 * F.lane); xr[64 * j] = v[j] * r * g4; }
    }
}

__global__ void __launch_bounds__(NWAVES * 64, 2) mk_fwd(Args args) {
    extern __shared__ __attribute__((aligned(16))) unsigned char lds[];
    MK F;
    F.lds = (LAS unsigned char*)lds; F.tid = threadIdx.x; F.lane = F.tid & 63; F.wave = __builtin_amdgcn_readfirstlane(F.tid >> 6); F.G = gridDim.x; F.bid = blockIdx.x;
    F.out = args.out; F.ws = args.ws;
    for (int u = F.tid; u < (LDS_BYTES - LDSCTL_OFF) / 4; u += NWAVES * 64) ((LAS unsigned*)(F.lds + LDSCTL_OFF))[u] = 0u;
    __syncthreads();
    cooperative_groups::grid_group grid = cooperative_groups::this_grid();
    const int lo = args.ph_lo, hi = args.ph_hi;
    for (int ph = lo; ph < hi; ++ph) {
        { int bid_ = blockIdx.x; asm volatile("" : "+s"(bid_)); F.bid = bid_; int t_ = threadIdx.x; asm volatile("" : "+v"(t_)); F.tid = t_; F.lane = t_ & 63; F.wave = __builtin_amdgcn_readfirstlane(t_ >> 6); }
        if (ph == PH_PRO) ph_prologue(F, args);
        else if (ph == PH_FINAL) ph_final_norm(F, args);
        else {
            const int l = (ph - PH_L0) / PH_PER_LAYER, k = (ph - PH_L0) % PH_PER_LAYER;
            const float* xin = (l == 0) ? ARGF(args, 0) : F.out;
            if (k == PK_NORM) ph_norm_mod(F, args, xin, l);
            else if (k == PK_INPROJ) {
                pg8::Gemm g = pg8::make_gemm((const bf16_t*)(F.ws + WS_H), DM, (const bf16_t*)(F.ws + WS_WIN_T) + (size_t)l * 3584 * DM, DM, M, 3584, DM);
                pg8::StaticOrder S; S.init(M, 3584, F.G, F.bid);
                EpiInProj E{(bf16_t*)(F.ws + WS_ACT), (const float*)(F.ws + WS_CS64), (const float*)(F.ws + WS_CS32)};
                pg8::gemm_phase<EpiInProj, pg8::StaticOrder, true, true>(F.lds, g, S, E);
            } else if (k == PK_ATTN) {
                fa::attn_phase(F.ws, (fa::lds_ptr)F.lds, (unsigned*)(F.ws + WS_CTL) + CW_Q + 64 * l, F.tid, F.wave, F.lane);
            } else if (k == PK_OUTPROJ) {
                pg8::Gemm g = pg8::make_gemm((const bf16_t*)(F.ws + WS_MIX), DM, (const bf16_t*)(F.ws + WS_WOUT_T) + (size_t)l * DM * DM, DM, M, DM, DM);
                pg8::StaticOrder S; S.init(M, DM, F.G, F.bid);
                EpiOutProj E{xin, F.out, (const float*)(F.ws + WS_MOD) + (size_t)l * NB * 3072 + 2048};
                pg8::gemm_phase<EpiOutProj, pg8::StaticOrder, true, true>(F.lds, g, S, E);
            }
        }
        if (ph + 1 < hi) grid.sync();
    }
}
static int g_grid = 0;
static void launch_mk(Args a, int lo, int hi, hipStream_t stream) {
    a.ph_lo = lo; a.ph_hi = hi;
    if (hi - lo > 1) { void* params[] = {&a}; hipLaunchCooperativeKernel((const void*)mk_fwd, dim3(g_grid), dim3(NWAVES * 64), params, LDS_BYTES, stream); }
    else hipLaunchKernelGGL(mk_fwd, dim3(g_grid), dim3(NWAVES * 64), LDS_BYTES, stream, a);
}
extern "C" void kernel_launch(void* const* d_in, const int* in_sizes, int n_in, void* d_out, int out_size, void* d_ws, size_t ws_size, hipStream_t stream) {
    if (n_in != 19 || out_size != M * DM || ws_size < WS_END) { fprintf(stderr, "kernel_launch: unexpected shapes (n_in %d out %d ws %zu)\n", n_in, out_size, ws_size); return; }
    if (g_grid == 0) {
        int dev = 0, cus = 0, per_cu = 0;
        hipGetDevice(&dev); hipDeviceGetAttribute(&cus, hipDeviceAttributeMultiprocessorCount, dev);
        hipFuncSetAttribute((const void*)mk_fwd, hipFuncAttributeMaxDynamicSharedMemorySize, LDS_BYTES);
        hipOccupancyMaxActiveBlocksPerMultiprocessor(&per_cu, (const void*)mk_fwd, NWAVES * 64, LDS_BYTES);
        if (per_cu < 1) { fprintf(stderr, "kernel_launch: occupancy query says %d blocks per CU\n", per_cu); per_cu = 1; }
        g_grid = cus;
        (void)hipGetLastError();
    }
    const float* c = (const float*)d_in[1];
    const float* pos_k = (const float*)d_in[7]; const float* pos_v = (const float*)d_in[8];
    const float* ck_w1 = (const float*)d_in[9]; const float* ck_w2 = (const float*)d_in[10]; const float* cv_w1 = (const float*)d_in[11]; const float* cv_w2 = (const float*)d_in[12];
    const float* qn = (const float*)d_in[13]; const float* wuq = (const float*)d_in[14]; const float* kvn = (const float*)d_in[15]; const float* wukv = (const float*)d_in[16];
    char* ws = (char*)d_ws; (void)c;
    float* cs32 = (float*)(ws + WS_CS32); float* posb = (float*)(ws + WS_POSB); float* HID = (float*)(ws + WS_HID);
    bf16_t* MIX = (bf16_t*)(ws + WS_MIX); bf16_t* ACT = (bf16_t*)(ws + WS_ACT);
    bf16_t* MQ = (bf16_t*)(ws + WS_MQ); bf16_t* MK_ = (bf16_t*)(ws + WS_MK); bf16_t* MV = (bf16_t*)(ws + WS_MV); bf16_t* OC = (bf16_t*)(ws + WS_OC);
    bf16_t* KC = (bf16_t*)(ws + WS_KC); bf16_t* VC = (bf16_t*)(ws + WS_VC); u64* SEL = (u64*)(ws + WS_SEL);
    Args a{};
    for (int i = 0; i < 19; ++i) a.in[i] = d_in[i];
    a.out = (float*)d_out; a.ws = (unsigned char*)d_ws;
    for (int i = 0; i < 32; ++i) a.inv.i64[i] = (float)std::pow(10000.0, -(double)i / 32.0);
    for (int i = 0; i < 16; ++i) a.inv.i32[i] = (float)std::pow(10000.0, -(double)i / 16.0);
    hipMemsetAsync(ws + WS_CTL, 0, CTL_ZERO_BYTES, stream);

    launch_mk(a, PH_PRO, PH_PRO + 1, stream);
    nv_prep_posb<<<2, 256, 0, stream>>>(pos_k, pos_v, ck_w1, cv_w1, posb);
    for (int l = 0; l < DEPTH; ++l) {
        const int p0 = PH_L0 + l * PH_PER_LAYER;
        launch_mk(a, p0 + PK_NORM, p0 + PK_NORM + 1, stream);
        launch_mk(a, p0 + PK_INPROJ, p0 + PK_INPROJ + 1, stream);
        nv_mla_up<<<M, 256, 0, stream>>>(ACT, qn + l * 192, wuq + (size_t)l * 192 * 480, kvn + l * 128, wukv + (size_t)l * 128 * 640, MQ, MK_, MV);
        nv_mla_qrope<<<(M * 80 + 255) / 256, 256, 0, stream>>>(MQ, cs32);
        nv_cmp_hidden<<<dim3(NCMP, 16, 2), 128, 0, stream>>>(ACT, ck_w1 + (size_t)l * 2048 * 128, cv_w1 + (size_t)l * 2048 * 128, posb + l * 256, HID);
        nv_cmp_out<<<dim3(256, 16, 2), 64, 0, stream>>>(HID, ck_w2 + (size_t)l * 128 * 64, cv_w2 + (size_t)l * 128 * 64, KC, VC);
        nv_nsa_cmp<<<dim3(64, 16), 64, 0, stream>>>(ACT, KC, VC, OC, SEL);
        launch_mk(a, p0 + PK_ATTN, p0 + PK_ATTN + 1, stream);
        launch_mk(a, p0 + PK_OUTPROJ, p0 + PK_OUTPROJ + 1, stream);
    }
    launch_mk(a, PH_FINAL, PH_FINAL + 1, stream);
}
```

```cpp
#include <hip/hip_runtime.h>
#include <cstdio>
#include <cstdint>
#include <cmath>
#include <hip/hip_cooperative_groups.h>

typedef unsigned short bf16_t;
typedef unsigned long long u64;

constexpr int NB = 8, SEQ = 4096, DM = 1024, M = NB * SEQ, DEPTH = 2;
constexpr int D_IN = 3506;
constexpr int NCMP = 255;
constexpr int ACTW = 3584;
constexpr int A_NQ = 0, A_KC = 384, A_VC = 512, A_KS = 640, A_VS = 768, A_KW = 896, A_VW = 1024;
constexpr int A_NZ = 1152, A_SQ = 1536, A_SK = 1856, A_SV = 2176, A_SZ = 2496;
constexpr int A_MCQ = 2816, A_MCKV = 3008, A_MKR = 3136, A_GATE = 3168, A_MZ = 3200;
constexpr float LOG2E = 1.4426950408889634f;
constexpr float QS_NSA = 0.125f * LOG2E;
constexpr float QS_MLA = 0.10206207261596577f * LOG2E;

constexpr size_t MiB = 1u << 20;
constexpr size_t WS_CTL = 0;
constexpr size_t WS_MOD = 1 * MiB;
constexpr size_t WS_CS64 = 2 * MiB;
constexpr size_t WS_CS32 = 10 * MiB;
constexpr size_t WS_POSB = 14 * MiB;
constexpr size_t WS_POSBP = 14 * MiB + 512 * 1024;
constexpr size_t WS_HID = 15 * MiB;
constexpr size_t WS_WIN_T = 20 * MiB;
constexpr size_t WS_WOUT_T = 34 * MiB;
constexpr size_t WS_WUQ_T = 38 * MiB;
constexpr size_t WS_WUKV_T = 39 * MiB;
constexpr size_t WS_W1T = 40 * MiB;
constexpr size_t WS_W2T = 42 * MiB;
constexpr size_t WS_SSQP = 44 * MiB;
constexpr size_t WS_H = 64 * MiB;
constexpr size_t WS_MIX = 64 * MiB;
constexpr size_t WS_ACT = 128 * MiB;
constexpr size_t WS_MQ = 352 * MiB;
constexpr size_t WS_MK = 382 * MiB;
constexpr size_t WS_MV = 412 * MiB;
constexpr size_t WS_OC = 432 * MiB;
constexpr size_t WS_KC = 456 * MiB;
constexpr size_t WS_VC = 457 * MiB;
constexpr size_t WS_SEL = 458 * MiB;
constexpr size_t WS_END = 460 * MiB;

__device__ __forceinline__ float bf2f(bf16_t v) { return __uint_as_float(((unsigned)v) << 16); }
__device__ __forceinline__ bf16_t f2bf(float f) { unsigned u = __float_as_uint(f); return (bf16_t)((u + 0x7fffu + ((u >> 16) & 1u)) >> 16); }
__device__ __forceinline__ float blo(unsigned u) { return __uint_as_float(u << 16); }
__device__ __forceinline__ float bhi(unsigned u) { return __uint_as_float(u & 0xffff0000u); }
__device__ __forceinline__ float silu_f(float v) { return v / (1.f + __expf(-v)); }
__device__ __forceinline__ float sigm_f(float v) { return 1.f / (1.f + __expf(-v)); }

struct RopeInv { float i64[32]; float i32[16]; };


#define GAS __attribute__((address_space(1)))
#define LAS __attribute__((address_space(3)))
typedef unsigned v4u __attribute__((ext_vector_type(4)));
typedef float f32x4 __attribute__((ext_vector_type(4)));
#define RLX_AGENT __ATOMIC_RELAXED, __HIP_MEMORY_SCOPE_AGENT
#define LDS_WAIT() asm volatile("s_waitcnt lgkmcnt(0)" ::: "memory")
#define VM_WAIT() asm volatile("s_waitcnt vmcnt(0)" ::: "memory")
__device__ __forceinline__ unsigned pk2(float lo, float hi) { return (unsigned)f2bf(lo) | ((unsigned)f2bf(hi) << 16); }

template <int MASK> __device__ __forceinline__ float xs_f(float v) { return __int_as_float(__builtin_amdgcn_ds_swizzle(__float_as_int(v), (MASK << 10) | 0x1f)); }
template <int MASK> __device__ __forceinline__ int xs_i(int v) { return __builtin_amdgcn_ds_swizzle(v, (MASK << 10) | 0x1f); }
__device__ __forceinline__ float psum32(float v) { auto rr = __builtin_amdgcn_permlane32_swap(__float_as_uint(v), __float_as_uint(v), false, false); return __uint_as_float(rr[0]) + __uint_as_float(rr[1]); }
__device__ __forceinline__ float pmax32(float v) { auto rr = __builtin_amdgcn_permlane32_swap(__float_as_uint(v), __float_as_uint(v), false, false); return fmaxf(__uint_as_float(rr[0]), __uint_as_float(rr[1])); }
__device__ __forceinline__ float pxchg32(float v, int hi) { auto rr = __builtin_amdgcn_permlane32_swap(__float_as_uint(v), __float_as_uint(v), false, false); return hi ? __uint_as_float(rr[0]) : __uint_as_float(rr[1]); }
namespace pg8 {
#define PG8_LAS __attribute__((address_space(3)))
typedef short bf16x8 __attribute__((ext_vector_type(8)));
typedef float f32x4 __attribute__((ext_vector_type(4)));
typedef unsigned u32x4 __attribute__((ext_vector_type(4)));
constexpr int BM = 256, BK = 64, HALF = 128, HTB = HALF * BK * 2  , STAGE_BYTES = 8 * HTB, NXCD = 8, WGM = 8;

__host__ __device__ __forceinline__ int lds_byte(int r, int c) { const int st = (r >> 4) * 2 + (c >> 5), rr = r & 15, cc = c & 31, ob = rr * 64 + cc * 2; return st * 1024 + (ob ^ (((ob >> 9) & 1) << 5)); }
__host__ __device__ __forceinline__ void stage_rc(int b, int& R, int& C) { const int st = b / 1024, sb = b % 1024, swz = sb ^ (((sb >> 9) & 1) << 5); R = (st >> 1) * 16 + swz / 64; C = (st & 1) * 32 + (swz % 64) / 2; }
__host__ __device__ __forceinline__ int perm32(int rho) { const int n = rho >> 4, i = rho & 15; return 8 * (i >> 2) + 4 * n + (i & 3); }

struct Unit { int pm, pn; };
struct Gemm { const bf16_t* A; const bf16_t* Bt; int lda, ldb, kstepA; size_t a_ts_hi, a_ts_lo; int M, N, K;
    __device__ __forceinline__ size_t a_off(int pm) const { return (size_t)(pm >> 1) * a_ts_hi + (size_t)(pm & 1) * a_ts_lo; } };
__host__ __device__ inline Gemm make_gemm(const bf16_t* A, int lda, const bf16_t* Bt, int ldb, int M, int N, int K) {
    Gemm g; g.A = A; g.Bt = Bt; g.lda = lda; g.ldb = ldb; g.kstepA = BK; g.a_ts_hi = (size_t)512 * lda * 2; g.a_ts_lo = (size_t)256 * lda * 2; g.M = M; g.N = N; g.K = K; return g; }

struct StaticOrder {
    int nM, nN, nwg, G, c;
    __host__ __device__ void init(int M, int N, int G_, int c_) { nM = M / BM; nN = N / BM; nwg = nM * nN; G = G_; c = c_; }
    __host__ __device__ bool next(int i, Unit& u) const {
        const long L = (long)i * G + c; if (L >= nwg) return false;
        int wgid = (int)L; { const int q = nwg / NXCD, r = nwg % NXCD, xcd = wgid % NXCD, off = wgid / NXCD; wgid = (xcd < r ? xcd * (q + 1) : r * (q + 1) + (xcd - r) * q) + off; }
        const int nig = WGM * nN, gid = wgid / nig, fm = gid * WGM, gsz = (nM - fm) < WGM ? (nM - fm) : WGM;
        u.pm = fm + ((wgid % nig) % gsz); u.pn = (wgid % nig) / gsz; return true;
    }
    __device__ __forceinline__ void a_ready(const Unit&) const {}
    __device__ __forceinline__ void done(const Unit&) const {}
};
__device__ __forceinline__ unsigned cvt_pk_bf16(float lo, float hi) { unsigned r; asm volatile("v_cvt_pk_bf16_f32 %0, %1, %2" : "=v"(r) : "v"(lo), "v"(hi)); return r; }

template <class Epi, class Sched, bool ALIGN_EPI = false, bool SP2 = false>
__device__ __forceinline__ void gemm_phase(PG8_LAS unsigned char* lds, const Gemm g, const Sched& S, const Epi& E, int tid_in) {
    int tid_ = tid_in; asm volatile("" : "+v"(tid_));
    const int tid = tid_, wid = __builtin_amdgcn_readfirstlane(tid >> 6), lane = tid & 63, wr = wid >> 2, wc = wid & 3, fr = lane & 15, fq = lane >> 4;
    const int K = g.K, nt = K / BK;
    unsigned voffA[2], voffB[2];
#pragma unroll
    for (int i = 0; i < 2; ++i) { int R, C; stage_rc(tid * 16 + i * 8192, R, C); const int Rb = Epi::PERM ? ((R & ~31) + perm32(R & 31)) : R;
        voffA[i] = (unsigned)(R * g.lda + C) * 2u; voffB[i] = (unsigned)(Rb * g.ldb + C) * 2u; }
    const size_t kstepA = (size_t)g.kstepA * 2, kstepB = (size_t)(BK * 2);
    const size_t hstepA = (size_t)HALF * g.lda * 2, hstepB = (size_t)HALF * g.ldb * 2;
    const size_t tstepB = 2 * hstepB;
    const unsigned ldsw = (unsigned)wid * 1024u;
    const int aoff = lds_byte(wr * 64 + fr, fq * 8), boff = lds_byte(wc * 32 + fr, fq * 8);
#define PG8_SA(b, h) (((b) * 2 + (h)) * HTB)
#define PG8_SB(b, h) ((4 + (b) * 2 + (h)) * HTB)
#define PG8_STAGE(bufoff, gbase, voff) do { _Pragma("unroll") for (int _i = 0; _i < 2; ++_i) \
        __builtin_amdgcn_global_load_lds((const unsigned*)((const char*)(gbase) + (voff)[_i]), (PG8_LAS unsigned*)(lds + (bufoff) + ldsw + _i * 8192), 16, 0, 0); } while (0)
#define PG8_LDA(dst, b, h) do { _Pragma("unroll") for (int m = 0; m < 4; ++m) _Pragma("unroll") for (int k = 0; k < 2; ++k) dst[m][k] = *(const PG8_LAS bf16x8*)(lds + PG8_SA(b, h) + aoff + m * 2048 + k * 1024); } while (0)
#define PG8_LDB(dst, b, h) do { _Pragma("unroll") for (int n = 0; n < 2; ++n) _Pragma("unroll") for (int k = 0; k < 2; ++k) dst[n][k] = *(const PG8_LAS bf16x8*)(lds + PG8_SB(b, h) + boff + n * 2048 + k * 1024); } while (0)
#define PG8_MMA(ai, bj, At, Bt) do { __builtin_amdgcn_s_setprio(1); _Pragma("unroll") for (int m = 0; m < 4; ++m) _Pragma("unroll") for (int n = 0; n < 2; ++n) _Pragma("unroll") for (int k = 0; k < 2; ++k) \
        acc[ai][bj][m][n] = __builtin_amdgcn_mfma_f32_16x16x32_bf16(Bt[n][k], At[m][k], acc[ai][bj][m][n], 0, 0, 0); __builtin_amdgcn_s_setprio(0); } while (0)
#define PG8_WAIT_V(n) asm volatile("s_waitcnt vmcnt(" #n ")" ::: "memory")
#define PG8_WAIT_L(n) asm volatile("s_waitcnt lgkmcnt(" #n ")" ::: "memory")
#define PG8_BAR __builtin_amdgcn_s_barrier()
#define PG8_SCHED __builtin_amdgcn_sched_barrier(0)
    Unit cur, nxt; int ui = 0;
    if (!S.next(0, cur)) return;
    f32x4 acc[2][2][4][2];
#pragma unroll
    for (int a = 0; a < 2; ++a)
#pragma unroll
        for (int b = 0; b < 2; ++b)
#pragma unroll
            for (int m = 0; m < 4; ++m)
#pragma unroll
                for (int n = 0; n < 2; ++n) acc[a][b][m][n] = (f32x4){0.f, 0.f, 0.f, 0.f};
    bf16x8 At[4][2], B0[2][2], B1[2][2];
    const char* cA = (const char*)g.A + g.a_off(cur.pm); const char* cB = (const char*)g.Bt + (size_t)cur.pn * tstepB;
    S.a_ready(cur);
    if constexpr (SP2) {
        PG8_STAGE(PG8_SB(0, 0), cB, voffB); PG8_STAGE(PG8_SB(0, 1), cB + hstepB, voffB); PG8_STAGE(PG8_SA(0, 0), cA, voffA); PG8_STAGE(PG8_SA(0, 1), cA + hstepA, voffA);
        if (wr == 1) PG8_BAR;
        PG8_WAIT_V(2); PG8_BAR;
        PG8_STAGE(PG8_SB(1, 0), cB + kstepB, voffB); PG8_STAGE(PG8_SA(1, 0), cA + kstepA, voffA); PG8_STAGE(PG8_SB(1, 1), cB + hstepB + kstepB, voffB);
        PG8_WAIT_V(6); PG8_BAR;
    } else {
        PG8_STAGE(PG8_SB(0, 0), cB, voffB); PG8_STAGE(PG8_SA(0, 0), cA, voffA); PG8_STAGE(PG8_SB(0, 1), cB + hstepB, voffB); PG8_STAGE(PG8_SA(0, 1), cA + hstepA, voffA);
        if (wr == 1) PG8_BAR;
        PG8_WAIT_V(4); PG8_BAR;
        PG8_STAGE(PG8_SB(1, 0), cB + kstepB, voffB); PG8_STAGE(PG8_SA(1, 0), cA + kstepA, voffA); PG8_STAGE(PG8_SB(1, 1), cB + hstepB + kstepB, voffB);
        PG8_WAIT_V(6); PG8_BAR;
    }
    for (;;) {
        const bool has_next = S.next(ui + 1, nxt);
        const char* nA = has_next ? (const char*)g.A + g.a_off(nxt.pm) : cA; const char* nB = has_next ? (const char*)g.Bt + (size_t)nxt.pn * tstepB : cB;
        for (int t = 0; t < nt; t += 2) {
            const bool last = (t == nt - 2);
            const char* a1 = cA + (size_t)(t + 1) * kstepA;
            const char* a2 = last ? nA : cA + (size_t)(t + 2) * kstepA; const char* b2 = last ? nB : cB + (size_t)(t + 2) * kstepB;
            const char* a3 = a2 + kstepA; const char* b3 = b2 + kstepB;
            if (last && has_next) S.a_ready(nxt);
            if constexpr (SP2) {
            PG8_LDB(B0, 0, 0); PG8_LDB(B1, 0, 1); PG8_SCHED; PG8_LDA(At, 0, 0); PG8_STAGE(PG8_SA(1, 1), a1 + hstepA, voffA);
            PG8_WAIT_V(8); PG8_WAIT_L(0); PG8_BAR; PG8_MMA(0, 0, At, B0); PG8_MMA(0, 1, At, B1); PG8_BAR; PG8_SCHED;
            PG8_LDA(At, 0, 1); PG8_STAGE(PG8_SB(0, 0), b2, voffB); PG8_STAGE(PG8_SB(0, 1), b2 + hstepB, voffB); PG8_STAGE(PG8_SA(0, 0), a2, voffA);
            PG8_WAIT_V(8); PG8_WAIT_L(0); PG8_BAR; PG8_MMA(1, 0, At, B0); PG8_MMA(1, 1, At, B1); PG8_BAR; PG8_SCHED;
            PG8_LDB(B0, 1, 0); PG8_LDB(B1, 1, 1); PG8_SCHED; PG8_LDA(At, 1, 0); PG8_STAGE(PG8_SA(0, 1), a2 + hstepA, voffA);
            PG8_WAIT_V(8); PG8_WAIT_L(0); PG8_BAR; PG8_MMA(0, 0, At, B0); PG8_MMA(0, 1, At, B1); PG8_BAR; PG8_SCHED;
            PG8_LDA(At, 1, 1); PG8_STAGE(PG8_SB(1, 0), b3, voffB); PG8_STAGE(PG8_SB(1, 1), b3 + hstepB, voffB); PG8_STAGE(PG8_SA(1, 0), a3, voffA);
            PG8_WAIT_V(8); PG8_WAIT_L(0); PG8_BAR; PG8_MMA(1, 0, At, B0); PG8_MMA(1, 1, At, B1); PG8_BAR; PG8_SCHED;
            } else {
            PG8_LDB(B0, 0, 0); PG8_SCHED; PG8_LDA(At, 0, 0); PG8_STAGE(PG8_SA(1, 1), a1 + hstepA, voffA);
            PG8_WAIT_L(8); PG8_BAR; PG8_WAIT_L(0); PG8_MMA(0, 0, At, B0); PG8_BAR; PG8_SCHED;
            PG8_LDB(B1, 0, 1); PG8_STAGE(PG8_SB(0, 0), b2, voffB);
            PG8_BAR; PG8_WAIT_L(0); PG8_MMA(0, 1, At, B1); PG8_BAR;
            PG8_LDA(At, 0, 1); PG8_STAGE(PG8_SA(0, 0), a2, voffA);
            PG8_BAR; PG8_WAIT_L(0); PG8_MMA(1, 0, At, B0); PG8_BAR; PG8_SCHED;
            PG8_STAGE(PG8_SB(0, 1), b2 + hstepB, voffB);
            PG8_WAIT_V(6); PG8_BAR; PG8_MMA(1, 1, At, B1); PG8_BAR;
            PG8_LDB(B0, 1, 0); PG8_SCHED; PG8_LDA(At, 1, 0); PG8_STAGE(PG8_SA(0, 1), a2 + hstepA, voffA);
            PG8_WAIT_L(8); PG8_BAR; PG8_WAIT_L(0); PG8_MMA(0, 0, At, B0); PG8_BAR; PG8_SCHED;
            PG8_LDB(B1, 1, 1); PG8_STAGE(PG8_SB(1, 0), b3, voffB);
            PG8_BAR; PG8_WAIT_L(0); PG8_MMA(0, 1, At, B1); PG8_BAR;
            PG8_LDA(At, 1, 1); PG8_STAGE(PG8_SA(1, 0), a3, voffA);
            PG8_BAR; PG8_WAIT_L(0); PG8_MMA(1, 0, At, B0); PG8_BAR; PG8_SCHED;
            PG8_STAGE(PG8_SB(1, 1), b3 + hstepB, voffB);
            PG8_WAIT_V(6); PG8_BAR; PG8_MMA(1, 1, At, B1); PG8_BAR;
            }
        }
        if constexpr (ALIGN_EPI) { if (wr == 0) PG8_BAR; }
        if constexpr (!Epi::AFTER_DRAIN) { E(acc, cur, wr, wc, fr, fq); S.done(cur); }
        if (!has_next) break;
#pragma unroll
        for (int a = 0; a < 2; ++a)
#pragma unroll
            for (int b = 0; b < 2; ++b)
#pragma unroll
                for (int m = 0; m < 4; ++m)
#pragma unroll
                    for (int n = 0; n < 2; ++n) acc[a][b][m][n] = (f32x4){0.f, 0.f, 0.f, 0.f};
        cur = nxt; cA = nA; cB = nB; ++ui;
        if constexpr (ALIGN_EPI) { if (wr == 1) PG8_BAR; }
    }
    PG8_WAIT_V(0);
    if constexpr (!ALIGN_EPI) { if (wr == 0) PG8_BAR; }
    PG8_BAR;
    if constexpr (Epi::AFTER_DRAIN) { E.fused(acc, cur, wr, wc, fr, fq, lds, wid, lane); S.done(cur); }
#undef PG8_SA
#undef PG8_SB
#undef PG8_STAGE
#undef PG8_LDA
#undef PG8_LDB
#undef PG8_MMA
#undef PG8_WAIT_V
#undef PG8_WAIT_L
#undef PG8_BAR
#undef PG8_SCHED
}
}
#define XB_TMO      128
#define XB_XCNT(j)  (256  + 64 * (j))
#define XB_XSUB(j)  (1280 + 64 * (j))
#define XB_XGEN(j)  (2304 + 64 * (j))
#define XB_TOP      3328
#define XB_TOPGEN   3392
#define XCD_BAR_WORDS 3456
#define XB_SPIN_CAP (1u << 18)

__device__ __forceinline__ unsigned xb_ld(unsigned* p)              { return __hip_atomic_load(p, __ATOMIC_RELAXED, __HIP_MEMORY_SCOPE_AGENT); }
__device__ __forceinline__ unsigned xb_add(unsigned* p, unsigned v) { return __hip_atomic_fetch_add(p, v, __ATOMIC_RELAXED, __HIP_MEMORY_SCOPE_AGENT); }
__device__ __forceinline__ unsigned xb_xcc_id() { return (unsigned)__builtin_amdgcn_s_getreg((3 << 11) | 20) & 0xFu; }
#define XB_SPIN(cond, bar) do { unsigned _sp = 0; while (cond) { __builtin_amdgcn_s_sleep(1); \
    if ((++_sp & 255u) == 0u) { if (xb_ld(&(bar)[XB_TMO])) break; if (_sp > XB_SPIN_CAP) { atomicAdd(&(bar)[XB_TMO], 1u); break; } } } } while (0)

struct XcdBarrier {
    unsigned* bar; unsigned x;
    volatile LAS unsigned* st;
};

__device__ __forceinline__ XcdBarrier xcd_barrier_post(unsigned* bar, volatile LAS unsigned* st) {
    XcdBarrier b; b.bar = bar; b.x = xb_xcc_id(); b.st = st;
    if (threadIdx.x == 0) (void)xb_add(&bar[XB_XCNT(b.x)], 1u);
    return b;
}
__device__ __forceinline__ void xcd_barrier_complete(unsigned* bar, unsigned x, unsigned& nloc, unsigned& nx) {
    const unsigned G = gridDim.x * gridDim.y * gridDim.z;
    unsigned sum, cnt, mine, sp = 0u;
    for (;;) {
        sum = 0u; cnt = 0u; mine = 0u;
#pragma unroll
        for (unsigned j = 0; j < 16; ++j) { const unsigned c = xb_ld(&bar[XB_XCNT(j)]); sum += c; cnt += (c > 0u) ? 1u : 0u; mine = (j == x) ? c : mine; }
        if (sum == G) break;
        __builtin_amdgcn_s_sleep(1);
        if ((++sp & 255u) == 0u) { if (xb_ld(&bar[XB_TMO])) break; if (sp > XB_SPIN_CAP) { atomicAdd(&bar[XB_TMO], 1u); break; } }
    }
    nloc = mine > 0u ? mine : 1u; nx = cnt > 0u ? cnt : 1u;
}

__device__ __forceinline__ void xcd_barrier(const XcdBarrier& b) {
    asm volatile("s_waitcnt vmcnt(0)" ::: "memory");
    __syncthreads();
    if (threadIdx.x == 0) {
        unsigned* bar = b.bar;
        __builtin_amdgcn_s_waitcnt(0);
        unsigned nloc = b.st[0], nx = b.st[1];
        if (nloc == 0u) { xcd_barrier_complete(bar, b.x, nloc, nx); b.st[0] = nloc; b.st[1] = nx; }
        const unsigned old = xb_add(&bar[XB_XSUB(b.x)], 1u);
        const unsigned gen = old / nloc;
        if (old + 1u == (gen + 1u) * nloc) {
            __builtin_amdgcn_fence(__ATOMIC_RELEASE, "agent");
            asm volatile("s_waitcnt vmcnt(0)" ::: "memory");
            const unsigned og = xb_add(&bar[XB_TOP], 1u);
            const unsigned tg = og / nx;
            if (og + 1u == (tg + 1u) * nx) xb_add(&bar[XB_TOPGEN], 1u);
            else XB_SPIN(xb_ld(&bar[XB_TOPGEN]) == tg, bar);
            __builtin_amdgcn_fence(__ATOMIC_ACQUIRE, "agent");
            xb_add(&bar[XB_XGEN(b.x)], 1u);
            asm volatile("s_waitcnt vmcnt(0)" ::: "memory");
        } else {
            XB_SPIN(xb_ld(&bar[XB_XGEN(b.x)]) == gen, bar);
            __builtin_amdgcn_fence(__ATOMIC_ACQUIRE, "agent");
            asm volatile("s_waitcnt vmcnt(0)" ::: "memory");
        }
    }
    __syncthreads();
}
__device__ __forceinline__ void sincos_rev(float ang, float& s, float& c) {
    double rev = (double)ang * 0.15915494309189535; rev -= rint(rev);
    float r = (float)rev; s = __builtin_amdgcn_sinf(r); c = __builtin_amdgcn_cosf(r);
}
__device__ __forceinline__ int inproj_src_col(int c) {
    if (c < 1152) return c;
    if (c < 1536) return 1170 + (c - 1152);
    if (c < 3168) return c + 18;
    if (c < 3200) return (c - 3168 < 18) ? 1152 + (c - 3168) : -1;
    if (c < 3520) return c - 14;
    return -1;
}
namespace fa {
typedef short bf16x8 __attribute__((ext_vector_type(8)));
typedef short s16x4 __attribute__((ext_vector_type(4)));
typedef float f32x16 __attribute__((ext_vector_type(16)));
typedef unsigned u32x4 __attribute__((ext_vector_type(4)));
typedef __attribute__((address_space(3))) const char* lds_cptr;
typedef __attribute__((address_space(3))) char* lds_ptr;
#define FA_LAS __attribute__((address_space(3)))

constexpr int STAGE_B = 20480, KIMG = 0, VIMG = 12288;
constexpr int L_WSF = 2 * STAGE_B, L_MISC = L_WSF + 2048, L_OST = L_MISC + 2048, OST_RS = 68, OST_WB = 32 * OST_RS * 4;
constexpr int L_END = L_OST + 8 * OST_WB;
static_assert(L_END <= 131072, "attention LDS map");
constexpr float NEG_INF = -INFINITY;
constexpr float THR = 6.0f;

__device__ __forceinline__ float ex2(float x) { return __builtin_amdgcn_exp2f(x); }
__device__ __forceinline__ int crow(int r, int hi) { return (r & 3) + 8 * (r >> 2) + 4 * hi; }
__device__ __forceinline__ unsigned cvtpk(float lo, float hi) { typedef float f2 __attribute__((ext_vector_type(2))); typedef __bf16 b2 __attribute__((ext_vector_type(2))); f2 v = {lo, hi}; b2 b = __builtin_convertvector(v, b2); return __builtin_bit_cast(unsigned, b); }

struct KVSrc { const bf16_t* K; const bf16_t* V; int kpitch, vpitch; };
struct StageRegs { u32x4 k0, k1, v; };

template <int NKC>
__device__ __forceinline__ void stage_load(StageRegs& R, const KVSrc& s, int key0, int tid, int wave, int lane) {
    R.k0 = *(const u32x4*)(s.K + (size_t)(key0 + (tid & 63)) * s.kpitch + (tid >> 6) * 8);
    if (NKC == 12) { if (tid < 256) R.k1 = *(const u32x4*)(s.K + (size_t)(key0 + (tid & 63)) * s.kpitch + (8 + (tid >> 6)) * 8); }
    R.v = *(const u32x4*)(s.V + (size_t)(key0 + 16 * (wave & 3) + (lane >> 2)) * s.vpitch + 32 * (wave >> 2) + 8 * (lane & 3));
}
template <int NKC>
__device__ __forceinline__ void stage_write(const StageRegs& R, lds_ptr st, int tid, int wave, int lane) {
    *(FA_LAS u32x4*)(st + KIMG + (tid >> 6) * 1024 + (tid & 63) * 16) = R.k0;
    if (NKC == 12) { if (tid < 256) *(FA_LAS u32x4*)(st + KIMG + (8 + (tid >> 6)) * 1024 + (tid & 63) * 16) = R.k1; }
    *(FA_LAS u32x4*)(st + VIMG + wave * 1024 + lane * 16) = R.v;
}

template <int NK>
__device__ __forceinline__ void qkt(f32x16& p0, f32x16& p1, lds_cptr Kimg, const bf16x8* qr, int r32, int hi) {
    lds_cptr kb = Kimg + hi * 1024 + r32 * 16;
    f32x16 z = {}; p0 = z; p1 = z;
#pragma unroll
    for (int d0 = 0; d0 < NK; ++d0) {
        const bf16x8 b0 = *(const FA_LAS bf16x8*)(kb + d0 * 2048), b1 = *(const FA_LAS bf16x8*)(kb + d0 * 2048 + 512);
        p0 = __builtin_amdgcn_mfma_f32_32x32x16_bf16(b0, qr[d0], p0, 0, 0, 0); p1 = __builtin_amdgcn_mfma_f32_32x32x16_bf16(b1, qr[d0], p1, 0, 0, 0);
    }
}
typedef short v4i16_t __attribute__((ext_vector_type(4)));
__device__ __forceinline__ s16x4 vtr(lds_cptr p) { return __builtin_bit_cast(s16x4, __builtin_amdgcn_ds_read_tr16_b64_v4i16((FA_LAS v4i16_t*)p)); }
__device__ __forceinline__ void pv(f32x16* o, lds_cptr vp, const u32x4& w0, const u32x4& w1, const u32x4& w2, const u32x4& w3) {
    const bf16x8 pa[4] = {__builtin_bit_cast(bf16x8, w0), __builtin_bit_cast(bf16x8, w1), __builtin_bit_cast(bf16x8, w2), __builtin_bit_cast(bf16x8, w3)};
#pragma unroll
    for (int d0 = 0; d0 < 2; ++d0)
#pragma unroll
        for (int ks = 0; ks < 4; ++ks) {
            const s16x4 lo = vtr(vp + d0 * 4096 + ks * 1024), hi_ = vtr(vp + d0 * 4096 + ks * 1024 + 512);
            const bf16x8 vf = {lo[0], lo[1], lo[2], lo[3], hi_[0], hi_[1], hi_[2], hi_[3]};
            o[d0] = __builtin_amdgcn_mfma_f32_32x32x16_bf16(pa[ks], vf, o[d0], 0, 0, 0);
        }
}
__device__ __forceinline__ float rowmax32(const f32x16& p0, const f32x16& p1) {
    float a = fmaxf(p0[0], p1[0]);
#pragma unroll
    for (int r = 1; r < 16; ++r) a = fmaxf(a, fmaxf(p0[r], p1[r]));
    return pmax32(a);
}

constexpr int MK_CAUSAL = 0, MK_SEL = 1, MK_WIN = 2;

template <int MKIND, int NK, int NKC>
__device__ __forceinline__ void softmax_branch(f32x16 (&o)[2], float& l, lds_ptr lds, const KVSrc& src, const bf16x8* qr, int t_lo, int t_hi, int qidx  ,
                                               int wrow0  , u64 selmask, int tid, int wave, int lane) {
    const int r32 = lane & 31, hi = lane >> 5;
    FA_LAS float* wsf = (FA_LAS float*)(lds + L_WSF) + wave * 64;
    lds_cptr vlane = (lds_cptr)lds + VIMG + ((lane >> 4) & 1) * 32 + (lane & 3) * 8 + (4 * hi + ((lane & 15) >> 2)) * 64;
    float m = NEG_INF; l = 0.f; { f32x16 z = {}; o[0] = z; o[1] = z; }
    StageRegs R;
    stage_load<NKC>(R, src, t_lo * 64, tid, wave, lane);
    stage_write<NKC>(R, lds, tid, wave, lane);
    __syncthreads();
    for (int t = t_lo; t <= t_hi; ++t) {
        const int cur = (t - t_lo) & 1; lds_ptr st = lds + cur * STAGE_B; lds_ptr stn = lds + (cur ^ 1) * STAGE_B;
        if (t < t_hi) stage_load<NKC>(R, src, (t + 1) * 64, tid, wave, lane);
        bool need;
        if (MKIND == MK_CAUSAL) need = (64 * t <= wrow0 + 31);
        else if (MKIND == MK_SEL) need = (64 * t <= wrow0 + 31) && __any((int)((selmask >> t) & 1ull));
        else need = (64 * t <= wrow0 + 31) && (64 * t + 63 > wrow0 - 512);
        if (need) {
            f32x16 p0, p1;
            qkt<NK>(p0, p1, (lds_cptr)st + KIMG, qr, r32, hi);
            if (64 * t + 63 > wrow0) {
                const int kb = 64 * t + 4 * hi;
#pragma unroll
                for (int r = 0; r < 16; ++r) { const int kv = kb + (r & 3) + 8 * (r >> 2); if (kv > qidx) p0[r] = NEG_INF; if (kv + 32 > qidx) p1[r] = NEG_INF; }
            }
            if (MKIND == MK_WIN) { if (64 * t <= wrow0 + 31 - 512) {
                const int kb = 64 * t + 4 * hi;
#pragma unroll
                for (int r = 0; r < 16; ++r) { const int kv = kb + (r & 3) + 8 * (r >> 2); if (kv <= qidx - 512) p0[r] = NEG_INF; if (kv + 32 <= qidx - 512) p1[r] = NEG_INF; }
            } }
            float rm = rowmax32(p0, p1);
            bool rowon = true;
            if (MKIND == MK_SEL) { rowon = ((selmask >> t) & 1ull) != 0ull; rm = rowon ? rm : NEG_INF; }
            if (__any(rm > m + THR)) {
                const float mn = fmaxf(m, rm); const float f = (mn == NEG_INF) ? 1.f : ex2(m - mn);
                l *= f; m = mn; if (hi == 0) wsf[r32] = f;
                asm volatile("s_waitcnt lgkmcnt(0)" ::: "memory");
#pragma unroll
                for (int g = 0; g < 4; ++g) { const f32x4 fv = *(const FA_LAS f32x4*)(wsf + 8 * g + 4 * hi);
#pragma unroll
                    for (int e = 0; e < 4; ++e) { o[0][4 * g + e] *= fv[e]; o[1][4 * g + e] *= fv[e]; } }
            }
            const float mu = rowon ? ((m == NEG_INF) ? 0.f : m) : INFINITY;
            float s = 0.f;
#pragma unroll
            for (int r = 0; r < 16; ++r) { p0[r] = ex2(p0[r] - mu); p1[r] = ex2(p1[r] - mu); s += p0[r] + p1[r]; }
            l += s;
            u32x4 w0, w1, w2, w3;
            w0.x = cvtpk(p0[0], p0[1]); w0.y = cvtpk(p0[2], p0[3]); w0.z = cvtpk(p0[4], p0[5]); w0.w = cvtpk(p0[6], p0[7]);
            w1.x = cvtpk(p0[8], p0[9]); w1.y = cvtpk(p0[10], p0[11]); w1.z = cvtpk(p0[12], p0[13]); w1.w = cvtpk(p0[14], p0[15]);
            w2.x = cvtpk(p1[0], p1[1]); w2.y = cvtpk(p1[2], p1[3]); w2.z = cvtpk(p1[4], p1[5]); w2.w = cvtpk(p1[6], p1[7]);
            w3.x = cvtpk(p1[8], p1[9]); w3.y = cvtpk(p1[10], p1[11]); w3.z = cvtpk(p1[12], p1[13]); w3.w = cvtpk(p1[14], p1[15]);
            pv(o, vlane + cur * STAGE_B, w0, w1, w2, w3);
        }
        if (t < t_hi) stage_write<NKC>(R, stn, tid, wave, lane);
        __syncthreads();
    }
}

__device__ __forceinline__ void add_scaled(f32x16 (&acc)[2], const f32x16 (&o)[2], float fac, FA_LAS float* wsf, int r32, int hi) {
    asm volatile("s_waitcnt lgkmcnt(0)" ::: "memory");
    if (hi == 0) wsf[r32] = fac;
    asm volatile("s_waitcnt lgkmcnt(0)" ::: "memory");
#pragma unroll
    for (int g = 0; g < 4; ++g) { const f32x4 fv = *(const FA_LAS f32x4*)(wsf + 8 * g + 4 * hi);
#pragma unroll
        for (int e = 0; e < 4; ++e) { acc[0][4 * g + e] += o[0][4 * g + e] * fv[e]; acc[1][4 * g + e] += o[1][4 * g + e] * fv[e]; } }
}
__device__ __forceinline__ void store_rows(const f32x16 (&acc)[2], lds_ptr lds, int wave, int lane, bf16_t* mixrow0  , const bf16_t* addrow0, int addpitch, const bf16_t* mulrow0, int mulpitch) {
    const int r32 = lane & 31, hi = lane >> 5;
    FA_LAS float* stg = (FA_LAS float*)(lds + L_OST + wave * OST_WB);
#pragma unroll
    for (int r = 0; r < 16; ++r) { const int q = crow(r, hi); stg[q * OST_RS + r32] = acc[0][r]; stg[q * OST_RS + 32 + r32] = acc[1][r]; }
    asm volatile("s_waitcnt lgkmcnt(0)" ::: "memory");
#pragma unroll
    for (int i = 0; i < 4; ++i) {
        const int row = i * 8 + (lane >> 3), ch = lane & 7;
        const f32x4 a = *(const FA_LAS f32x4*)(stg + row * OST_RS + ch * 8), b = *(const FA_LAS f32x4*)(stg + row * OST_RS + ch * 8 + 4);
        float v[8] = {a[0], a[1], a[2], a[3], b[0], b[1], b[2], b[3]};
        if (addrow0) { const uint4 ad = *(const uint4*)(addrow0 + (size_t)row * addpitch + ch * 8);
            v[0] += blo(ad.x); v[1] += bhi(ad.x); v[2] += blo(ad.y); v[3] += bhi(ad.y); v[4] += blo(ad.z); v[5] += bhi(ad.z); v[6] += blo(ad.w); v[7] += bhi(ad.w); }
        const uint4 mu = *(const uint4*)(mulrow0 + (size_t)row * mulpitch + ch * 8);
        v[0] *= blo(mu.x); v[1] *= bhi(mu.x); v[2] *= blo(mu.y); v[3] *= bhi(mu.y); v[4] *= blo(mu.z); v[5] *= bhi(mu.z); v[6] *= blo(mu.w); v[7] *= bhi(mu.w);
        uint4 ov; ov.x = cvtpk(v[0], v[1]); ov.y = cvtpk(v[2], v[3]); ov.z = cvtpk(v[4], v[5]); ov.w = cvtpk(v[6], v[7]);
        *(uint4*)(mixrow0 + (size_t)row * DM + ch * 8) = ov;
    }
    asm volatile("s_waitcnt lgkmcnt(0)" ::: "memory");
}

__device__ __forceinline__ void unit_mla(unsigned char* ws, lds_ptr lds, int b, int h, int qb, int tid, int wave, int lane) {
    const int r32 = lane & 31, hi = lane >> 5; const int q0 = qb * 256, wrow0 = q0 + 32 * wave, qidx = wrow0 + r32; const size_t m0 = (size_t)b * SEQ;
    const bf16_t* MQ = (const bf16_t*)(ws + WS_MQ); const bf16_t* MKp = (const bf16_t*)(ws + WS_MK); const bf16_t* MV = (const bf16_t*)(ws + WS_MV); const bf16_t* ACT = (const bf16_t*)(ws + WS_ACT); bf16_t* MIX = (bf16_t*)(ws + WS_MIX);
    bf16x8 qr[6];
#pragma unroll
    for (int d0 = 0; d0 < 6; ++d0) qr[d0] = *(const bf16x8*)(MQ + (m0 + qidx) * 480 + h * 96 + d0 * 16 + hi * 8);
    KVSrc src{MKp + m0 * 480 + h * 96, MV + m0 * 320 + h * 64, 480, 320};
    f32x16 o[2]; float l;
    softmax_branch<MK_CAUSAL, 6, 12>(o, l, lds, src, qr, 0, (q0 + 255) >> 6, qidx, wrow0, 0ull, tid, wave, lane);
    l = psum32(l);
    FA_LAS float* wsf = (FA_LAS float*)(lds + L_WSF) + wave * 64;
    f32x16 acc[2]; { f32x16 z = {}; acc[0] = z; acc[1] = z; }
    add_scaled(acc, o, 1.f / l, wsf, r32, hi);
    store_rows(acc, lds, wave, lane, MIX + (m0 + wrow0) * DM + 704 + h * 64, nullptr, 0, ACT + (m0 + wrow0) * ACTW + A_MZ + h * 64, ACTW);
}
__device__ __forceinline__ void unit_nsa(unsigned char* ws, lds_ptr lds, int b, int h, int qb, int tid, int wave, int lane) {
    const int r32 = lane & 31, hi = lane >> 5; const int q0 = qb * 256, wrow0 = q0 + 32 * wave, qidx = wrow0 + r32, g = h / 3; const size_t m0 = (size_t)b * SEQ;
    const bf16_t* ACT = (const bf16_t*)(ws + WS_ACT); const bf16_t* OC = (const bf16_t*)(ws + WS_OC); const u64* SEL = (const u64*)(ws + WS_SEL); bf16_t* MIX = (bf16_t*)(ws + WS_MIX);
    bf16x8 qr[4];
#pragma unroll
    for (int d0 = 0; d0 < 4; ++d0) qr[d0] = *(const bf16x8*)(ACT + (m0 + qidx) * ACTW + A_NQ + h * 64 + d0 * 16 + hi * 8);
    const u64 sel = SEL[(size_t)(b * 2 + g) * SEQ + qidx];
    const float gs = bf2f(ACT[(m0 + qidx) * ACTW + A_GATE + h * 3 + 1]), gw = bf2f(ACT[(m0 + qidx) * ACTW + A_GATE + h * 3 + 2]);
    FA_LAS float* wsf = (FA_LAS float*)(lds + L_WSF) + wave * 64;
    f32x16 acc[2]; { f32x16 z = {}; acc[0] = z; acc[1] = z; }
    {
        KVSrc src{ACT + m0 * ACTW + A_KS + g * 64, ACT + m0 * ACTW + A_VS + g * 64, ACTW, ACTW};
        f32x16 o[2]; float l;
        softmax_branch<MK_SEL, 4, 8>(o, l, lds, src, qr, 0, (q0 + 255) >> 6, qidx, wrow0, sel, tid, wave, lane);
        l = psum32(l);
        add_scaled(acc, o, gs / l, wsf, r32, hi);
    }
    {
        KVSrc src{ACT + m0 * ACTW + A_KW + g * 64, ACT + m0 * ACTW + A_VW + g * 64, ACTW, ACTW};
        f32x16 o[2]; float l; const int tlo = (q0 >= 512) ? ((q0 - 512) >> 6) : 0;
        softmax_branch<MK_WIN, 4, 8>(o, l, lds, src, qr, tlo, (q0 + 255) >> 6, qidx, wrow0, 0ull, tid, wave, lane);
        l = psum32(l);
        add_scaled(acc, o, gw / l, wsf, r32, hi);
    }
    store_rows(acc, lds, wave, lane, MIX + (m0 + wrow0) * DM + h * 64, OC + (m0 + wrow0) * 384 + h * 64, 384, ACT + (m0 + wrow0) * ACTW + A_NZ + h * 64, ACTW);
}

constexpr float SB_CUT = 104.0f;
__device__ __forceinline__ void unit_sb(unsigned char* ws, lds_ptr lds, int b, int h, int qb, int tid, int wave, int lane) {
    const int r32 = lane & 31, hi = lane >> 5; const int q0 = qb * 256, wrow0 = q0 + 32 * wave, qidx = wrow0 + r32; const size_t m0 = (size_t)b * SEQ;
    const bf16_t* ACT = (const bf16_t*)(ws + WS_ACT); bf16_t* MIX = (bf16_t*)(ws + WS_MIX);
    bf16x8 qr[4];
#pragma unroll
    for (int d0 = 0; d0 < 4; ++d0) qr[d0] = *(const bf16x8*)(ACT + (m0 + qidx) * ACTW + A_SQ + h * 64 + d0 * 16 + hi * 8);
    KVSrc src{ACT + m0 * ACTW + A_SK + h * 64, ACT + m0 * ACTW + A_SV + h * 64, ACTW, ACTW};
    FA_LAS unsigned* flags = (FA_LAS unsigned*)(lds + L_MISC) + 16;
    lds_cptr vlane = (lds_cptr)lds + VIMG + ((lane >> 4) & 1) * 32 + (lane & 3) * 8 + (4 * hi + ((lane & 15) >> 2)) * 64;
    f32x16 o[2]; { f32x16 z = {}; o[0] = z; o[1] = z; }
    float R = 0.f;
    const int t_hi = (q0 + 255) >> 6;
    StageRegs SR;
    stage_load<8>(SR, src, t_hi * 64, tid, wave, lane);
    stage_write<8>(SR, lds, tid, wave, lane);
    __syncthreads();
    for (int t = t_hi; t >= 0; --t) {
        const int it = t_hi - t, cur = it & 1; lds_ptr st = lds + cur * STAGE_B; lds_ptr stn = lds + (cur ^ 1) * STAGE_B;
        if (t > 0) stage_load<8>(SR, src, (t - 1) * 64, tid, wave, lane);
        const bool mydone = __all(R >= SB_CUT) != 0;
        const bool need = (64 * t < wrow0 + 31) && !mydone;
        if (need) {
            f32x16 p0, p1;
            qkt<4>(p0, p1, (lds_cptr)st + KIMG, qr, r32, hi);
            const bool diag = (64 * t + 63 >= wrow0);
            const int kb = 64 * t + 4 * hi;
            f32x16 s0, s1;
#pragma unroll
            for (int r = 0; r < 16; ++r) {
                const float z0 = p0[r], z1 = p1[r];
                float a0 = fmaxf(z0, 0.f) + 0.6931471805599453f * __log2f(1.f + ex2(-fabsf(z0) * LOG2E));
                float a1 = fmaxf(z1, 0.f) + 0.6931471805599453f * __log2f(1.f + ex2(-fabsf(z1) * LOG2E));
                if (diag) { const int kv = kb + (r & 3) + 8 * (r >> 2); if (kv >= qidx) a0 = 0.f; if (kv + 32 >= qidx) a1 = 0.f; }
                s0[r] = a0; s1[r] = a1;
            }
            float T[8];
#pragma unroll
            for (int i = 0; i < 4; ++i) {
                s0[4 * i + 2] += s0[4 * i + 3]; s0[4 * i + 1] += s0[4 * i + 2]; s0[4 * i] += s0[4 * i + 1]; T[i] = s0[4 * i];
                s1[4 * i + 2] += s1[4 * i + 3]; s1[4 * i + 1] += s1[4 * i + 2]; s1[4 * i] += s1[4 * i + 1]; T[4 + i] = s1[4 * i];
            }
            float TP[8];
#pragma unroll
            for (int i = 0; i < 8; ++i) TP[i] = pxchg32(T[i], hi);
            float accS = R, suf[8];
#pragma unroll
            for (int i = 7; i >= 0; --i) { suf[i] = accS + (hi == 0 ? TP[i] : 0.f); accS += T[i] + TP[i]; }
            R = accS;
#pragma unroll
            for (int r = 0; r < 16; ++r) {
                float a0 = ex2((p0[r] - (s0[r] + suf[r >> 2])) * LOG2E), a1 = ex2((p1[r] - (s1[r] + suf[4 + (r >> 2)])) * LOG2E);
                if (diag) { const int kv = kb + (r & 3) + 8 * (r >> 2); if (kv >= qidx) a0 = 0.f; if (kv + 32 >= qidx) a1 = 0.f; }
                p0[r] = a0; p1[r] = a1;
            }
            u32x4 w0, w1, w2, w3;
            w0.x = cvtpk(p0[0], p0[1]); w0.y = cvtpk(p0[2], p0[3]); w0.z = cvtpk(p0[4], p0[5]); w0.w = cvtpk(p0[6], p0[7]);
            w1.x = cvtpk(p0[8], p0[9]); w1.y = cvtpk(p0[10], p0[11]); w1.z = cvtpk(p0[12], p0[13]); w1.w = cvtpk(p0[14], p0[15]);
            w2.x = cvtpk(p1[0], p1[1]); w2.y = cvtpk(p1[2], p1[3]); w2.z = cvtpk(p1[4], p1[5]); w2.w = cvtpk(p1[6], p1[7]);
            w3.x = cvtpk(p1[8], p1[9]); w3.y = cvtpk(p1[10], p1[11]); w3.z = cvtpk(p1[12], p1[13]); w3.w = cvtpk(p1[14], p1[15]);
            pv(o, vlane + cur * STAGE_B, w0, w1, w2, w3);
        }
        const bool fin = (__all(R >= SB_CUT) != 0) || (t == 0);
        if (lane == 0) flags[cur * 8 + wave] = fin ? 1u : 0u;
        if (t > 0) stage_write<8>(SR, stn, tid, wave, lane);
        __syncthreads();
        unsigned alld = 1u;
#pragma unroll
        for (int w = 0; w < 8; ++w) alld &= flags[cur * 8 + w];
        if (alld) break;
    }
    __syncthreads();
    f32x16 acc[2]; acc[0] = o[0]; acc[1] = o[1];
    store_rows(acc, lds, wave, lane, MIX + (m0 + wrow0) * DM + 384 + h * 64, nullptr, 0, ACT + (m0 + wrow0) * ACTW + A_SZ + h * 64, ACTW);
}

constexpr int N_HEAVY = 16 * 88, N_UNITS = N_HEAVY + 16 * 40;
__device__ __forceinline__ void attn_phase(unsigned char* ws, lds_ptr lds, unsigned* qctr, int tid, int wave, int lane) {
    FA_LAS int* ubox = (FA_LAS int*)(lds + L_MISC);
    for (;;) {
        if (tid == 0) ubox[0] = (int)atomicAdd(qctr, 1u);
        __syncthreads();
        const int u = ubox[0];
        __syncthreads();
        if (u >= N_UNITS) break;
        if (u < N_HEAVY) { const int qb = 15 - u / 88, r = u % 88;
            if (r < 48) unit_nsa(ws, lds, r / 6, r % 6, qb, tid, wave, lane);
            else unit_mla(ws, lds, (r - 48) / 5, (r - 48) % 5, qb, tid, wave, lane);
        } else { const int v = u - N_HEAVY; unit_sb(ws, lds, (v % 40) / 5, v % 5, 15 - v / 40, tid, wave, lane); }
        __syncthreads();
    }
}
}
namespace cm {
using fa::bf16x8; using fa::f32x16; using fa::u32x4; using fa::lds_cptr; using fa::lds_ptr; using fa::crow; using fa::ex2; using fa::cvtpk; using fa::vtr; using fa::s16x4;
#define CM_LAS __attribute__((address_space(3)))

__device__ __forceinline__ int tok_off(int T, int c) { return T * 128 + (T >> 7) * 128 + ((c ^ ((T >> 4) & 7)) << 4); }
constexpr int L_TOK = 0, L_RED = 69632, L_HID = L_RED + 16384, HID_PITCH = 272;
__device__ __forceinline__ void compress_unit(unsigned char* ws, lds_ptr lds, int l, int kv, int bg, int nb, int tid, int wave, int lane) {
    const int b = bg >> 1, g = bg & 1, n0 = 32 * nb, r32 = lane & 31, hi = lane >> 5, cg = wave & 3, kh = wave >> 2;
    const bf16_t* ACT = (const bf16_t*)(ws + WS_ACT);
    const bf16_t* src = ACT + (size_t)b * SEQ * ACTW + (kv ? A_VC : A_KC) + g * 64;
    for (int idx = tid; idx < 528 * 8; idx += 512) { const int T = idx >> 3, c = idx & 7; int tok = 16 * n0 + T; tok = tok > SEQ - 1 ? SEQ - 1 : tok;
        *(CM_LAS u32x4*)(lds + L_TOK + tok_off(T, c)) = *(const u32x4*)(src + (size_t)tok * ACTW + c * 8); }
    __syncthreads();
    const bf16_t* W1T = (const bf16_t*)(ws + WS_W1T) + (size_t)((l * 2 + kv) * 128 + 32 * cg + r32) * 2048 + kh * 1024 + 8 * hi;
    f32x16 acc = {};
#pragma unroll 8
    for (int ks = 0; ks < 64; ++ks) {
        const int k = kh * 1024 + ks * 16 + 8 * hi; const int T = 16 * r32 + (k >> 6), c = (k & 63) >> 3;
        const bf16x8 a = *(const CM_LAS bf16x8*)(lds + L_TOK + tok_off(T, c));
        const bf16x8 bfrag = *(const bf16x8*)(W1T + ks * 16);
        acc = __builtin_amdgcn_mfma_f32_32x32x16_bf16(a, bfrag, acc, 0, 0, 0);
    }
    CM_LAS float* red = (CM_LAS float*)(lds + L_RED) + cg * 1024;
    if (kh == 1) {
#pragma unroll
        for (int r = 0; r < 16; ++r) red[r * 64 + lane] = acc[r];
    }
    __syncthreads();
    if (kh == 0) {
        const float* pp = (const float*)(ws + WS_POSBP) + (size_t)(l * 2 + kv) * 32 * 128 + 32 * cg + r32; float pb = 0.f;
        for (int i = 0; i < 32; ++i) pb += pp[i * 128];
#pragma unroll
        for (int r = 0; r < 16; ++r) { const float v = acc[r] + red[r * 64 + lane] + pb; const float s = silu_f(v);
            *(CM_LAS bf16_t*)(lds + L_HID + crow(r, hi) * HID_PITCH + (32 * cg + r32) * 2) = f2bf(s); }
    }
    __syncthreads();
    if (wave < 2) {
        const bf16_t* W2T = (const bf16_t*)(ws + WS_W2T) + (size_t)((l * 2 + kv) * 64 + 32 * wave + r32) * 128 + 8 * hi;
        f32x16 o = {};
#pragma unroll
        for (int ks = 0; ks < 8; ++ks) {
            const bf16x8 a = *(const CM_LAS bf16x8*)(lds + L_HID + r32 * HID_PITCH + (ks * 16 + 8 * hi) * 2);
            const bf16x8 bfrag = *(const bf16x8*)(W2T + ks * 16);
            o = __builtin_amdgcn_mfma_f32_32x32x16_bf16(a, bfrag, o, 0, 0, 0);
        }
        bf16_t* outp = (bf16_t*)(ws + (kv ? WS_VC : WS_KC)) + (size_t)bg * 256 * 64 + 32 * wave + r32;
#pragma unroll
        for (int r = 0; r < 16; ++r) { const int n = n0 + crow(r, hi); outp[(size_t)n * 64] = (n < NCMP) ? f2bf(o[r]) : (bf16_t)0; }
    }
    __syncthreads();
}
__device__ __forceinline__ void compress_phase(unsigned char* ws, lds_ptr lds, int l, int bid, int G, int tid, int wave, int lane) {
    for (int u = bid; u < 2 * 16 * 8; u += G) compress_unit(ws, lds, l, u >> 7, (u >> 3) & 15, u & 7, tid, wave, lane);
}

constexpr int L_KCI = 0, L_VCI = 32768, L_IMP = 65536, IMP_RS = 65, L_WSF2 = L_IMP + 3 * 64 * IMP_RS * 4;
static_assert(L_WSF2 + 2048 <= 131072, "cmp LDS map");
__device__ __forceinline__ void cmp_unit(unsigned char* ws, lds_ptr lds, int bg, int tb, int tid, int wave, int lane) {
    asm volatile("" : "+v"(tid), "+v"(lane));
    const int b = bg >> 1, g = bg & 1, t0 = 64 * tb, r32 = lane & 31, hi = lane >> 5; const size_t m0 = (size_t)b * SEQ;
    const bf16_t* ACT = (const bf16_t*)(ws + WS_ACT); const bf16_t* KC = (const bf16_t*)(ws + WS_KC) + (size_t)bg * 256 * 64; const bf16_t* VC = (const bf16_t*)(ws + WS_VC) + (size_t)bg * 256 * 64;
    const int tlast = t0 + 63; const int nvmax = (tlast >= 31) ? min(NCMP, (tlast - 31) / 16 + 1) : 0; const int nblk = (nvmax + 31) >> 5;
    CM_LAS float* imp = (CM_LAS float*)(lds + L_IMP);
    for (int i = tid; i < 3 * 64 * IMP_RS; i += 512) imp[i] = 0.f;
    for (int idx = tid; idx < nblk * 32 * 8; idx += 512) { const int key = idx >> 3, c = idx & 7;
        *(CM_LAS u32x4*)(lds + L_KCI + c * 4096 + key * 16) = *(const u32x4*)(KC + key * 64 + c * 8);
        *(CM_LAS u32x4*)(lds + L_VCI + (c >> 2) * 16384 + (key >> 4) * 1024 + (key & 15) * 64 + (c & 3) * 16) = *(const u32x4*)(VC + key * 64 + c * 8); }
    __syncthreads();
    if (wave < 6) {
        const int hh = wave >> 1, rb = wave & 1, h = 3 * g + hh; const int t = t0 + 32 * rb + r32;
        bf16x8 qr[4];
#pragma unroll
        for (int d0 = 0; d0 < 4; ++d0) qr[d0] = *(const bf16x8*)(ACT + (m0 + t) * ACTW + A_NQ + h * 64 + d0 * 16 + hi * 8);
        const int nv = (t >= 31) ? min(NCMP, (t - 31) / 16 + 1) : 0;
        f32x16 s[8];
        lds_cptr kb = (lds_cptr)lds + L_KCI + hi * 4096 + r32 * 16;
#pragma unroll
        for (int nbk = 0; nbk < 8; ++nbk) { f32x16 z = {}; s[nbk] = z;
            if (nbk < nblk) {
#pragma unroll
                for (int d0 = 0; d0 < 4; ++d0) { const bf16x8 kf = *(const CM_LAS bf16x8*)(kb + d0 * 8192 + nbk * 512); s[nbk] = __builtin_amdgcn_mfma_f32_32x32x16_bf16(kf, qr[d0], s[nbk], 0, 0, 0); }
            }
#pragma unroll
            for (int r = 0; r < 16; ++r) { const int n = 32 * nbk + crow(r, hi); if (n >= nv) s[nbk][r] = fa::NEG_INF; }
        }
        float mx = fa::NEG_INF;
#pragma unroll
        for (int nbk = 0; nbk < 8; ++nbk)
#pragma unroll
            for (int r = 0; r < 16; ++r) mx = fmaxf(mx, s[nbk][r]);
        mx = pmax32(mx);
        const float mu = (mx == fa::NEG_INF) ? 0.f : mx;
        float lsum = 0.f;
#pragma unroll
        for (int nbk = 0; nbk < 8; ++nbk)
#pragma unroll
            for (int r = 0; r < 16; ++r) { s[nbk][r] = ex2(s[nbk][r] - mu); lsum += s[nbk][r]; }
        lsum = psum32(lsum);
        const float inv = (lsum > 0.f) ? 1.f / lsum : 0.f;
        f32x16 o[2]; { f32x16 z = {}; o[0] = z; o[1] = z; }
        lds_cptr vlane = (lds_cptr)lds + L_VCI + ((lane >> 4) & 1) * 32 + (lane & 3) * 8 + (4 * hi + ((lane & 15) >> 2)) * 64;
        CM_LAS float* impq = imp + (hh * 64 + 32 * rb + r32) * IMP_RS;
        float eprev = 0.f;
#pragma unroll
        for (int nbk = 0; nbk < 8; ++nbk) {
            if (nbk < nblk) {
#pragma unroll
                for (int r = 0; r < 16; ++r) s[nbk][r] *= inv;
#pragma unroll
                for (int gq = 0; gq < 4; ++gq) {
                    const float G = (s[nbk][4 * gq] + s[nbk][4 * gq + 1]) + (s[nbk][4 * gq + 2] + s[nbk][4 * gq + 3]);
                    const float eP = pxchg32(s[nbk][4 * gq + 3], hi);
                    const float add = (hi == 1) ? eP : eprev;
                    impq[8 * nbk + 2 * gq + hi] = G + add;
                    eprev = eP;
                }
                u32x4 w0, w1;
                w0.x = cvtpk(s[nbk][0], s[nbk][1]); w0.y = cvtpk(s[nbk][2], s[nbk][3]); w0.z = cvtpk(s[nbk][4], s[nbk][5]); w0.w = cvtpk(s[nbk][6], s[nbk][7]);
                w1.x = cvtpk(s[nbk][8], s[nbk][9]); w1.y = cvtpk(s[nbk][10], s[nbk][11]); w1.z = cvtpk(s[nbk][12], s[nbk][13]); w1.w = cvtpk(s[nbk][14], s[nbk][15]);
                const bf16x8 pa0 = __builtin_bit_cast(bf16x8, w0), pa1 = __builtin_bit_cast(bf16x8, w1);
#pragma unroll
                for (int d0 = 0; d0 < 2; ++d0) {
                    { const s16x4 lo = vtr(vlane + d0 * 16384 + (2 * nbk) * 1024), hi_ = vtr(vlane + d0 * 16384 + (2 * nbk) * 1024 + 512);
                      const bf16x8 vf = {lo[0], lo[1], lo[2], lo[3], hi_[0], hi_[1], hi_[2], hi_[3]}; o[d0] = __builtin_amdgcn_mfma_f32_32x32x16_bf16(pa0, vf, o[d0], 0, 0, 0); }
                    { const s16x4 lo = vtr(vlane + d0 * 16384 + (2 * nbk + 1) * 1024), hi_ = vtr(vlane + d0 * 16384 + (2 * nbk + 1) * 1024 + 512);
                      const bf16x8 vf = {lo[0], lo[1], lo[2], lo[3], hi_[0], hi_[1], hi_[2], hi_[3]}; o[d0] = __builtin_amdgcn_mfma_f32_32x32x16_bf16(pa1, vf, o[d0], 0, 0, 0); }
                }
            }
        }
        CM_LAS float* wsf = (CM_LAS float*)(lds + L_WSF2) + wave * 64;
        const float gc = bf2f(ACT[(m0 + t) * ACTW + A_GATE + h * 3 + 0]);
        if (hi == 0) wsf[r32] = gc;
        asm volatile("s_waitcnt lgkmcnt(0)" ::: "memory");
        bf16_t* OC = (bf16_t*)(ws + WS_OC) + (m0 + t0 + 32 * rb) * 384 + h * 64 + r32;
#pragma unroll
        for (int r = 0; r < 16; ++r) { const int q = crow(r, hi); const float gq = wsf[q]; OC[(size_t)q * 384] = f2bf(o[0][r] * gq); OC[(size_t)q * 384 + 32] = f2bf(o[1][r] * gq); }
    }
    __syncthreads();
    {
        const int q = tid >> 3, sub = tid & 7, t = t0 + q, cur = t >> 6; float v[8];
#pragma unroll
        for (int e = 0; e < 8; ++e) { const int j = sub * 8 + e; const float im = (imp[(0 * 64 + q) * IMP_RS + j] + imp[(1 * 64 + q) * IMP_RS + j]) + imp[(2 * 64 + q) * IMP_RS + j];
            const bool valid = (j * 64 <= t), forced = (j == 0) || (j == cur) || (j == cur - 1); v[e] = valid ? (forced ? 1e9f : im) : -1e9f; }
        u64 mask = 0ull;
        for (int rnd = 0; rnd < 16; ++rnd) {
            float bv = -3.0e38f; int bj = 64;
#pragma unroll
            for (int e = 0; e < 8; ++e) { if (v[e] > bv) { bv = v[e]; bj = sub * 8 + e; } }
            { const float ov = xs_f<1>(bv); const int oj = xs_i<1>(bj); if (ov > bv || (ov == bv && oj < bj)) { bv = ov; bj = oj; } }
            { const float ov = xs_f<2>(bv); const int oj = xs_i<2>(bj); if (ov > bv || (ov == bv && oj < bj)) { bv = ov; bj = oj; } }
            { const float ov = xs_f<4>(bv); const int oj = xs_i<4>(bj); if (ov > bv || (ov == bv && oj < bj)) { bv = ov; bj = oj; } }
            mask |= (1ull << (bj & 63));
#pragma unroll
            for (int e = 0; e < 8; ++e) if (bj == sub * 8 + e) v[e] = -3.4e38f;
        }
        const u64 vmask = (cur >= 63) ? ~0ull : ((1ull << (cur + 1)) - 1ull);
        if (sub == 0) ((u64*)(ws + WS_SEL))[(size_t)bg * SEQ + t] = mask & vmask;
    }
    __syncthreads();
}
__device__ __forceinline__ void cmp_phase(unsigned char* ws, lds_ptr lds, unsigned* qctr, int tid, int wave, int lane) {
    CM_LAS int* ubox = (CM_LAS int*)(lds + 131072 - 64);
    for (;;) {
        if (tid == 0) ubox[0] = (int)atomicAdd(qctr, 1u);
        __syncthreads();
        const int u = ubox[0];
        __syncthreads();
        if (u >= 1024) break;
        cmp_unit(ws, lds, u & 15, 63 - (u >> 4), tid, wave, lane);
    }
}
}
constexpr int NWAVES = 8;
constexpr int RING_BYTES = 131072;
constexpr int LDSCTL_OFF = RING_BYTES, MISC_OFF = LDSCTL_OFF + 320;
constexpr int LDS_BYTES = 147456;
constexpr int CW_BAR = 4096;
constexpr size_t CTL_ZERO_BYTES = 256 * 1024;
constexpr int CW_Q = 1024;

constexpr int PH_PRO = 0, PH_L0 = 1, PH_PER_LAYER = 6, PH_FINAL = 1 + 2 * PH_PER_LAYER, PH_COUNT = PH_FINAL + 1;
constexpr int PK_NORM = 0, PK_INPROJ = 1, PK_P3 = 2, PK_P4 = 3, PK_ATTN = 4, PK_OUTPROJ = 5;

struct Args { const void* in[19]; float* out; unsigned char* ws; RopeInv inv; int ph_lo, ph_hi; };

__device__ __forceinline__ float wave_sum(float v) {
    v += xs_f<1>(v); v += xs_f<2>(v); v += xs_f<4>(v); v += xs_f<8>(v); v += xs_f<16>(v); return psum32(v);
}

__device__ __forceinline__ int rope_head_base(int pn, int hh) {
    if (pn == 0) return 64 * hh;
    if (pn == 1) return (hh < 2) ? 256 + 64 * hh : 384 + 64 * (hh - 2);
    return (hh < 2) ? 640 + 64 * hh : 896 + 64 * (hh - 2);
}
__device__ __forceinline__ void gen_group(int L, int& base, int& op) {
    if (L < 4) { base = 512 + 32 * L; op = 0; }
    else if (L < 8) { base = 768 + 32 * (L - 4); op = 0; }
    else if (L < 12) { base = 1024 + 32 * (L - 8); op = 0; }
    else if (L < 22) { base = 1536 + 32 * (L - 12); op = 2; }
    else if (L < 42) { base = 1856 + 32 * (L - 22); op = 0; }
    else if (L < 48) { base = 2816 + 32 * (L - 42); op = 0; }
    else if (L < 60) { base = 1152 + 32 * (L - 48); op = 1; }
    else if (L < 70) { base = 2496 + 32 * (L - 60); op = 1; }
    else { base = 3200 + 32 * (L - 70); op = 1; }
}
__device__ __forceinline__ int phys_to_act(int pn, int p) {
    if (pn < 3) { const int f = p >> 7, hh = (p >> 5) & 3, i = p & 31; return rope_head_base(pn, hh) + 32 * f + i; }
    if (pn < 13) { int base, op; gen_group((pn - 3) * 8 + (p >> 5), base, op); return base + (p & 31); }
    const int bj = p >> 7, q = p & 127;
    if (q < 64) return A_MCKV + 64 * bj + q;
    if (q < 80) return A_MKR + 16 * bj + (q - 64);
    if (q < 96) { const int gi = 16 * bj + (q - 80); return gi < 18 ? A_GATE + gi : -1; }
    return -1;
}

struct EpiInProj {
    static constexpr bool PERM = true, AFTER_DRAIN = false;
    bf16_t* ACT; const float* cs64; const float* cs32; float* ssqp; bf16_t* MKp;
    __device__ __forceinline__ void operator()(const pg8::f32x4 (&acc)[2][2][4][2], const pg8::Unit& u, int wr, int wc, int fr, int fq) const {
        using pg8::cvt_pk_bf16; typedef pg8::u32x4 u32x4;
        const int pn = u.pn; const int row0 = u.pm * 256 + wr * 64 + fr;
        if (pn < 3) {
            const int hb = rope_head_base(pn, wc) + 8 * fq; const float sc = (pn == 0 || (pn == 1 && wc < 2)) ? QS_NSA : 1.f;
#pragma unroll
            for (int ai = 0; ai < 2; ++ai)
#pragma unroll
                for (int m = 0; m < 4; ++m) {
                    const int row = row0 + ai * 128 + m * 16;
                    const f32x4* cp = (const f32x4*)(cs64 + ((size_t)row * 32 + 8 * fq) * 2);
                    const f32x4 t0 = cp[0], t1 = cp[1], t2 = cp[2], t3 = cp[3];
                    const f32x4 a0 = acc[ai][0][m][0], a1 = acc[ai][0][m][1], b0 = acc[ai][1][m][0], b1 = acc[ai][1][m][1];
                    float o1[8], o2[8];
                    o1[0] = a0[0] * t0[0] - b0[0] * t0[1]; o2[0] = b0[0] * t0[0] + a0[0] * t0[1];
                    o1[1] = a0[1] * t0[2] - b0[1] * t0[3]; o2[1] = b0[1] * t0[2] + a0[1] * t0[3];
                    o1[2] = a0[2] * t1[0] - b0[2] * t1[1]; o2[2] = b0[2] * t1[0] + a0[2] * t1[1];
                    o1[3] = a0[3] * t1[2] - b0[3] * t1[3]; o2[3] = b0[3] * t1[2] + a0[3] * t1[3];
                    o1[4] = a1[0] * t2[0] - b1[0] * t2[1]; o2[4] = b1[0] * t2[0] + a1[0] * t2[1];
                    o1[5] = a1[1] * t2[2] - b1[1] * t2[3]; o2[5] = b1[1] * t2[2] + a1[1] * t2[3];
                    o1[6] = a1[2] * t3[0] - b1[2] * t3[1]; o2[6] = b1[2] * t3[0] + a1[2] * t3[1];
                    o1[7] = a1[3] * t3[2] - b1[3] * t3[3]; o2[7] = b1[3] * t3[2] + a1[3] * t3[3];
                    u32x4 w1, w2;
                    w1.x = cvt_pk_bf16(o1[0] * sc, o1[1] * sc); w1.y = cvt_pk_bf16(o1[2] * sc, o1[3] * sc); w1.z = cvt_pk_bf16(o1[4] * sc, o1[5] * sc); w1.w = cvt_pk_bf16(o1[6] * sc, o1[7] * sc);
                    w2.x = cvt_pk_bf16(o2[0] * sc, o2[1] * sc); w2.y = cvt_pk_bf16(o2[2] * sc, o2[3] * sc); w2.z = cvt_pk_bf16(o2[4] * sc, o2[5] * sc); w2.w = cvt_pk_bf16(o2[6] * sc, o2[7] * sc);
                    bf16_t* rp = ACT + (size_t)row * ACTW + hb;
                    *(u32x4*)rp = w1; *(u32x4*)(rp + 32) = w2;
                }
        } else if (pn < 13) {
#pragma unroll
            for (int bj = 0; bj < 2; ++bj) {
                int base, op; gen_group((pn - 3) * 8 + bj * 4 + wc, base, op);
#pragma unroll
                for (int ai = 0; ai < 2; ++ai)
#pragma unroll
                    for (int m = 0; m < 4; ++m) {
                        const int row = row0 + ai * 128 + m * 16;
                        f32x4 v0 = acc[ai][bj][m][0], v1 = acc[ai][bj][m][1];
                        if (op == 1) {
#pragma unroll
                            for (int e = 0; e < 4; ++e) { v0[e] = silu_f(v0[e]); v1[e] = silu_f(v1[e]); }
                        } else if (op == 2) { v0 = v0 * 0.125f; v1 = v1 * 0.125f; }
                        u32x4 w; w.x = cvt_pk_bf16(v0[0], v0[1]); w.y = cvt_pk_bf16(v0[2], v0[3]); w.z = cvt_pk_bf16(v1[0], v1[1]); w.w = cvt_pk_bf16(v1[2], v1[3]);
                        *(u32x4*)(ACT + (size_t)row * ACTW + base + 8 * fq) = w;
                        const int L = (pn - 3) * 8 + bj * 4 + wc;
                        if (L >= 42 && L < 48) {
                            float ss = (v0[0] * v0[0] + v0[1] * v0[1]) + (v0[2] * v0[2] + v0[3] * v0[3]) + (v1[0] * v1[0] + v1[1] * v1[1]) + (v1[2] * v1[2] + v1[3] * v1[3]);
                            ss += xs_f<16>(ss); ss = psum32(ss);
                            if (fq == 0) ssqp[(size_t)row * 16 + (L - 42)] = ss;
                        }
                    }
            }
        } else {
            if (wc < 2) {
#pragma unroll
                for (int bj = 0; bj < 2; ++bj)
#pragma unroll
                    for (int ai = 0; ai < 2; ++ai)
#pragma unroll
                        for (int m = 0; m < 4; ++m) {
                            const int row = row0 + ai * 128 + m * 16;
                            const f32x4 v0 = acc[ai][bj][m][0], v1 = acc[ai][bj][m][1];
                            u32x4 w; w.x = cvt_pk_bf16(v0[0], v0[1]); w.y = cvt_pk_bf16(v0[2], v0[3]); w.z = cvt_pk_bf16(v1[0], v1[1]); w.w = cvt_pk_bf16(v1[2], v1[3]);
                            *(u32x4*)(ACT + (size_t)row * ACTW + A_MCKV + 64 * bj + 32 * wc + 8 * fq) = w;
                            float ss = (v0[0] * v0[0] + v0[1] * v0[1]) + (v0[2] * v0[2] + v0[3] * v0[3]) + (v1[0] * v1[0] + v1[1] * v1[1]) + (v1[2] * v1[2] + v1[3] * v1[3]);
                            ss += xs_f<16>(ss); ss = psum32(ss);
                            if (fq == 0) ssqp[(size_t)row * 16 + 6 + bj * 2 + wc] = ss;
                        }
            } else if (wc == 2) {
#pragma unroll
                for (int ai = 0; ai < 2; ++ai)
#pragma unroll
                    for (int m = 0; m < 4; ++m) {
                        const int row = row0 + ai * 128 + m * 16;
                        const f32x4 a0 = acc[ai][0][m][0], a1 = acc[ai][0][m][1], b0 = acc[ai][1][m][0], b1 = acc[ai][1][m][1];
                        if (fq < 2) {
                            const f32x4* cp = (const f32x4*)(cs32 + ((size_t)row * 16 + 8 * fq) * 2);
                            const f32x4 t0 = cp[0], t1 = cp[1], t2 = cp[2], t3 = cp[3];
                            float o1[8], o2[8];
                            o1[0] = a0[0] * t0[0] - b0[0] * t0[1]; o2[0] = b0[0] * t0[0] + a0[0] * t0[1];
                            o1[1] = a0[1] * t0[2] - b0[1] * t0[3]; o2[1] = b0[1] * t0[2] + a0[1] * t0[3];
                            o1[2] = a0[2] * t1[0] - b0[2] * t1[1]; o2[2] = b0[2] * t1[0] + a0[2] * t1[1];
                            o1[3] = a0[3] * t1[2] - b0[3] * t1[3]; o2[3] = b0[3] * t1[2] + a0[3] * t1[3];
                            o1[4] = a1[0] * t2[0] - b1[0] * t2[1]; o2[4] = b1[0] * t2[0] + a1[0] * t2[1];
                            o1[5] = a1[1] * t2[2] - b1[1] * t2[3]; o2[5] = b1[1] * t2[2] + a1[1] * t2[3];
                            o1[6] = a1[2] * t3[0] - b1[2] * t3[1]; o2[6] = b1[2] * t3[0] + a1[2] * t3[1];
                            o1[7] = a1[3] * t3[2] - b1[3] * t3[3]; o2[7] = b1[3] * t3[2] + a1[3] * t3[3];
                            u32x4 w1, w2;
                            w1.x = cvt_pk_bf16(o1[0], o1[1]); w1.y = cvt_pk_bf16(o1[2], o1[3]); w1.z = cvt_pk_bf16(o1[4], o1[5]); w1.w = cvt_pk_bf16(o1[6], o1[7]);
                            w2.x = cvt_pk_bf16(o2[0], o2[1]); w2.y = cvt_pk_bf16(o2[2], o2[3]); w2.z = cvt_pk_bf16(o2[4], o2[5]); w2.w = cvt_pk_bf16(o2[6], o2[7]);
                            bf16_t* rp = ACT + (size_t)row * ACTW + A_MKR + 8 * fq;
                            *(u32x4*)rp = w1; *(u32x4*)(rp + 16) = w2;
#pragma unroll
                            for (int hh = 0; hh < 5; ++hh) { bf16_t* kp = MKp + (size_t)row * 480 + hh * 96 + 64 + 8 * fq; *(u32x4*)kp = w1; *(u32x4*)(kp + 16) = w2; }
                        } else {
                            const int g0 = 8 * (fq - 2);
                            float ga[8], gb[8];
#pragma unroll
                            for (int e = 0; e < 4; ++e) { ga[e] = a0[e]; ga[4 + e] = a1[e]; gb[e] = b0[e]; gb[4 + e] = b1[e]; }
#pragma unroll
                            for (int e = 0; e < 8; ++e) { ga[e] = (g0 + e < 18) ? sigm_f(ga[e]) : 0.f; gb[e] = (16 + g0 + e < 18) ? sigm_f(gb[e]) : 0.f; }
                            u32x4 w1, w2;
                            w1.x = cvt_pk_bf16(ga[0], ga[1]); w1.y = cvt_pk_bf16(ga[2], ga[3]); w1.z = cvt_pk_bf16(ga[4], ga[5]); w1.w = cvt_pk_bf16(ga[6], ga[7]);
                            w2.x = cvt_pk_bf16(gb[0], gb[1]); w2.y = cvt_pk_bf16(gb[2], gb[3]); w2.z = cvt_pk_bf16(gb[4], gb[5]); w2.w = cvt_pk_bf16(gb[6], gb[7]);
                            bf16_t* rp = ACT + (size_t)row * ACTW + A_GATE + g0;
                            *(u32x4*)rp = w1; *(u32x4*)(rp + 16) = w2;
                        }
                    }
            }
        }
    }
};

struct EpiOutProj {
    static constexpr bool PERM = false, AFTER_DRAIN = false;
    const float* xin; float* xout; const float* gate;
    __device__ __forceinline__ void operator()(const pg8::f32x4 (&acc)[2][2][4][2], const pg8::Unit& u, int wr, int wc, int fr, int fq) const {
        const int col0 = u.pn * 256 + wc * 32 + 4 * fq;
#pragma unroll
        for (int ai = 0; ai < 2; ++ai)
#pragma unroll
            for (int m = 0; m < 4; ++m) {
                const int row = u.pm * 256 + ai * 128 + wr * 64 + m * 16 + fr; const int b = row / SEQ;
                const size_t off = (size_t)row * DM + col0; const float* gp = gate + (size_t)b * 3072 + col0;
#pragma unroll
                for (int bj = 0; bj < 2; ++bj)
#pragma unroll
                    for (int n = 0; n < 2; ++n) {
                        const f32x4 g4 = *(const f32x4*)(gp + bj * 128 + n * 16); const f32x4 xi = *(const f32x4*)(xin + off + bj * 128 + n * 16);
                        *(f32x4*)(xout + off + bj * 128 + n * 16) = xi + g4 * acc[ai][bj][m][n];
                    }
            }
    }
};

__device__ __forceinline__ int wuq_src(int p) {
    if (p < 256) return (p >> 6) * 96 + (p & 63);
    const int q = p - 256, bj = q >> 7, r = q & 127;
    if (r < 80) return (r >> 4) * 96 + 64 + 16 * bj + (r & 15);
    const int idx = (r - 80) + 48 * bj; return idx < 64 ? 4 * 96 + idx : -1;
}
__device__ __forceinline__ int wukv_src(int p) {
    if (p < 320) return (p >> 6) * 128 + (p & 63);
    if (p < 640) { const int q = p - 320; return (q >> 6) * 128 + 64 + (q & 63); }
    return -1;
}
struct EpiQUp {
    static constexpr bool PERM = true, AFTER_DRAIN = false;
    bf16_t* MQ; const float* ssqp; const float* cs32;
    __device__ __forceinline__ void operator()(const pg8::f32x4 (&acc)[2][2][4][2], const pg8::Unit& u, int wr, int wc, int fr, int fq) const {
        using pg8::cvt_pk_bf16; typedef pg8::u32x4 u32x4;
        const int row0 = u.pm * 256 + wr * 64 + fr; const int q = 32 * wc + 8 * fq;
#pragma unroll
        for (int ai = 0; ai < 2; ++ai)
#pragma unroll
            for (int m = 0; m < 4; ++m) {
                const int row = row0 + ai * 128 + m * 16;
                const f32x4 sa = *(const f32x4*)(ssqp + (size_t)row * 16); const float2 sb = *(const float2*)(ssqp + (size_t)row * 16 + 4);
                const float rs = rsqrtf(((sa[0] + sa[1]) + (sa[2] + sa[3]) + (sb.x + sb.y)) * (1.f / 192.f) + 1e-6f) * QS_MLA;
                const f32x4 a0 = acc[ai][0][m][0], a1 = acc[ai][0][m][1], b0 = acc[ai][1][m][0], b1 = acc[ai][1][m][1];
                bf16_t* rowp = MQ + (size_t)row * 480;
                if (u.pn == 0) {
                    u32x4 w1, w2;
                    w1.x = cvt_pk_bf16(a0[0] * rs, a0[1] * rs); w1.y = cvt_pk_bf16(a0[2] * rs, a0[3] * rs); w1.z = cvt_pk_bf16(a1[0] * rs, a1[1] * rs); w1.w = cvt_pk_bf16(a1[2] * rs, a1[3] * rs);
                    w2.x = cvt_pk_bf16(b0[0] * rs, b0[1] * rs); w2.y = cvt_pk_bf16(b0[2] * rs, b0[3] * rs); w2.z = cvt_pk_bf16(b1[0] * rs, b1[1] * rs); w2.w = cvt_pk_bf16(b1[2] * rs, b1[3] * rs);
                    *(u32x4*)(rowp + (q >> 6) * 96 + (q & 63)) = w1;
                    *(u32x4*)(rowp + (2 + (q >> 6)) * 96 + (q & 63)) = w2;
                } else if (q < 80) {
                    const int head = q >> 4, i = q & 15;
                    const f32x4* cp = (const f32x4*)(cs32 + ((size_t)row * 16 + i) * 2);
                    const f32x4 t0 = cp[0], t1 = cp[1], t2 = cp[2], t3 = cp[3];
                    float o1[8], o2[8];
                    o1[0] = a0[0] * t0[0] - b0[0] * t0[1]; o2[0] = b0[0] * t0[0] + a0[0] * t0[1];
                    o1[1] = a0[1] * t0[2] - b0[1] * t0[3]; o2[1] = b0[1] * t0[2] + a0[1] * t0[3];
                    o1[2] = a0[2] * t1[0] - b0[2] * t1[1]; o2[2] = b0[2] * t1[0] + a0[2] * t1[1];
                    o1[3] = a0[3] * t1[2] - b0[3] * t1[3]; o2[3] = b0[3] * t1[2] + a0[3] * t1[3];
                    o1[4] = a1[0] * t2[0] - b1[0] * t2[1]; o2[4] = b1[0] * t2[0] + a1[0] * t2[1];
                    o1[5] = a1[1] * t2[2] - b1[1] * t2[3]; o2[5] = b1[1] * t2[2] + a1[1] * t2[3];
                    o1[6] = a1[2] * t3[0] - b1[2] * t3[1]; o2[6] = b1[2] * t3[0] + a1[2] * t3[1];
                    o1[7] = a1[3] * t3[2] - b1[3] * t3[3]; o2[7] = b1[3] * t3[2] + a1[3] * t3[3];
                    u32x4 w1, w2;
                    w1.x = cvt_pk_bf16(o1[0] * rs, o1[1] * rs); w1.y = cvt_pk_bf16(o1[2] * rs, o1[3] * rs); w1.z = cvt_pk_bf16(o1[4] * rs, o1[5] * rs); w1.w = cvt_pk_bf16(o1[6] * rs, o1[7] * rs);
                    w2.x = cvt_pk_bf16(o2[0] * rs, o2[1] * rs); w2.y = cvt_pk_bf16(o2[2] * rs, o2[3] * rs); w2.z = cvt_pk_bf16(o2[4] * rs, o2[5] * rs); w2.w = cvt_pk_bf16(o2[6] * rs, o2[7] * rs);
                    *(u32x4*)(rowp + head * 96 + 64 + i) = w1; *(u32x4*)(rowp + head * 96 + 80 + i) = w2;
                } else {
                    const int idx0 = q - 80;
                    u32x4 w1; w1.x = cvt_pk_bf16(a0[0] * rs, a0[1] * rs); w1.y = cvt_pk_bf16(a0[2] * rs, a0[3] * rs); w1.z = cvt_pk_bf16(a1[0] * rs, a1[1] * rs); w1.w = cvt_pk_bf16(a1[2] * rs, a1[3] * rs);
                    *(u32x4*)(rowp + 384 + idx0) = w1;
                    if (48 + idx0 < 64) { u32x4 w2; w2.x = cvt_pk_bf16(b0[0] * rs, b0[1] * rs); w2.y = cvt_pk_bf16(b0[2] * rs, b0[3] * rs); w2.z = cvt_pk_bf16(b1[0] * rs, b1[1] * rs); w2.w = cvt_pk_bf16(b1[2] * rs, b1[3] * rs);
                        *(u32x4*)(rowp + 384 + 48 + idx0) = w2; }
                }
            }
    }
};
struct EpiKVUp {
    static constexpr bool PERM = true, AFTER_DRAIN = false;
    bf16_t* MKp; bf16_t* MV; const float* ssqp;
    __device__ __forceinline__ void operator()(const pg8::f32x4 (&acc)[2][2][4][2], const pg8::Unit& u, int wr, int wc, int fr, int fq) const {
        using pg8::cvt_pk_bf16; typedef pg8::u32x4 u32x4;
        const int row0 = u.pm * 256 + wr * 64 + fr;
#pragma unroll
        for (int ai = 0; ai < 2; ++ai)
#pragma unroll
            for (int m = 0; m < 4; ++m) {
                const int row = row0 + ai * 128 + m * 16;
                const f32x4 sa = *(const f32x4*)(ssqp + (size_t)row * 16 + 6 - 2);
                const float2 sb = *(const float2*)(ssqp + (size_t)row * 16 + 8);
                const float rs = rsqrtf(((sa[2] + sa[3]) + (sb.x + sb.y)) * (1.f / 128.f) + 1e-6f);
#pragma unroll
                for (int bj = 0; bj < 2; ++bj) {
                    const int p = u.pn * 256 + 128 * bj + 32 * wc + 8 * fq;
                    const f32x4 v0 = acc[ai][bj][m][0] * rs, v1 = acc[ai][bj][m][1] * rs;
                    u32x4 w; w.x = cvt_pk_bf16(v0[0], v0[1]); w.y = cvt_pk_bf16(v0[2], v0[3]); w.z = cvt_pk_bf16(v1[0], v1[1]); w.w = cvt_pk_bf16(v1[2], v1[3]);
                    if (p < 320) *(u32x4*)(MKp + (size_t)row * 480 + (p >> 6) * 96 + (p & 63)) = w;
                    else if (p < 640) *(u32x4*)(MV + (size_t)row * 320 + (p - 320)) = w;
                }
            }
    }
};

__device__ __forceinline__ void tr_item(const float* W, int ldw, int srccol, bf16_t* WT, int K, int wt_row0, int k0, LAS float* scr, int lane, const float* kscale = nullptr) {
#pragma unroll 8
    for (int i = 0; i < 32; ++i) { const int kk = 2 * i + (lane >> 5); float v = (srccol >= 0) ? W[(size_t)(k0 + kk) * ldw + srccol] : 0.f; if (kscale) v *= kscale[k0 + kk]; scr[kk * 33 + (lane & 31)] = v; }
    LDS_WAIT(); asm volatile("" ::: "memory");
    const int c = lane & 7;
#pragma unroll
    for (int j = 0; j < 4; ++j) { const int n = (lane >> 3) + 8 * j; const LAS float* s = scr + (8 * c) * 33 + n;
        v4u o; o.x = pk2(s[0 * 33], s[1 * 33]); o.y = pk2(s[2 * 33], s[3 * 33]); o.z = pk2(s[4 * 33], s[5 * 33]); o.w = pk2(s[6 * 33], s[7 * 33]);
        *(v4u*)(WT + (size_t)(wt_row0 + n) * K + k0 + 8 * c) = o; }
    LDS_WAIT(); asm volatile("" ::: "memory");
}

struct MK {
    LAS unsigned char* lds; int tid, lane, wave, G, bid; float* out; unsigned char* ws;
};
#define ARGF(A, i) ((const float*)(A).in[i])

__device__ __forceinline__ void ph_prologue(MK& F, const Args& A) {
    const RopeInv& inv = A.inv;
    float* mod = (float*)(F.ws + WS_MOD);
    {
        LAS float* red = (LAS float*)F.lds;
        for (int item = F.bid; item < DEPTH * 48; item += F.G) {
            const int l = item / 48, col = (item % 48) * 64 + F.lane;
            float acc[NB];
#pragma unroll
            for (int b = 0; b < NB; ++b) acc[b] = 0.f;
            const float* cvec = ARGF(A, 1); const float* adab = ARGF(A, 4);
            const float* wp = ARGF(A, 3) + ((size_t)l * DM + F.wave * 128) * 3072 + col;
            for (int k = 0; k < 128; ++k) { const float w = wp[(size_t)k * 3072];
#pragma unroll
                for (int b = 0; b < NB; ++b) { const float cv = cvec[b * DM + F.wave * 128 + k]; acc[b] += silu_f(cv) * w; } }
#pragma unroll
            for (int b = 0; b < NB; ++b) red[(F.wave * NB + b) * 64 + F.lane] = acc[b];
            __syncthreads();
            { const int b = F.tid >> 6; float s = adab[l * 3072 + col];
#pragma unroll
              for (int w = 0; w < 8; ++w) s += red[(w * NB + b) * 64 + F.lane];
              mod[((size_t)l * NB + b) * 3072 + col] = s; }
            __syncthreads();
        }
    }
    const int gw = F.bid * NWAVES + F.wave, NGW = F.G * NWAVES;
    {
        LAS float* scr = (LAS float*)(F.lds + F.wave * 16384);
        bf16_t* WIN_T = (bf16_t*)(F.ws + WS_WIN_T); bf16_t* WOUT_T = (bf16_t*)(F.ws + WS_WOUT_T);
        bf16_t* WUQ_T = (bf16_t*)(F.ws + WS_WUQ_T); bf16_t* WUKV_T = (bf16_t*)(F.ws + WS_WUKV_T);
        constexpr int I_IN = 16 * 112, I_OUT = 16 * 32, I_UQ = 4 * 16, I_UKV = 2 * 24, I_W1 = 2 * 128, I_W2 = 2 * 4, I_PB = 2 * 32, I_L = I_IN + I_OUT + I_UQ + I_UKV + I_W1 + I_W2 + I_PB, NIT = DEPTH * I_L;
        for (int it = gw; it < NIT; it += NGW) {
            int r = it; const int l = r / I_L; r -= l * I_L;
            if (r < I_IN) { const int kb = r / 112, nb = r % 112; const int prow = nb * 32 + (F.lane & 31); const int act = phys_to_act(prow >> 8, prow & 255); const int src = (act < 0) ? -1 : inproj_src_col(act);
                tr_item(ARGF(A, 6) + (size_t)l * DM * D_IN, D_IN, src, WIN_T + (size_t)l * 3584 * DM, DM, nb * 32, kb * 64, scr, F.lane); }
            else if (r < I_IN + I_OUT) { r -= I_IN; const int kb = r / 32, nb = r % 32;
                tr_item(ARGF(A, 17) + (size_t)l * DM * DM, DM, nb * 32 + (F.lane & 31), WOUT_T + (size_t)l * DM * DM, DM, nb * 32, kb * 64, scr, F.lane); }
            else if (r < I_IN + I_OUT + I_UQ) { r -= I_IN + I_OUT; const int kb = r / 16, nb = r % 16;
                const int src = (kb < 3) ? wuq_src(nb * 32 + (F.lane & 31)) : -1;
                tr_item(ARGF(A, 14) + (size_t)l * 192 * 480, 480, src, WUQ_T + (size_t)l * 512 * 256, 256, nb * 32, kb * 64, scr, F.lane, (kb < 3) ? ARGF(A, 13) + l * 192 : nullptr); }
            else if (r < I_IN + I_OUT + I_UQ + I_UKV) { r -= I_IN + I_OUT + I_UQ; const int kb = r / 24, nb = r % 24;
                tr_item(ARGF(A, 16) + (size_t)l * 128 * 640, 640, wukv_src(nb * 32 + (F.lane & 31)), WUKV_T + (size_t)l * 768 * 128, 128, nb * 32, kb * 64, scr, F.lane, ARGF(A, 15) + l * 128); }
            else if (r < I_IN + I_OUT + I_UQ + I_UKV + I_W1) { r -= I_IN + I_OUT + I_UQ + I_UKV; const int kv = r / 128, kb = (r % 128) / 4, nb = r % 4;
                tr_item(ARGF(A, kv ? 11 : 9) + (size_t)l * 2048 * 128, 128, nb * 32 + (F.lane & 31), (bf16_t*)(F.ws + WS_W1T) + (size_t)(l * 2 + kv) * 128 * 2048, 2048, nb * 32, kb * 64, scr, F.lane); }
            else if (r < I_IN + I_OUT + I_UQ + I_UKV + I_W1 + I_W2) { r -= I_IN + I_OUT + I_UQ + I_UKV + I_W1; const int kv = r / 4, kb = (r % 4) / 2, nb = r % 2;
                tr_item(ARGF(A, kv ? 12 : 10) + (size_t)l * 128 * 64, 64, nb * 32 + (F.lane & 31), (bf16_t*)(F.ws + WS_W2T) + (size_t)(l * 2 + kv) * 64 * 128, 128, nb * 32, kb * 64, scr, F.lane); }
            else { r -= I_IN + I_OUT + I_UQ + I_UKV + I_W1 + I_W2; const int kv = r / 32, ch = r % 32;
                const float* pe = ARGF(A, kv ? 8 : 7) + (size_t)l * 2048 + ch * 64; const float* w1 = ARGF(A, kv ? 11 : 9) + ((size_t)l * 2048 + ch * 64) * 128;
                float s0 = 0.f, s1 = 0.f;
                for (int k = 0; k < 64; ++k) { const float pv_ = pe[k]; s0 += pv_ * w1[(size_t)k * 128 + F.lane]; s1 += pv_ * w1[(size_t)k * 128 + 64 + F.lane]; }
                float* pb = (float*)(F.ws + WS_POSBP) + ((size_t)(l * 2 + kv) * 32 + ch) * 128; pb[F.lane] = s0; pb[64 + F.lane] = s1; }
        }
    }
    {
        float* cs64 = (float*)(F.ws + WS_CS64); float* cs32 = (float*)(F.ws + WS_CS32);
        for (int idx = F.bid * 512 + F.tid; idx < M * 48; idx += F.G * 512) {
            const int m = idx / 48, i = idx % 48; const float p = (float)((const int*)A.in[2])[m]; float s, c;
            if (i < 32) { sincos_rev(p * inv.i64[i], s, c); *(float2*)(cs64 + ((size_t)m * 32 + i) * 2) = make_float2(c, s); }
            else { const int j = i - 32; sincos_rev(p * inv.i32[j], s, c); *(float2*)(cs32 + ((size_t)m * 16 + j) * 2) = make_float2(c, s); }
        }
    }
}

__device__ __forceinline__ void ph_norm_mod(MK& F, const Args& A, const float* xin, int l) {
    const float* g = ARGF(A, 5) + l * DM; const float* mod = (const float*)(F.ws + WS_MOD) + (size_t)l * NB * 3072; bf16_t* H = (bf16_t*)(F.ws + WS_H);
    const int gw = F.bid * NWAVES + F.wave, NGW = F.G * NWAVES;
    for (int row = gw; row < M; row += NGW) {
        const int b = row / SEQ; const f32x4* xr = (const f32x4*)(xin + (size_t)row * DM) + F.lane; f32x4 v[4]; float ss = 0.f;
#pragma unroll
        for (int j = 0; j < 4; ++j) { v[j] = xr[64 * j]; ss += (v[j].x * v[j].x + v[j].y * v[j].y) + (v[j].z * v[j].z + v[j].w * v[j].w); }
        const float r = rsqrtf(wave_sum(ss) * (1.f / DM) + 1e-6f);
        const float* sh = mod + (size_t)b * 3072; const float* sc = sh + 1024;
#pragma unroll
        for (int j = 0; j < 4; ++j) { const int c = 256 * j + 4 * F.lane; const f32x4 g4 = *(const f32x4*)(g + c), s4 = *(const f32x4*)(sc + c), h4 = *(const f32x4*)(sh + c);
            const f32x4 h = v[j] * r * g4 * (s4 + 1.f) + h4;
            uint2 o; o.x = pk2(h.x, h.y); o.y = pk2(h.z, h.w); *(uint2*)(H + (size_t)row * DM + c) = o; }
    }
}
__device__ __forceinline__ void ph_final_norm(MK& F, const Args& A) {
    const float* fnorm = ARGF(A, 18);
    const int gw = F.bid * NWAVES + F.wave, NGW = F.G * NWAVES;
    for (int row = gw; row < M; row += NGW) {
        f32x4* xr = (f32x4*)(F.out + (size_t)row * DM) + F.lane; f32x4 v[4]; float ss = 0.f;
#pragma unroll
        for (int j = 0; j < 4; ++j) { v[j] = xr[64 * j]; ss += (v[j].x * v[j].x + v[j].y * v[j].y) + (v[j].z * v[j].z + v[j].w * v[j].w); }
        const float r = rsqrtf(wave_sum(ss) * (1.f / DM) + 1e-6f);
#pragma unroll
        for (int j = 0; j < 4; ++j) { const f32x4 g4 = *(const f32x4*)(fnorm + 256 * j + 4 * F.lane); xr[64 * j] = v[j] * r * g4; }
    }
}

__global__ void __launch_bounds__(NWAVES * 64, 2) mk_fwd(Args args) {
    extern __shared__ __attribute__((aligned(16))) unsigned char lds[];
    MK F;
    const int s_wave = __builtin_amdgcn_readfirstlane((int)threadIdx.x >> 6);
    F.lds = (LAS unsigned char*)lds; F.tid = threadIdx.x; F.lane = F.tid & 63; F.wave = s_wave; F.G = gridDim.x; F.bid = blockIdx.x;
    F.out = args.out; F.ws = args.ws;
    for (int u = F.tid; u < (LDS_BYTES - LDSCTL_OFF) / 4; u += NWAVES * 64) ((LAS unsigned*)(F.lds + LDSCTL_OFF))[u] = 0u;
    __syncthreads();
    cooperative_groups::grid_group grid = cooperative_groups::this_grid();
    const int lo = args.ph_lo, hi = args.ph_hi;
    for (int ph = lo; ph < hi; ++ph) {
        { int bid_ = blockIdx.x; asm volatile("" : "+s"(bid_)); F.bid = bid_; }
#define FRESH_TID(var) int var; asm volatile("v_mbcnt_lo_u32_b32 %0, -1, 0\n\tv_mbcnt_hi_u32_b32 %0, -1, %0" : "=v"(var)); var += s_wave * 64
        if (ph == PH_PRO) { FRESH_TID(t_); F.tid = t_; F.lane = t_ & 63; ph_prologue(F, args); }
        else if (ph == PH_FINAL) { FRESH_TID(t_); F.tid = t_; F.lane = t_ & 63; ph_final_norm(F, args); }
        else {
            const int l = (ph - PH_L0) / PH_PER_LAYER, k = (ph - PH_L0) % PH_PER_LAYER;
            const float* xin = (l == 0) ? ARGF(args, 0) : F.out;
            if (k == PK_NORM) { FRESH_TID(t_); F.tid = t_; F.lane = t_ & 63; ph_norm_mod(F, args, xin, l); }
            else if (k == PK_INPROJ) {
                pg8::Gemm g = pg8::make_gemm((const bf16_t*)(F.ws + WS_H), DM, (const bf16_t*)(F.ws + WS_WIN_T) + (size_t)l * 3584 * DM, DM, M, 3584, DM);
                pg8::StaticOrder S; S.init(M, 3584, F.G, F.bid);
                EpiInProj E{(bf16_t*)(F.ws + WS_ACT), (const float*)(F.ws + WS_CS64), (const float*)(F.ws + WS_CS32), (float*)(F.ws + WS_SSQP), (bf16_t*)(F.ws + WS_MK)};
                { FRESH_TID(ftid); pg8::gemm_phase<EpiInProj, pg8::StaticOrder, true, true>(F.lds, g, S, E, ftid); }
            } else if (k == PK_P3) {
                { pg8::Gemm g = pg8::make_gemm((const bf16_t*)(F.ws + WS_ACT) + A_MCQ, ACTW, (const bf16_t*)(F.ws + WS_WUQ_T) + (size_t)l * 512 * 256, 256, M, 512, 256);
                  pg8::StaticOrder S; S.init(M, 512, F.G, F.bid);
                  EpiQUp E{(bf16_t*)(F.ws + WS_MQ), (const float*)(F.ws + WS_SSQP), (const float*)(F.ws + WS_CS32)};
                  { FRESH_TID(ftid); pg8::gemm_phase<EpiQUp, pg8::StaticOrder, true, true>(F.lds, g, S, E, ftid); } }
                { pg8::Gemm g = pg8::make_gemm((const bf16_t*)(F.ws + WS_ACT) + A_MCKV, ACTW, (const bf16_t*)(F.ws + WS_WUKV_T) + (size_t)l * 768 * 128, 128, M, 768, 128);
                  pg8::StaticOrder S; S.init(M, 768, F.G, F.bid);
                  EpiKVUp E{(bf16_t*)(F.ws + WS_MK), (bf16_t*)(F.ws + WS_MV), (const float*)(F.ws + WS_SSQP)};
                  { FRESH_TID(ftid); pg8::gemm_phase<EpiKVUp, pg8::StaticOrder, true, true>(F.lds, g, S, E, ftid); } }
                { FRESH_TID(t_); cm::compress_phase(F.ws, (fa::lds_ptr)F.lds, l, F.bid, F.G, t_, s_wave, t_ & 63); }
            } else if (k == PK_P4) {
                { FRESH_TID(t_); cm::cmp_phase(F.ws, (fa::lds_ptr)F.lds, (unsigned*)(F.ws + WS_CTL) + CW_Q + 64 * (2 + l), t_, s_wave, t_ & 63); }
            } else if (k == PK_ATTN) {
                { FRESH_TID(t_); fa::attn_phase(F.ws, (fa::lds_ptr)F.lds, (unsigned*)(F.ws + WS_CTL) + CW_Q + 64 * l, t_, s_wave, t_ & 63); }
            } else if (k == PK_OUTPROJ) {
                pg8::Gemm g = pg8::make_gemm((const bf16_t*)(F.ws + WS_MIX), DM, (const bf16_t*)(F.ws + WS_WOUT_T) + (size_t)l * DM * DM, DM, M, DM, DM);
                pg8::StaticOrder S; S.init(M, DM, F.G, F.bid);
                EpiOutProj E{xin, F.out, (const float*)(F.ws + WS_MOD) + (size_t)l * NB * 3072 + 2048};
                { FRESH_TID(ftid); pg8::gemm_phase<EpiOutProj, pg8::StaticOrder, true, true>(F.lds, g, S, E, ftid); }
            }
        }
        if (ph + 1 < hi) grid.sync();
    }
}
static int g_grid = 0;
static void launch_mk(Args a, int lo, int hi, hipStream_t stream) {
    a.ph_lo = lo; a.ph_hi = hi;
    if (hi - lo > 1) { void* params[] = {&a}; hipLaunchCooperativeKernel((const void*)mk_fwd, dim3(g_grid), dim3(NWAVES * 64), params, LDS_BYTES, stream); }
    else hipLaunchKernelGGL(mk_fwd, dim3(g_grid), dim3(NWAVES * 64), LDS_BYTES, stream, a);
}
extern "C" void kernel_launch(void* const* d_in, const int* in_sizes, int n_in, void* d_out, int out_size, void* d_ws, size_t ws_size, hipStream_t stream) {
    if (n_in != 19 || out_size != M * DM || ws_size < WS_END) { fprintf(stderr, "kernel_launch: unexpected shapes (n_in %d out %d ws %zu)\n", n_in, out_size, ws_size); return; }
    if (g_grid == 0) {
        int dev = 0, cus = 0, per_cu = 0;
        hipGetDevice(&dev); hipDeviceGetAttribute(&cus, hipDeviceAttributeMultiprocessorCount, dev);
        hipFuncSetAttribute((const void*)mk_fwd, hipFuncAttributeMaxDynamicSharedMemorySize, LDS_BYTES);
        hipOccupancyMaxActiveBlocksPerMultiprocessor(&per_cu, (const void*)mk_fwd, NWAVES * 64, LDS_BYTES);
        if (per_cu < 1) { fprintf(stderr, "kernel_launch: occupancy query says %d blocks per CU\n", per_cu); per_cu = 1; }
        g_grid = cus;
        (void)hipGetLastError();
    }
    char* ws = (char*)d_ws;
    Args a{};
    for (int i = 0; i < 19; ++i) a.in[i] = d_in[i];
    a.out = (float*)d_out; a.ws = (unsigned char*)d_ws;
    for (int i = 0; i < 32; ++i) a.inv.i64[i] = (float)std::pow(10000.0, -(double)i / 32.0);
    for (int i = 0; i < 16; ++i) a.inv.i32[i] = (float)std::pow(10000.0, -(double)i / 16.0);
    hipMemsetAsync(ws + WS_CTL, 0, CTL_ZERO_BYTES, stream);

    launch_mk(a, 0, PH_COUNT, stream);
}
```

```cpp
#include <hip/hip_runtime.h>
#include <cstdio>
#include <cstdint>
#include <cmath>
#include <hip/hip_cooperative_groups.h>

typedef unsigned short bf16_t;
typedef unsigned long long u64;

constexpr int NB = 8, SEQ = 4096, DM = 1024, M = NB * SEQ, DEPTH = 2;
constexpr int D_IN = 3506;
constexpr int NCMP = 255;
constexpr int ACTW = 3584;
constexpr int A_NQ = 0, A_KC = 384, A_VC = 512, A_KS = 640, A_VS = 768, A_KW = 896, A_VW = 1024;
constexpr int A_NZ = 1152, A_SQ = 1536, A_SK = 1856, A_SV = 2176, A_SZ = 2496;
constexpr int A_MCQ = 2816, A_MCKV = 3008, A_MKR = 3136, A_GATE = 3168, A_MZ = 3200;
constexpr float LOG2E = 1.4426950408889634f;
constexpr float QS_NSA = 0.125f * LOG2E;
constexpr float QS_MLA = 0.10206207261596577f * LOG2E;

constexpr size_t MiB = 1u << 20;
constexpr size_t WS_CTL = 0;
constexpr size_t WS_MOD = 1 * MiB;
constexpr size_t WS_CS64 = 2 * MiB;
constexpr size_t WS_CS32 = 10 * MiB;
constexpr size_t WS_POSB = 14 * MiB;
constexpr size_t WS_POSBP = 14 * MiB + 512 * 1024;
constexpr size_t WS_HID = 15 * MiB;
constexpr size_t WS_WIN_T = 20 * MiB;
constexpr size_t WS_WOUT_T = 34 * MiB;
constexpr size_t WS_WUQ_T = 38 * MiB;
constexpr size_t WS_WUKV_T = 39 * MiB;
constexpr size_t WS_W1T = 40 * MiB;
constexpr size_t WS_W2T = 42 * MiB;
constexpr size_t WS_SSQP = 44 * MiB;
constexpr size_t WS_H = 64 * MiB;
constexpr size_t WS_MIX = 64 * MiB;
constexpr size_t WS_ACT = 128 * MiB;
constexpr size_t WS_MQ = 352 * MiB;
constexpr size_t WS_MK = 382 * MiB;
constexpr size_t WS_MV = 412 * MiB;
constexpr size_t WS_OC = 432 * MiB;
constexpr size_t WS_KC = 456 * MiB;
constexpr size_t WS_VC = 457 * MiB;
constexpr size_t WS_SEL = 458 * MiB;
constexpr size_t WS_END = 460 * MiB;

__device__ __forceinline__ float bf2f(bf16_t v) { return __uint_as_float(((unsigned)v) << 16); }
__device__ __forceinline__ bf16_t f2bf(float f) { unsigned u = __float_as_uint(f); return (bf16_t)((u + 0x7fffu + ((u >> 16) & 1u)) >> 16); }
__device__ __forceinline__ float blo(unsigned u) { return __uint_as_float(u << 16); }
__device__ __forceinline__ float bhi(unsigned u) { return __uint_as_float(u & 0xffff0000u); }
__device__ __forceinline__ float silu_f(float v) { return v / (1.f + __expf(-v)); }
__device__ __forceinline__ float sigm_f(float v) { return 1.f / (1.f + __expf(-v)); }

struct RopeInv { float i64[32]; float i32[16]; };


#define GAS __attribute__((address_space(1)))
#define LAS __attribute__((address_space(3)))
typedef unsigned v4u __attribute__((ext_vector_type(4)));
typedef float f32x4 __attribute__((ext_vector_type(4)));
#define RLX_AGENT __ATOMIC_RELAXED, __HIP_MEMORY_SCOPE_AGENT
#define LDS_WAIT() asm volatile("s_waitcnt lgkmcnt(0)" ::: "memory")
#define VM_WAIT() asm volatile("s_waitcnt vmcnt(0)" ::: "memory")
__device__ __forceinline__ unsigned pk2(float lo, float hi) { return (unsigned)f2bf(lo) | ((unsigned)f2bf(hi) << 16); }

template <int MASK> __device__ __forceinline__ float xs_f(float v) { return __int_as_float(__builtin_amdgcn_ds_swizzle(__float_as_int(v), (MASK << 10) | 0x1f)); }
template <int MASK> __device__ __forceinline__ int xs_i(int v) { return __builtin_amdgcn_ds_swizzle(v, (MASK << 10) | 0x1f); }
__device__ __forceinline__ float psum32(float v) { auto rr = __builtin_amdgcn_permlane32_swap(__float_as_uint(v), __float_as_uint(v), false, false); return __uint_as_float(rr[0]) + __uint_as_float(rr[1]); }
__device__ __forceinline__ float pmax32(float v) { auto rr = __builtin_amdgcn_permlane32_swap(__float_as_uint(v), __float_as_uint(v), false, false); return fmaxf(__uint_as_float(rr[0]), __uint_as_float(rr[1])); }
__device__ __forceinline__ float pxchg32(float v, int hi) { auto rr = __builtin_amdgcn_permlane32_swap(__float_as_uint(v), __float_as_uint(v), false, false); return hi ? __uint_as_float(rr[0]) : __uint_as_float(rr[1]); }
namespace pg8 {
#define PG8_LAS __attribute__((address_space(3)))
typedef short bf16x8 __attribute__((ext_vector_type(8)));
typedef float f32x4 __attribute__((ext_vector_type(4)));
typedef unsigned u32x4 __attribute__((ext_vector_type(4)));
constexpr int BM = 256, BK = 64, HALF = 128, HTB = HALF * BK * 2  , STAGE_BYTES = 8 * HTB, NXCD = 8, WGM = 8;

__host__ __device__ __forceinline__ int lds_byte(int r, int c) { const int st = (r >> 4) * 2 + (c >> 5), rr = r & 15, cc = c & 31, ob = rr * 64 + cc * 2; return st * 1024 + (ob ^ (((ob >> 9) & 1) << 5)); }
__host__ __device__ __forceinline__ void stage_rc(int b, int& R, int& C) { const int st = b / 1024, sb = b % 1024, swz = sb ^ (((sb >> 9) & 1) << 5); R = (st >> 1) * 16 + swz / 64; C = (st & 1) * 32 + (swz % 64) / 2; }
__host__ __device__ __forceinline__ int perm32(int rho) { const int n = rho >> 4, i = rho & 15; return 8 * (i >> 2) + 4 * n + (i & 3); }

struct Unit { int pm, pn; };
struct Gemm { const bf16_t* A; const bf16_t* Bt; int lda, ldb, kstepA; size_t a_ts_hi, a_ts_lo; int M, N, K;
    __device__ __forceinline__ size_t a_off(int pm) const { return (size_t)(pm >> 1) * a_ts_hi + (size_t)(pm & 1) * a_ts_lo; } };
__host__ __device__ inline Gemm make_gemm(const bf16_t* A, int lda, const bf16_t* Bt, int ldb, int M, int N, int K) {
    Gemm g; g.A = A; g.Bt = Bt; g.lda = lda; g.ldb = ldb; g.kstepA = BK; g.a_ts_hi = (size_t)512 * lda * 2; g.a_ts_lo = (size_t)256 * lda * 2; g.M = M; g.N = N; g.K = K; return g; }

struct StaticOrder {
    int nM, nN, nwg, G, c;
    __host__ __device__ void init(int M, int N, int G_, int c_) { nM = M / BM; nN = N / BM; nwg = nM * nN; G = G_; c = c_; }
    __host__ __device__ bool next(int i, Unit& u) const {
        const long L = (long)i * G + c; if (L >= nwg) return false;
        int wgid = (int)L; { const int q = nwg / NXCD, r = nwg % NXCD, xcd = wgid % NXCD, off = wgid / NXCD; wgid = (xcd < r ? xcd * (q + 1) : r * (q + 1) + (xcd - r) * q) + off; }
        const int nig = WGM * nN, gid = wgid / nig, fm = gid * WGM, gsz = (nM - fm) < WGM ? (nM - fm) : WGM;
        u.pm = fm + ((wgid % nig) % gsz); u.pn = (wgid % nig) / gsz; return true;
    }
    __device__ __forceinline__ void a_ready(const Unit&) const {}
    __device__ __forceinline__ void done(const Unit&) const {}
};
__device__ __forceinline__ unsigned cvt_pk_bf16(float lo, float hi) { unsigned r; asm volatile("v_cvt_pk_bf16_f32 %0, %1, %2" : "=v"(r) : "v"(lo), "v"(hi)); return r; }

template <class Epi, class Sched, bool ALIGN_EPI = false, bool SP2 = false>
__device__ __forceinline__ void gemm_phase(PG8_LAS unsigned char* lds, const Gemm g, const Sched& S, const Epi& E, int tid_in) {
    int tid_ = tid_in; asm volatile("" : "+v"(tid_));
    const int tid = tid_, wid = __builtin_amdgcn_readfirstlane(tid >> 6), lane = tid & 63, wr = wid >> 2, wc = wid & 3, fr = lane & 15, fq = lane >> 4;
    const int K = g.K, nt = K / BK;
    unsigned voffA[2], voffB[2];
#pragma unroll
    for (int i = 0; i < 2; ++i) { int R, C; stage_rc(tid * 16 + i * 8192, R, C); const int Rb = Epi::PERM ? ((R & ~31) + perm32(R & 31)) : R;
        voffA[i] = (unsigned)(R * g.lda + C) * 2u; voffB[i] = (unsigned)(Rb * g.ldb + C) * 2u; }
    const size_t kstepA = (size_t)g.kstepA * 2, kstepB = (size_t)(BK * 2);
    const size_t hstepA = (size_t)HALF * g.lda * 2, hstepB = (size_t)HALF * g.ldb * 2;
    const size_t tstepB = 2 * hstepB;
    const unsigned ldsw = (unsigned)wid * 1024u;
    const int aoff = lds_byte(wr * 64 + fr, fq * 8), boff = lds_byte(wc * 32 + fr, fq * 8);
#define PG8_SA(b, h) (((b) * 2 + (h)) * HTB)
#define PG8_SB(b, h) ((4 + (b) * 2 + (h)) * HTB)
#define PG8_STAGE(bufoff, gbase, voff) do { _Pragma("unroll") for (int _i = 0; _i < 2; ++_i) \
        __builtin_amdgcn_global_load_lds((const unsigned*)((const char*)(gbase) + (voff)[_i]), (PG8_LAS unsigned*)(lds + (bufoff) + ldsw + _i * 8192), 16, 0, 0); } while (0)
#define PG8_LDA(dst, b, h) do { _Pragma("unroll") for (int m = 0; m < 4; ++m) _Pragma("unroll") for (int k = 0; k < 2; ++k) dst[m][k] = *(const PG8_LAS bf16x8*)(lds + PG8_SA(b, h) + aoff + m * 2048 + k * 1024); } while (0)
#define PG8_LDB(dst, b, h) do { _Pragma("unroll") for (int n = 0; n < 2; ++n) _Pragma("unroll") for (int k = 0; k < 2; ++k) dst[n][k] = *(const PG8_LAS bf16x8*)(lds + PG8_SB(b, h) + boff + n * 2048 + k * 1024); } while (0)
#define PG8_MMA(ai, bj, At, Bt) do { __builtin_amdgcn_s_setprio(1); _Pragma("unroll") for (int m = 0; m < 4; ++m) _Pragma("unroll") for (int n = 0; n < 2; ++n) _Pragma("unroll") for (int k = 0; k < 2; ++k) \
        acc[ai][bj][m][n] = __builtin_amdgcn_mfma_f32_16x16x32_bf16(Bt[n][k], At[m][k], acc[ai][bj][m][n], 0, 0, 0); __builtin_amdgcn_s_setprio(0); } while (0)
#define PG8_WAIT_V(n) asm volatile("s_waitcnt vmcnt(" #n ")" ::: "memory")
#define PG8_WAIT_L(n) asm volatile("s_waitcnt lgkmcnt(" #n ")" ::: "memory")
#define PG8_BAR __builtin_amdgcn_s_barrier()
#define PG8_SCHED __builtin_amdgcn_sched_barrier(0)
    Unit cur, nxt; int ui = 0;
    if (!S.next(0, cur)) return;
    f32x4 acc[2][2][4][2];
#pragma unroll
    for (int a = 0; a < 2; ++a)
#pragma unroll
        for (int b = 0; b < 2; ++b)
#pragma unroll
            for (int m = 0; m < 4; ++m)
#pragma unroll
                for (int n = 0; n < 2; ++n) acc[a][b][m][n] = (f32x4){0.f, 0.f, 0.f, 0.f};
    bf16x8 At[4][2], B0[2][2], B1[2][2];
    const char* cA = (const char*)g.A + g.a_off(cur.pm); const char* cB = (const char*)g.Bt + (size_t)cur.pn * tstepB;
    S.a_ready(cur);
    if constexpr (SP2) {
        PG8_STAGE(PG8_SB(0, 0), cB, voffB); PG8_STAGE(PG8_SB(0, 1), cB + hstepB, voffB); PG8_STAGE(PG8_SA(0, 0), cA, voffA); PG8_STAGE(PG8_SA(0, 1), cA + hstepA, voffA);
        if (wr == 1) PG8_BAR;
        PG8_WAIT_V(2); PG8_BAR;
        PG8_STAGE(PG8_SB(1, 0), cB + kstepB, voffB); PG8_STAGE(PG8_SA(1, 0), cA + kstepA, voffA); PG8_STAGE(PG8_SB(1, 1), cB + hstepB + kstepB, voffB);
        PG8_WAIT_V(6); PG8_BAR;
    } else {
        PG8_STAGE(PG8_SB(0, 0), cB, voffB); PG8_STAGE(PG8_SA(0, 0), cA, voffA); PG8_STAGE(PG8_SB(0, 1), cB + hstepB, voffB); PG8_STAGE(PG8_SA(0, 1), cA + hstepA, voffA);
        if (wr == 1) PG8_BAR;
        PG8_WAIT_V(4); PG8_BAR;
        PG8_STAGE(PG8_SB(1, 0), cB + kstepB, voffB); PG8_STAGE(PG8_SA(1, 0), cA + kstepA, voffA); PG8_STAGE(PG8_SB(1, 1), cB + hstepB + kstepB, voffB);
        PG8_WAIT_V(6); PG8_BAR;
    }
    for (;;) {
        const bool has_next = S.next(ui + 1, nxt);
        const char* nA = has_next ? (const char*)g.A + g.a_off(nxt.pm) : cA; const char* nB = has_next ? (const char*)g.Bt + (size_t)nxt.pn * tstepB : cB;
        for (int t = 0; t < nt; t += 2) {
            const bool last = (t == nt - 2);
            const char* a1 = cA + (size_t)(t + 1) * kstepA;
            const char* a2 = last ? nA : cA + (size_t)(t + 2) * kstepA; const char* b2 = last ? nB : cB + (size_t)(t + 2) * kstepB;
            const char* a3 = a2 + kstepA; const char* b3 = b2 + kstepB;
            if (last && has_next) S.a_ready(nxt);
            if constexpr (SP2) {
            PG8_LDB(B0, 0, 0); PG8_LDB(B1, 0, 1); PG8_SCHED; PG8_LDA(At, 0, 0); PG8_STAGE(PG8_SA(1, 1), a1 + hstepA, voffA);
            PG8_WAIT_V(8); PG8_WAIT_L(0); PG8_BAR; PG8_MMA(0, 0, At, B0); PG8_MMA(0, 1, At, B1); PG8_BAR; PG8_SCHED;
            PG8_LDA(At, 0, 1); PG8_STAGE(PG8_SB(0, 0), b2, voffB); PG8_STAGE(PG8_SB(0, 1), b2 + hstepB, voffB); PG8_STAGE(PG8_SA(0, 0), a2, voffA);
            PG8_WAIT_V(8); PG8_WAIT_L(0); PG8_BAR; PG8_MMA(1, 0, At, B0); PG8_MMA(1, 1, At, B1); PG8_BAR; PG8_SCHED;
            PG8_LDB(B0, 1, 0); PG8_LDB(B1, 1, 1); PG8_SCHED; PG8_LDA(At, 1, 0); PG8_STAGE(PG8_SA(0, 1), a2 + hstepA, voffA);
            PG8_WAIT_V(8); PG8_WAIT_L(0); PG8_BAR; PG8_MMA(0, 0, At, B0); PG8_MMA(0, 1, At, B1); PG8_BAR; PG8_SCHED;
            PG8_LDA(At, 1, 1); PG8_STAGE(PG8_SB(1, 0), b3, voffB); PG8_STAGE(PG8_SB(1, 1), b3 + hstepB, voffB); PG8_STAGE(PG8_SA(1, 0), a3, voffA);
            PG8_WAIT_V(8); PG8_WAIT_L(0); PG8_BAR; PG8_MMA(1, 0, At, B0); PG8_MMA(1, 1, At, B1); PG8_BAR; PG8_SCHED;
            } else {
            PG8_LDB(B0, 0, 0); PG8_SCHED; PG8_LDA(At, 0, 0); PG8_STAGE(PG8_SA(1, 1), a1 + hstepA, voffA);
            PG8_WAIT_L(8); PG8_BAR; PG8_WAIT_L(0); PG8_MMA(0, 0, At, B0); PG8_BAR; PG8_SCHED;
            PG8_LDB(B1, 0, 1); PG8_STAGE(PG8_SB(0, 0), b2, voffB);
            PG8_BAR; PG8_WAIT_L(0); PG8_MMA(0, 1, At, B1); PG8_BAR;
            PG8_LDA(At, 0, 1); PG8_STAGE(PG8_SA(0, 0), a2, voffA);
            PG8_BAR; PG8_WAIT_L(0); PG8_MMA(1, 0, At, B0); PG8_BAR; PG8_SCHED;
            PG8_STAGE(PG8_SB(0, 1), b2 + hstepB, voffB);
            PG8_WAIT_V(6); PG8_BAR; PG8_MMA(1, 1, At, B1); PG8_BAR;
            PG8_LDB(B0, 1, 0); PG8_SCHED; PG8_LDA(At, 1, 0); PG8_STAGE(PG8_SA(0, 1), a2 + hstepA, voffA);
            PG8_WAIT_L(8); PG8_BAR; PG8_WAIT_L(0); PG8_MMA(0, 0, At, B0); PG8_BAR; PG8_SCHED;
            PG8_LDB(B1, 1, 1); PG8_STAGE(PG8_SB(1, 0), b3, voffB);
            PG8_BAR; PG8_WAIT_L(0); PG8_MMA(0, 1, At, B1); PG8_BAR;
            PG8_LDA(At, 1, 1); PG8_STAGE(PG8_SA(1, 0), a3, voffA);
            PG8_BAR; PG8_WAIT_L(0); PG8_MMA(1, 0, At, B0); PG8_BAR; PG8_SCHED;
            PG8_STAGE(PG8_SB(1, 1), b3 + hstepB, voffB);
            PG8_WAIT_V(6); PG8_BAR; PG8_MMA(1, 1, At, B1); PG8_BAR;
            }
        }
        if constexpr (ALIGN_EPI) { if (wr == 0) PG8_BAR; }
        if constexpr (!Epi::AFTER_DRAIN) { E(acc, cur, wr, wc, fr, fq); S.done(cur); }
        if (!has_next) break;
#pragma unroll
        for (int a = 0; a < 2; ++a)
#pragma unroll
            for (int b = 0; b < 2; ++b)
#pragma unroll
                for (int m = 0; m < 4; ++m)
#pragma unroll
                    for (int n = 0; n < 2; ++n) acc[a][b][m][n] = (f32x4){0.f, 0.f, 0.f, 0.f};
        cur = nxt; cA = nA; cB = nB; ++ui;
        if constexpr (ALIGN_EPI) { if (wr == 1) PG8_BAR; }
    }
    PG8_WAIT_V(0);
    if constexpr (!ALIGN_EPI) { if (wr == 0) PG8_BAR; }
    PG8_BAR;
    if constexpr (Epi::AFTER_DRAIN) { E.fused(acc, cur, wr, wc, fr, fq, lds, wid, lane); S.done(cur); }
#undef PG8_SA
#undef PG8_SB
#undef PG8_STAGE
#undef PG8_LDA
#undef PG8_LDB
#undef PG8_MMA
#undef PG8_WAIT_V
#undef PG8_WAIT_L
#undef PG8_BAR
#undef PG8_SCHED
}
}
#define XB_TMO      128
#define XB_XCNT(j)  (256  + 64 * (j))
#define XB_XSUB(j)  (1280 + 64 * (j))
#define XB_XGEN(j)  (2304 + 64 * (j))
#define XB_TOP      3328
#define XB_TOPGEN   3392
#define XCD_BAR_WORDS 3456
#define XB_SPIN_CAP (1u << 18)

__device__ __forceinline__ unsigned xb_ld(unsigned* p)              { return __hip_atomic_load(p, __ATOMIC_RELAXED, __HIP_MEMORY_SCOPE_AGENT); }
__device__ __forceinline__ unsigned xb_add(unsigned* p, unsigned v) { return __hip_atomic_fetch_add(p, v, __ATOMIC_RELAXED, __HIP_MEMORY_SCOPE_AGENT); }
__device__ __forceinline__ unsigned xb_xcc_id() { return (unsigned)__builtin_amdgcn_s_getreg((3 << 11) | 20) & 0xFu; }
#define XB_SPIN(cond, bar) do { unsigned _sp = 0; while (cond) { __builtin_amdgcn_s_sleep(1); \
    if ((++_sp & 255u) == 0u) { if (xb_ld(&(bar)[XB_TMO])) break; if (_sp > XB_SPIN_CAP) { atomicAdd(&(bar)[XB_TMO], 1u); break; } } } } while (0)

struct XcdBarrier {
    unsigned* bar; unsigned x;
    volatile LAS unsigned* st;
};

__device__ __forceinline__ XcdBarrier xcd_barrier_post(unsigned* bar, volatile LAS unsigned* st) {
    XcdBarrier b; b.bar = bar; b.x = xb_xcc_id(); b.st = st;
    if (threadIdx.x == 0) (void)xb_add(&bar[XB_XCNT(b.x)], 1u);
    return b;
}
__device__ __forceinline__ void xcd_barrier_complete(unsigned* bar, unsigned x, unsigned& nloc, unsigned& nx) {
    const unsigned G = gridDim.x * gridDim.y * gridDim.z;
    unsigned sum, cnt, mine, sp = 0u;
    for (;;) {
        sum = 0u; cnt = 0u; mine = 0u;
#pragma unroll
        for (unsigned j = 0; j < 16; ++j) { const unsigned c = xb_ld(&bar[XB_XCNT(j)]); sum += c; cnt += (c > 0u) ? 1u : 0u; mine = (j == x) ? c : mine; }
        if (sum == G) break;
        __builtin_amdgcn_s_sleep(1);
        if ((++sp & 255u) == 0u) { if (xb_ld(&bar[XB_TMO])) break; if (sp > XB_SPIN_CAP) { atomicAdd(&bar[XB_TMO], 1u); break; } }
    }
    nloc = mine > 0u ? mine : 1u; nx = cnt > 0u ? cnt : 1u;
}

__device__ __forceinline__ void xcd_barrier(const XcdBarrier& b) {
    asm volatile("s_waitcnt vmcnt(0)" ::: "memory");
    __syncthreads();
    if (threadIdx.x == 0) {
        unsigned* bar = b.bar;
        __builtin_amdgcn_s_waitcnt(0);
        unsigned nloc = b.st[0], nx = b.st[1];
        if (nloc == 0u) { xcd_barrier_complete(bar, b.x, nloc, nx); b.st[0] = nloc; b.st[1] = nx; }
        const unsigned old = xb_add(&bar[XB_XSUB(b.x)], 1u);
        const unsigned gen = old / nloc;
        if (old + 1u == (gen + 1u) * nloc) {
            __builtin_amdgcn_fence(__ATOMIC_RELEASE, "agent");
            asm volatile("s_waitcnt vmcnt(0)" ::: "memory");
            const unsigned og = xb_add(&bar[XB_TOP], 1u);
            const unsigned tg = og / nx;
            if (og + 1u == (tg + 1u) * nx) xb_add(&bar[XB_TOPGEN], 1u);
            else XB_SPIN(xb_ld(&bar[XB_TOPGEN]) == tg, bar);
            __builtin_amdgcn_fence(__ATOMIC_ACQUIRE, "agent");
            xb_add(&bar[XB_XGEN(b.x)], 1u);
            asm volatile("s_waitcnt vmcnt(0)" ::: "memory");
        } else {
            XB_SPIN(xb_ld(&bar[XB_XGEN(b.x)]) == gen, bar);
            __builtin_amdgcn_fence(__ATOMIC_ACQUIRE, "agent");
            asm volatile("s_waitcnt vmcnt(0)" ::: "memory");
        }
    }
    __syncthreads();
}
__device__ __forceinline__ void sincos_rev(float ang, float& s, float& c) {
    double rev = (double)ang * 0.15915494309189535; rev -= rint(rev);
    float r = (float)rev; s = __builtin_amdgcn_sinf(r); c = __builtin_amdgcn_cosf(r);
}
__device__ __forceinline__ int inproj_src_col(int c) {
    if (c < 1152) return c;
    if (c < 1536) return 1170 + (c - 1152);
    if (c < 3168) return c + 18;
    if (c < 3200) return (c - 3168 < 18) ? 1152 + (c - 3168) : -1;
    if (c < 3520) return c - 14;
    return -1;
}
namespace fa {
typedef short bf16x8 __attribute__((ext_vector_type(8)));
typedef short s16x4 __attribute__((ext_vector_type(4)));
typedef float f32x16 __attribute__((ext_vector_type(16)));
typedef unsigned u32x4 __attribute__((ext_vector_type(4)));
typedef __attribute__((address_space(3))) const char* lds_cptr;
typedef __attribute__((address_space(3))) char* lds_ptr;
#define FA_LAS __attribute__((address_space(3)))

constexpr int STAGE_B = 20480, KIMG = 0, VIMG = 12288;
constexpr int L_WSF = 2 * STAGE_B, L_MISC = L_WSF + 2048, L_OST = L_MISC + 2048, OST_RS = 68, OST_WB = 32 * OST_RS * 4;
constexpr int L_END = L_OST + 8 * OST_WB;
static_assert(L_END <= 131072, "attention LDS map");
constexpr float NEG_INF = -INFINITY;
constexpr float THR = 6.0f;

__device__ __forceinline__ float ex2(float x) { return __builtin_amdgcn_exp2f(x); }
__device__ __forceinline__ int crow(int r, int hi) { return (r & 3) + 8 * (r >> 2) + 4 * hi; }
__device__ __forceinline__ unsigned cvtpk(float lo, float hi) { typedef float f2 __attribute__((ext_vector_type(2))); typedef __bf16 b2 __attribute__((ext_vector_type(2))); f2 v = {lo, hi}; b2 b = __builtin_convertvector(v, b2); return __builtin_bit_cast(unsigned, b); }

struct KVSrc { const bf16_t* K; const bf16_t* V; int kpitch, vpitch; };
struct StageRegs { u32x4 k0, k1, v; };

template <int NKC>
__device__ __forceinline__ void stage_load(StageRegs& R, const KVSrc& s, int key0, int tid, int wave, int lane) {
    R.k0 = *(const u32x4*)(s.K + (size_t)(key0 + (tid & 63)) * s.kpitch + (tid >> 6) * 8);
    if (NKC == 12) { if (tid < 256) R.k1 = *(const u32x4*)(s.K + (size_t)(key0 + (tid & 63)) * s.kpitch + (8 + (tid >> 6)) * 8); }
    R.v = *(const u32x4*)(s.V + (size_t)(key0 + 16 * (wave & 3) + (lane >> 2)) * s.vpitch + 32 * (wave >> 2) + 8 * (lane & 3));
}
template <int NKC>
__device__ __forceinline__ void stage_write(const StageRegs& R, lds_ptr st, int tid, int wave, int lane) {
    *(FA_LAS u32x4*)(st + KIMG + (tid >> 6) * 1024 + (tid & 63) * 16) = R.k0;
    if (NKC == 12) { if (tid < 256) *(FA_LAS u32x4*)(st + KIMG + (8 + (tid >> 6)) * 1024 + (tid & 63) * 16) = R.k1; }
    *(FA_LAS u32x4*)(st + VIMG + wave * 1024 + lane * 16) = R.v;
}

template <int NK>
__device__ __forceinline__ void qkt(f32x16& p0, f32x16& p1, lds_cptr Kimg, const bf16x8* qr, int r32, int hi) {
    lds_cptr kb = Kimg + hi * 1024 + r32 * 16;
    f32x16 z = {}; p0 = z; p1 = z;
#pragma unroll
    for (int d0 = 0; d0 < NK; ++d0) {
        const bf16x8 b0 = *(const FA_LAS bf16x8*)(kb + d0 * 2048), b1 = *(const FA_LAS bf16x8*)(kb + d0 * 2048 + 512);
        p0 = __builtin_amdgcn_mfma_f32_32x32x16_bf16(b0, qr[d0], p0, 0, 0, 0); p1 = __builtin_amdgcn_mfma_f32_32x32x16_bf16(b1, qr[d0], p1, 0, 0, 0);
    }
}
typedef short v4i16_t __attribute__((ext_vector_type(4)));
__device__ __forceinline__ s16x4 vtr(lds_cptr p) { return __builtin_bit_cast(s16x4, __builtin_amdgcn_ds_read_tr16_b64_v4i16((FA_LAS v4i16_t*)p)); }
__device__ __forceinline__ void pv(f32x16* o, lds_cptr vp, const u32x4& w0, const u32x4& w1, const u32x4& w2, const u32x4& w3) {
    const bf16x8 pa[4] = {__builtin_bit_cast(bf16x8, w0), __builtin_bit_cast(bf16x8, w1), __builtin_bit_cast(bf16x8, w2), __builtin_bit_cast(bf16x8, w3)};
#pragma unroll
    for (int d0 = 0; d0 < 2; ++d0)
#pragma unroll
        for (int ks = 0; ks < 4; ++ks) {
            const s16x4 lo = vtr(vp + d0 * 4096 + ks * 1024), hi_ = vtr(vp + d0 * 4096 + ks * 1024 + 512);
            const bf16x8 vf = {lo[0], lo[1], lo[2], lo[3], hi_[0], hi_[1], hi_[2], hi_[3]};
            o[d0] = __builtin_amdgcn_mfma_f32_32x32x16_bf16(pa[ks], vf, o[d0], 0, 0, 0);
        }
}
__device__ __forceinline__ float rowmax32(const f32x16& p0, const f32x16& p1) {
    float a = fmaxf(p0[0], p1[0]);
#pragma unroll
    for (int r = 1; r < 16; ++r) a = fmaxf(a, fmaxf(p0[r], p1[r]));
    return pmax32(a);
}

constexpr int MK_CAUSAL = 0, MK_SEL = 1, MK_WIN = 2;

template <int MKIND, int NK, int NKC>
__device__ __forceinline__ void softmax_branch(f32x16 (&o)[2], float& l, lds_ptr lds, const KVSrc& src, const bf16x8* qr, int t_lo, int t_hi, int qidx  ,
                                               int wrow0  , u64 selmask, int tid, int wave, int lane) {
    const int r32 = lane & 31, hi = lane >> 5;
    FA_LAS float* wsf = (FA_LAS float*)(lds + L_WSF) + wave * 64;
    lds_cptr vlane = (lds_cptr)lds + VIMG + ((lane >> 4) & 1) * 32 + (lane & 3) * 8 + (4 * hi + ((lane & 15) >> 2)) * 64;
    float m = NEG_INF; l = 0.f; { f32x16 z = {}; o[0] = z; o[1] = z; }
    StageRegs R;
    stage_load<NKC>(R, src, t_lo * 64, tid, wave, lane);
    stage_write<NKC>(R, lds, tid, wave, lane);
    __syncthreads();
    for (int t = t_lo; t <= t_hi; ++t) {
        const int cur = (t - t_lo) & 1; lds_ptr st = lds + cur * STAGE_B; lds_ptr stn = lds + (cur ^ 1) * STAGE_B;
        if (t < t_hi) stage_load<NKC>(R, src, (t + 1) * 64, tid, wave, lane);
        bool need;
        if (MKIND == MK_CAUSAL) need = (64 * t <= wrow0 + 31);
        else if (MKIND == MK_SEL) need = (64 * t <= wrow0 + 31) && __any((int)((selmask >> t) & 1ull));
        else need = (64 * t <= wrow0 + 31) && (64 * t + 63 > wrow0 - 512);
        if (need) {
            f32x16 p0, p1;
            qkt<NK>(p0, p1, (lds_cptr)st + KIMG, qr, r32, hi);
            if (64 * t + 63 > wrow0) {
                const int kb = 64 * t + 4 * hi;
#pragma unroll
                for (int r = 0; r < 16; ++r) { const int kv = kb + (r & 3) + 8 * (r >> 2); if (kv > qidx) p0[r] = NEG_INF; if (kv + 32 > qidx) p1[r] = NEG_INF; }
            }
            if (MKIND == MK_WIN) { if (64 * t <= wrow0 + 31 - 512) {
                const int kb = 64 * t + 4 * hi;
#pragma unroll
                for (int r = 0; r < 16; ++r) { const int kv = kb + (r & 3) + 8 * (r >> 2); if (kv <= qidx - 512) p0[r] = NEG_INF; if (kv + 32 <= qidx - 512) p1[r] = NEG_INF; }
            } }
            float rm = rowmax32(p0, p1);
            bool rowon = true;
            if (MKIND == MK_SEL) { rowon = ((selmask >> t) & 1ull) != 0ull; rm = rowon ? rm : NEG_INF; }
            if (__any(rm > m + THR)) {
                const float mn = fmaxf(m, rm); const float f = (mn == NEG_INF) ? 1.f : ex2(m - mn);
                l *= f; m = mn; if (hi == 0) wsf[r32] = f;
                asm volatile("s_waitcnt lgkmcnt(0)" ::: "memory");
#pragma unroll
                for (int g = 0; g < 4; ++g) { const f32x4 fv = *(const FA_LAS f32x4*)(wsf + 8 * g + 4 * hi);
#pragma unroll
                    for (int e = 0; e < 4; ++e) { o[0][4 * g + e] *= fv[e]; o[1][4 * g + e] *= fv[e]; } }
            }
            const float mu = rowon ? ((m == NEG_INF) ? 0.f : m) : INFINITY;
            float s = 0.f;
#pragma unroll
            for (int r = 0; r < 16; ++r) { p0[r] = ex2(p0[r] - mu); p1[r] = ex2(p1[r] - mu); s += p0[r] + p1[r]; }
            l += s;
            u32x4 w0, w1, w2, w3;
            w0.x = cvtpk(p0[0], p0[1]); w0.y = cvtpk(p0[2], p0[3]); w0.z = cvtpk(p0[4], p0[5]); w0.w = cvtpk(p0[6], p0[7]);
            w1.x = cvtpk(p0[8], p0[9]); w1.y = cvtpk(p0[10], p0[11]); w1.z = cvtpk(p0[12], p0[13]); w1.w = cvtpk(p0[14], p0[15]);
            w2.x = cvtpk(p1[0], p1[1]); w2.y = cvtpk(p1[2], p1[3]); w2.z = cvtpk(p1[4], p1[5]); w2.w = cvtpk(p1[6], p1[7]);
            w3.x = cvtpk(p1[8], p1[9]); w3.y = cvtpk(p1[10], p1[11]); w3.z = cvtpk(p1[12], p1[13]); w3.w = cvtpk(p1[14], p1[15]);
            pv(o, vlane + cur * STAGE_B, w0, w1, w2, w3);
        }
        if (t < t_hi) stage_write<NKC>(R, stn, tid, wave, lane);
        __syncthreads();
    }
}

__device__ __forceinline__ void add_scaled(f32x16 (&acc)[2], const f32x16 (&o)[2], float fac, FA_LAS float* wsf, int r32, int hi) {
    asm volatile("s_waitcnt lgkmcnt(0)" ::: "memory");
    if (hi == 0) wsf[r32] = fac;
    asm volatile("s_waitcnt lgkmcnt(0)" ::: "memory");
#pragma unroll
    for (int g = 0; g < 4; ++g) { const f32x4 fv = *(const FA_LAS f32x4*)(wsf + 8 * g + 4 * hi);
#pragma unroll
        for (int e = 0; e < 4; ++e) { acc[0][4 * g + e] += o[0][4 * g + e] * fv[e]; acc[1][4 * g + e] += o[1][4 * g + e] * fv[e]; } }
}
__device__ __forceinline__ void store_rows(const f32x16 (&acc)[2], lds_ptr lds, int wave, int lane, bf16_t* mixrow0  , const bf16_t* addrow0, int addpitch, const bf16_t* mulrow0, int mulpitch) {
    const int r32 = lane & 31, hi = lane >> 5;
    FA_LAS float* stg = (FA_LAS float*)(lds + L_OST + wave * OST_WB);
#pragma unroll
    for (int r = 0; r < 16; ++r) { const int q = crow(r, hi); stg[q * OST_RS + r32] = acc[0][r]; stg[q * OST_RS + 32 + r32] = acc[1][r]; }
    asm volatile("s_waitcnt lgkmcnt(0)" ::: "memory");
#pragma unroll
    for (int i = 0; i < 4; ++i) {
        const int row = i * 8 + (lane >> 3), ch = lane & 7;
        const f32x4 a = *(const FA_LAS f32x4*)(stg + row * OST_RS + ch * 8), b = *(const FA_LAS f32x4*)(stg + row * OST_RS + ch * 8 + 4);
        float v[8] = {a[0], a[1], a[2], a[3], b[0], b[1], b[2], b[3]};
        if (addrow0) { const uint4 ad = *(const uint4*)(addrow0 + (size_t)row * addpitch + ch * 8);
            v[0] += blo(ad.x); v[1] += bhi(ad.x); v[2] += blo(ad.y); v[3] += bhi(ad.y); v[4] += blo(ad.z); v[5] += bhi(ad.z); v[6] += blo(ad.w); v[7] += bhi(ad.w); }
        const uint4 mu = *(const uint4*)(mulrow0 + (size_t)row * mulpitch + ch * 8);
        v[0] *= blo(mu.x); v[1] *= bhi(mu.x); v[2] *= blo(mu.y); v[3] *= bhi(mu.y); v[4] *= blo(mu.z); v[5] *= bhi(mu.z); v[6] *= blo(mu.w); v[7] *= bhi(mu.w);
        uint4 ov; ov.x = cvtpk(v[0], v[1]); ov.y = cvtpk(v[2], v[3]); ov.z = cvtpk(v[4], v[5]); ov.w = cvtpk(v[6], v[7]);
        *(uint4*)(mixrow0 + (size_t)row * DM + ch * 8) = ov;
    }
    asm volatile("s_waitcnt lgkmcnt(0)" ::: "memory");
}

__device__ __forceinline__ void unit_mla(unsigned char* ws, lds_ptr lds, int b, int h, int qb, int tid, int wave, int lane) {
    const int r32 = lane & 31, hi = lane >> 5; const int q0 = qb * 256, wrow0 = q0 + 32 * wave, qidx = wrow0 + r32; const size_t m0 = (size_t)b * SEQ;
    const bf16_t* MQ = (const bf16_t*)(ws + WS_MQ); const bf16_t* MKp = (const bf16_t*)(ws + WS_MK); const bf16_t* MV = (const bf16_t*)(ws + WS_MV); const bf16_t* ACT = (const bf16_t*)(ws + WS_ACT); bf16_t* MIX = (bf16_t*)(ws + WS_MIX);
    bf16x8 qr[6];
#pragma unroll
    for (int d0 = 0; d0 < 6; ++d0) qr[d0] = *(const bf16x8*)(MQ + (m0 + qidx) * 480 + h * 96 + d0 * 16 + hi * 8);
    KVSrc src{MKp + m0 * 480 + h * 96, MV + m0 * 320 + h * 64, 480, 320};
    f32x16 o[2]; float l;
    softmax_branch<MK_CAUSAL, 6, 12>(o, l, lds, src, qr, 0, (q0 + 255) >> 6, qidx, wrow0, 0ull, tid, wave, lane);
    l = psum32(l);
    FA_LAS float* wsf = (FA_LAS float*)(lds + L_WSF) + wave * 64;
    f32x16 acc[2]; { f32x16 z = {}; acc[0] = z; acc[1] = z; }
    add_scaled(acc, o, 1.f / l, wsf, r32, hi);
    store_rows(acc, lds, wave, lane, MIX + (m0 + wrow0) * DM + 704 + h * 64, nullptr, 0, ACT + (m0 + wrow0) * ACTW + A_MZ + h * 64, ACTW);
}
__device__ __forceinline__ void unit_nsa(unsigned char* ws, lds_ptr lds, int b, int h, int qb, int tid, int wave, int lane) {
    const int r32 = lane & 31, hi = lane >> 5; const int q0 = qb * 256, wrow0 = q0 + 32 * wave, qidx = wrow0 + r32, g = h / 3; const size_t m0 = (size_t)b * SEQ;
    const bf16_t* ACT = (const bf16_t*)(ws + WS_ACT); const bf16_t* OC = (const bf16_t*)(ws + WS_OC); const u64* SEL = (const u64*)(ws + WS_SEL); bf16_t* MIX = (bf16_t*)(ws + WS_MIX);
    bf16x8 qr[4];
#pragma unroll
    for (int d0 = 0; d0 < 4; ++d0) qr[d0] = *(const bf16x8*)(ACT + (m0 + qidx) * ACTW + A_NQ + h * 64 + d0 * 16 + hi * 8);
    const u64 sel = SEL[(size_t)(b * 2 + g) * SEQ + qidx];
    const float gs = bf2f(ACT[(m0 + qidx) * ACTW + A_GATE + h * 3 + 1]), gw = bf2f(ACT[(m0 + qidx) * ACTW + A_GATE + h * 3 + 2]);
    FA_LAS float* wsf = (FA_LAS float*)(lds + L_WSF) + wave * 64;
    f32x16 acc[2]; { f32x16 z = {}; acc[0] = z; acc[1] = z; }
    {
        KVSrc src{ACT + m0 * ACTW + A_KS + g * 64, ACT + m0 * ACTW + A_VS + g * 64, ACTW, ACTW};
        f32x16 o[2]; float l;
        softmax_branch<MK_SEL, 4, 8>(o, l, lds, src, qr, 0, (q0 + 255) >> 6, qidx, wrow0, sel, tid, wave, lane);
        l = psum32(l);
        add_scaled(acc, o, gs / l, wsf, r32, hi);
    }
    {
        KVSrc src{ACT + m0 * ACTW + A_KW + g * 64, ACT + m0 * ACTW + A_VW + g * 64, ACTW, ACTW};
        f32x16 o[2]; float l; const int tlo = (q0 >= 512) ? ((q0 - 512) >> 6) : 0;
        softmax_branch<MK_WIN, 4, 8>(o, l, lds, src, qr, tlo, (q0 + 255) >> 6, qidx, wrow0, 0ull, tid, wave, lane);
        l = psum32(l);
        add_scaled(acc, o, gw / l, wsf, r32, hi);
    }
    store_rows(acc, lds, wave, lane, MIX + (m0 + wrow0) * DM + h * 64, OC + (m0 + wrow0) * 384 + h * 64, 384, ACT + (m0 + wrow0) * ACTW + A_NZ + h * 64, ACTW);
}

constexpr float SB_CUT = 104.0f;
__device__ __forceinline__ void unit_sb(unsigned char* ws, lds_ptr lds, int b, int h, int qb, int tid, int wave, int lane) {
    const int r32 = lane & 31, hi = lane >> 5; const int q0 = qb * 256, wrow0 = q0 + 32 * wave, qidx = wrow0 + r32; const size_t m0 = (size_t)b * SEQ;
    const bf16_t* ACT = (const bf16_t*)(ws + WS_ACT); bf16_t* MIX = (bf16_t*)(ws + WS_MIX);
    bf16x8 qr[4];
#pragma unroll
    for (int d0 = 0; d0 < 4; ++d0) qr[d0] = *(const bf16x8*)(ACT + (m0 + qidx) * ACTW + A_SQ + h * 64 + d0 * 16 + hi * 8);
    KVSrc src{ACT + m0 * ACTW + A_SK + h * 64, ACT + m0 * ACTW + A_SV + h * 64, ACTW, ACTW};
    FA_LAS unsigned* flags = (FA_LAS unsigned*)(lds + L_MISC) + 16;
    lds_cptr vlane = (lds_cptr)lds + VIMG + ((lane >> 4) & 1) * 32 + (lane & 3) * 8 + (4 * hi + ((lane & 15) >> 2)) * 64;
    f32x16 o[2]; { f32x16 z = {}; o[0] = z; o[1] = z; }
    float R = 0.f;
    const int t_hi = (q0 + 255) >> 6;
    StageRegs SR;
    stage_load<8>(SR, src, t_hi * 64, tid, wave, lane);
    stage_write<8>(SR, lds, tid, wave, lane);
    __syncthreads();
    for (int t = t_hi; t >= 0; --t) {
        const int it = t_hi - t, cur = it & 1; lds_ptr st = lds + cur * STAGE_B; lds_ptr stn = lds + (cur ^ 1) * STAGE_B;
        if (t > 0) stage_load<8>(SR, src, (t - 1) * 64, tid, wave, lane);
        const bool mydone = __all(R >= SB_CUT) != 0;
        const bool need = (64 * t < wrow0 + 31) && !mydone;
        if (need) {
            f32x16 p0, p1;
            qkt<4>(p0, p1, (lds_cptr)st + KIMG, qr, r32, hi);
            const bool diag = (64 * t + 63 >= wrow0);
            const int kb = 64 * t + 4 * hi;
            f32x16 s0, s1;
#pragma unroll
            for (int r = 0; r < 16; ++r) {
                const float z0 = p0[r], z1 = p1[r];
                float a0 = fmaxf(z0, 0.f) + 0.6931471805599453f * __log2f(1.f + ex2(-fabsf(z0) * LOG2E));
                float a1 = fmaxf(z1, 0.f) + 0.6931471805599453f * __log2f(1.f + ex2(-fabsf(z1) * LOG2E));
                if (diag) { const int kv = kb + (r & 3) + 8 * (r >> 2); if (kv >= qidx) a0 = 0.f; if (kv + 32 >= qidx) a1 = 0.f; }
                s0[r] = a0; s1[r] = a1;
            }
            float T[8];
#pragma unroll
            for (int i = 0; i < 4; ++i) {
                s0[4 * i + 2] += s0[4 * i + 3]; s0[4 * i + 1] += s0[4 * i + 2]; s0[4 * i] += s0[4 * i + 1]; T[i] = s0[4 * i];
                s1[4 * i + 2] += s1[4 * i + 3]; s1[4 * i + 1] += s1[4 * i + 2]; s1[4 * i] += s1[4 * i + 1]; T[4 + i] = s1[4 * i];
            }
            float TP[8];
#pragma unroll
            for (int i = 0; i < 8; ++i) TP[i] = pxchg32(T[i], hi);
            float accS = R, suf[8];
#pragma unroll
            for (int i = 7; i >= 0; --i) { suf[i] = accS + (hi == 0 ? TP[i] : 0.f); accS += T[i] + TP[i]; }
            R = accS;
#pragma unroll
            for (int r = 0; r < 16; ++r) {
                float a0 = ex2((p0[r] - (s0[r] + suf[r >> 2])) * LOG2E), a1 = ex2((p1[r] - (s1[r] + suf[4 + (r >> 2)])) * LOG2E);
                if (diag) { const int kv = kb + (r & 3) + 8 * (r >> 2); if (kv >= qidx) a0 = 0.f; if (kv + 32 >= qidx) a1 = 0.f; }
                p0[r] = a0; p1[r] = a1;
            }
            u32x4 w0, w1, w2, w3;
            w0.x = cvtpk(p0[0], p0[1]); w0.y = cvtpk(p0[2], p0[3]); w0.z = cvtpk(p0[4], p0[5]); w0.w = cvtpk(p0[6], p0[7]);
            w1.x = cvtpk(p0[8], p0[9]); w1.y = cvtpk(p0[10], p0[11]); w1.z = cvtpk(p0[12], p0[13]); w1.w = cvtpk(p0[14], p0[15]);
            w2.x = cvtpk(p1[0], p1[1]); w2.y = cvtpk(p1[2], p1[3]); w2.z = cvtpk(p1[4], p1[5]); w2.w = cvtpk(p1[6], p1[7]);
            w3.x = cvtpk(p1[8], p1[9]); w3.y = cvtpk(p1[10], p1[11]); w3.z = cvtpk(p1[12], p1[13]); w3.w = cvtpk(p1[14], p1[15]);
            pv(o, vlane + cur * STAGE_B, w0, w1, w2, w3);
        }
        const bool fin = (__all(R >= SB_CUT) != 0) || (t == 0);
        if (lane == 0) flags[cur * 8 + wave] = fin ? 1u : 0u;
        if (t > 0) stage_write<8>(SR, stn, tid, wave, lane);
        __syncthreads();
        unsigned alld = 1u;
#pragma unroll
        for (int w = 0; w < 8; ++w) alld &= flags[cur * 8 + w];
        if (alld) break;
    }
    __syncthreads();
    f32x16 acc[2]; acc[0] = o[0]; acc[1] = o[1];
    store_rows(acc, lds, wave, lane, MIX + (m0 + wrow0) * DM + 384 + h * 64, nullptr, 0, ACT + (m0 + wrow0) * ACTW + A_SZ + h * 64, ACTW);
}

constexpr int N_HEAVY = 16 * 88, N_UNITS = N_HEAVY + 16 * 40;
__device__ __forceinline__ void attn_phase(unsigned char* ws, lds_ptr lds, unsigned* qctr, int tid, int wave, int lane) {
    FA_LAS int* ubox = (FA_LAS int*)(lds + L_MISC);
    for (;;) {
        if (tid == 0) ubox[0] = (int)atomicAdd(qctr, 1u);
        __syncthreads();
        const int u = ubox[0];
        __syncthreads();
        if (u >= N_UNITS) break;
        if (u < N_HEAVY) { const int qb = 15 - u / 88, r = u % 88;
            if (r < 48) unit_nsa(ws, lds, r / 6, r % 6, qb, tid, wave, lane);
            else unit_mla(ws, lds, (r - 48) / 5, (r - 48) % 5, qb, tid, wave, lane);
        } else { const int v = u - N_HEAVY; unit_sb(ws, lds, (v % 40) / 5, v % 5, 15 - v / 40, tid, wave, lane); }
        __syncthreads();
    }
}
}
namespace cm {
using fa::bf16x8; using fa::f32x16; using fa::u32x4; using fa::lds_cptr; using fa::lds_ptr; using fa::crow; using fa::ex2; using fa::cvtpk; using fa::vtr; using fa::s16x4;
#define CM_LAS __attribute__((address_space(3)))

__device__ __forceinline__ int tok_off(int T, int c) { return T * 128 + (T >> 7) * 128 + ((c ^ ((T >> 4) & 7)) << 4); }
constexpr int L_TOK = 0, L_RED = 69632, L_HID = L_RED + 16384, HID_PITCH = 272;
__device__ __forceinline__ void compress_unit(unsigned char* ws, lds_ptr lds, int l, int kv, int bg, int nb, int tid, int wave, int lane) {
    const int b = bg >> 1, g = bg & 1, n0 = 32 * nb, r32 = lane & 31, hi = lane >> 5, cg = wave & 3, kh = wave >> 2;
    const bf16_t* ACT = (const bf16_t*)(ws + WS_ACT);
    const bf16_t* src = ACT + (size_t)b * SEQ * ACTW + (kv ? A_VC : A_KC) + g * 64;
    for (int idx = tid; idx < 528 * 8; idx += 512) { const int T = idx >> 3, c = idx & 7; int tok = 16 * n0 + T; tok = tok > SEQ - 1 ? SEQ - 1 : tok;
        *(CM_LAS u32x4*)(lds + L_TOK + tok_off(T, c)) = *(const u32x4*)(src + (size_t)tok * ACTW + c * 8); }
    __syncthreads();
    const bf16_t* W1T = (const bf16_t*)(ws + WS_W1T) + (size_t)((l * 2 + kv) * 128 + 32 * cg + r32) * 2048 + kh * 1024 + 8 * hi;
    f32x16 acc = {};
#pragma unroll 8
    for (int ks = 0; ks < 64; ++ks) {
        const int k = kh * 1024 + ks * 16 + 8 * hi; const int T = 16 * r32 + (k >> 6), c = (k & 63) >> 3;
        const bf16x8 a = *(const CM_LAS bf16x8*)(lds + L_TOK + tok_off(T, c));
        const bf16x8 bfrag = *(const bf16x8*)(W1T + ks * 16);
        acc = __builtin_amdgcn_mfma_f32_32x32x16_bf16(a, bfrag, acc, 0, 0, 0);
    }
    CM_LAS float* red = (CM_LAS float*)(lds + L_RED) + cg * 1024;
    if (kh == 1) {
#pragma unroll
        for (int r = 0; r < 16; ++r) red[r * 64 + lane] = acc[r];
    }
    __syncthreads();
    if (kh == 0) {
        const float* pp = (const float*)(ws + WS_POSBP) + (size_t)(l * 2 + kv) * 32 * 128 + 32 * cg + r32; float pb = 0.f;
        for (int i = 0; i < 32; ++i) pb += pp[i * 128];
#pragma unroll
        for (int r = 0; r < 16; ++r) { const float v = acc[r] + red[r * 64 + lane] + pb; const float s = silu_f(v);
            *(CM_LAS bf16_t*)(lds + L_HID + crow(r, hi) * HID_PITCH + (32 * cg + r32) * 2) = f2bf(s); }
    }
    __syncthreads();
    if (wave < 2) {
        const bf16_t* W2T = (const bf16_t*)(ws + WS_W2T) + (size_t)((l * 2 + kv) * 64 + 32 * wave + r32) * 128 + 8 * hi;
        f32x16 o = {};
#pragma unroll
        for (int ks = 0; ks < 8; ++ks) {
            const bf16x8 a = *(const CM_LAS bf16x8*)(lds + L_HID + r32 * HID_PITCH + (ks * 16 + 8 * hi) * 2);
            const bf16x8 bfrag = *(const bf16x8*)(W2T + ks * 16);
            o = __builtin_amdgcn_mfma_f32_32x32x16_bf16(a, bfrag, o, 0, 0, 0);
        }
        bf16_t* outp = (bf16_t*)(ws + (kv ? WS_VC : WS_KC)) + (size_t)bg * 256 * 64 + 32 * wave + r32;
#pragma unroll
        for (int r = 0; r < 16; ++r) { const int n = n0 + crow(r, hi); outp[(size_t)n * 64] = (n < NCMP) ? f2bf(o[r]) : (bf16_t)0; }
    }
    __syncthreads();
}
__device__ __forceinline__ void compress_phase(unsigned char* ws, lds_ptr lds, int l, int bid, int G, int tid, int wave, int lane) {
    for (int u = bid; u < 2 * 16 * 8; u += G) compress_unit(ws, lds, l, u >> 7, (u >> 3) & 15, u & 7, tid, wave, lane);
}

constexpr int L_KCI = 0, L_VCI = 32768, L_IMP = 65536, IMP_RS = 65, L_WSF2 = L_IMP + 3 * 64 * IMP_RS * 4;
static_assert(L_WSF2 + 2048 <= 131072, "cmp LDS map");
__device__ __forceinline__ void cmp_unit(unsigned char* ws, lds_ptr lds, int bg, int tb, int tid, int wave, int lane) {
    asm volatile("" : "+v"(tid), "+v"(lane));
    const int b = bg >> 1, g = bg & 1, t0 = 64 * tb, r32 = lane & 31, hi = lane >> 5; const size_t m0 = (size_t)b * SEQ;
    const bf16_t* ACT = (const bf16_t*)(ws + WS_ACT); const bf16_t* KC = (const bf16_t*)(ws + WS_KC) + (size_t)bg * 256 * 64; const bf16_t* VC = (const bf16_t*)(ws + WS_VC) + (size_t)bg * 256 * 64;
    const int tlast = t0 + 63; const int nvmax = (tlast >= 31) ? min(NCMP, (tlast - 31) / 16 + 1) : 0; const int nblk = (nvmax + 31) >> 5;
    CM_LAS float* imp = (CM_LAS float*)(lds + L_IMP);
    for (int i = tid; i < 3 * 64 * IMP_RS; i += 512) imp[i] = 0.f;
    for (int idx = tid; idx < nblk * 32 * 8; idx += 512) { const int key = idx >> 3, c = idx & 7;
        *(CM_LAS u32x4*)(lds + L_KCI + c * 4096 + key * 16) = *(const u32x4*)(KC + key * 64 + c * 8);
        *(CM_LAS u32x4*)(lds + L_VCI + (c >> 2) * 16384 + (key >> 4) * 1024 + (key & 15) * 64 + (c & 3) * 16) = *(const u32x4*)(VC + key * 64 + c * 8); }
    __syncthreads();
    if (wave < 6) {
        const int hh = wave >> 1, rb = wave & 1, h = 3 * g + hh; const int t = t0 + 32 * rb + r32;
        bf16x8 qr[4];
#pragma unroll
        for (int d0 = 0; d0 < 4; ++d0) qr[d0] = *(const bf16x8*)(ACT + (m0 + t) * ACTW + A_NQ + h * 64 + d0 * 16 + hi * 8);
        const int nv = (t >= 31) ? min(NCMP, (t - 31) / 16 + 1) : 0;
        f32x16 s[8];
        lds_cptr kb = (lds_cptr)lds + L_KCI + hi * 4096 + r32 * 16;
#pragma unroll
        for (int nbk = 0; nbk < 8; ++nbk) { f32x16 z = {}; s[nbk] = z;
            if (nbk < nblk) {
#pragma unroll
                for (int d0 = 0; d0 < 4; ++d0) { const bf16x8 kf = *(const CM_LAS bf16x8*)(kb + d0 * 8192 + nbk * 512); s[nbk] = __builtin_amdgcn_mfma_f32_32x32x16_bf16(kf, qr[d0], s[nbk], 0, 0, 0); }
            }
#pragma unroll
            for (int r = 0; r < 16; ++r) { const int n = 32 * nbk + crow(r, hi); if (n >= nv) s[nbk][r] = fa::NEG_INF; }
        }
        float mx = fa::NEG_INF;
#pragma unroll
        for (int nbk = 0; nbk < 8; ++nbk)
#pragma unroll
            for (int r = 0; r < 16; ++r) mx = fmaxf(mx, s[nbk][r]);
        mx = pmax32(mx);
        const float mu = (mx == fa::NEG_INF) ? 0.f : mx;
        float lsum = 0.f;
#pragma unroll
        for (int nbk = 0; nbk < 8; ++nbk)
#pragma unroll
            for (int r = 0; r < 16; ++r) { s[nbk][r] = ex2(s[nbk][r] - mu); lsum += s[nbk][r]; }
        lsum = psum32(lsum);
        const float inv = (lsum > 0.f) ? 1.f / lsum : 0.f;
        f32x16 o[2]; { f32x16 z = {}; o[0] = z; o[1] = z; }
        lds_cptr vlane = (lds_cptr)lds + L_VCI + ((lane >> 4) & 1) * 32 + (lane & 3) * 8 + (4 * hi + ((lane & 15) >> 2)) * 64;
        CM_LAS float* impq = imp + (hh * 64 + 32 * rb + r32) * IMP_RS;
        float eprev = 0.f;
#pragma unroll
        for (int nbk = 0; nbk < 8; ++nbk) {
            if (nbk < nblk) {
#pragma unroll
                for (int r = 0; r < 16; ++r) s[nbk][r] *= inv;
#pragma unroll
                for (int gq = 0; gq < 4; ++gq) {
                    const float G = (s[nbk][4 * gq] + s[nbk][4 * gq + 1]) + (s[nbk][4 * gq + 2] + s[nbk][4 * gq + 3]);
                    const float eP = pxchg32(s[nbk][4 * gq + 3], hi);
                    const float add = (hi == 1) ? eP : eprev;
                    impq[8 * nbk + 2 * gq + hi] = G + add;
                    eprev = eP;
                }
                u32x4 w0, w1;
                w0.x = cvtpk(s[nbk][0], s[nbk][1]); w0.y = cvtpk(s[nbk][2], s[nbk][3]); w0.z = cvtpk(s[nbk][4], s[nbk][5]); w0.w = cvtpk(s[nbk][6], s[nbk][7]);
                w1.x = cvtpk(s[nbk][8], s[nbk][9]); w1.y = cvtpk(s[nbk][10], s[nbk][11]); w1.z = cvtpk(s[nbk][12], s[nbk][13]); w1.w = cvtpk(s[nbk][14], s[nbk][15]);
                const bf16x8 pa0 = __builtin_bit_cast(bf16x8, w0), pa1 = __builtin_bit_cast(bf16x8, w1);
#pragma unroll
                for (int d0 = 0; d0 < 2; ++d0) {
                    { const s16x4 lo = vtr(vlane + d0 * 16384 + (2 * nbk) * 1024), hi_ = vtr(vlane + d0 * 16384 + (2 * nbk) * 1024 + 512);
                      const bf16x8 vf = {lo[0], lo[1], lo[2], lo[3], hi_[0], hi_[1], hi_[2], hi_[3]}; o[d0] = __builtin_amdgcn_mfma_f32_32x32x16_bf16(pa0, vf, o[d0], 0, 0, 0); }
                    { const s16x4 lo = vtr(vlane + d0 * 16384 + (2 * nbk + 1) * 1024), hi_ = vtr(vlane + d0 * 16384 + (2 * nbk + 1) * 1024 + 512);
                      const bf16x8 vf = {lo[0], lo[1], lo[2], lo[3], hi_[0], hi_[1], hi_[2], hi_[3]}; o[d0] = __builtin_amdgcn_mfma_f32_32x32x16_bf16(pa1, vf, o[d0], 0, 0, 0); }
                }
            }
        }
        CM_LAS float* wsf = (CM_LAS float*)(lds + L_WSF2) + wave * 64;
        const float gc = bf2f(ACT[(m0 + t) * ACTW + A_GATE + h * 3 + 0]);
        if (hi == 0) wsf[r32] = gc;
        asm volatile("s_waitcnt lgkmcnt(0)" ::: "memory");
        bf16_t* OC = (bf16_t*)(ws + WS_OC) + (m0 + t0 + 32 * rb) * 384 + h * 64 + r32;
#pragma unroll
        for (int r = 0; r < 16; ++r) { const int q = crow(r, hi); const float gq = wsf[q]; OC[(size_t)q * 384] = f2bf(o[0][r] * gq); OC[(size_t)q * 384 + 32] = f2bf(o[1][r] * gq); }
    }
    __syncthreads();
    {
        const int q = tid >> 3, sub = tid & 7, t = t0 + q, cur = t >> 6; float v[8];
#pragma unroll
        for (int e = 0; e < 8; ++e) { const int j = sub * 8 + e; const float im = (imp[(0 * 64 + q) * IMP_RS + j] + imp[(1 * 64 + q) * IMP_RS + j]) + imp[(2 * 64 + q) * IMP_RS + j];
            const bool valid = (j * 64 <= t), forced = (j == 0) || (j == cur) || (j == cur - 1); v[e] = valid ? (forced ? 1e9f : im) : -1e9f; }
        u64 mask = 0ull;
        for (int rnd = 0; rnd < 16; ++rnd) {
            float bv = -3.0e38f; int bj = 64;
#pragma unroll
            for (int e = 0; e < 8; ++e) { if (v[e] > bv) { bv = v[e]; bj = sub * 8 + e; } }
            { const float ov = xs_f<1>(bv); const int oj = xs_i<1>(bj); if (ov > bv || (ov == bv && oj < bj)) { bv = ov; bj = oj; } }
            { const float ov = xs_f<2>(bv); const int oj = xs_i<2>(bj); if (ov > bv || (ov == bv && oj < bj)) { bv = ov; bj = oj; } }
            { const float ov = xs_f<4>(bv); const int oj = xs_i<4>(bj); if (ov > bv || (ov == bv && oj < bj)) { bv = ov; bj = oj; } }
            mask |= (1ull << (bj & 63));
#pragma unroll
            for (int e = 0; e < 8; ++e) if (bj == sub * 8 + e) v[e] = -3.4e38f;
        }
        const u64 vmask = (cur >= 63) ? ~0ull : ((1ull << (cur + 1)) - 1ull);
        if (sub == 0) ((u64*)(ws + WS_SEL))[(size_t)bg * SEQ + t] = mask & vmask;
    }
    __syncthreads();
}
__device__ __forceinline__ void cmp_phase(unsigned char* ws, lds_ptr lds, unsigned* qctr, int tid, int wave, int lane) {
    CM_LAS int* ubox = (CM_LAS int*)(lds + 131072 - 64);
    for (;;) {
        if (tid == 0) ubox[0] = (int)atomicAdd(qctr, 1u);
        __syncthreads();
        const int u = ubox[0];
        __syncthreads();
        if (u >= 1024) break;
        cmp_unit(ws, lds, u & 15, 63 - (u >> 4), tid, wave, lane);
    }
}
}
constexpr int NWAVES = 8;
constexpr int RING_BYTES = 131072;
constexpr int LDSCTL_OFF = RING_BYTES, MISC_OFF = LDSCTL_OFF + 320;
constexpr int LDS_BYTES = 147456;
constexpr int CW_BAR = 4096;
constexpr size_t CTL_ZERO_BYTES = 256 * 1024;
constexpr int CW_Q = 1024;

constexpr int PH_PRO = 0, PH_L0 = 1, PH_PER_LAYER = 6, PH_FINAL = 1 + 2 * PH_PER_LAYER, PH_COUNT = PH_FINAL + 1;
constexpr int PK_NORM = 0, PK_INPROJ = 1, PK_P3 = 2, PK_P4 = 3, PK_ATTN = 4, PK_OUTPROJ = 5;

struct Args { const void* in[19]; float* out; unsigned char* ws; RopeInv inv; int ph_lo, ph_hi; };

__device__ __forceinline__ float wave_sum(float v) {
    v += xs_f<1>(v); v += xs_f<2>(v); v += xs_f<4>(v); v += xs_f<8>(v); v += xs_f<16>(v); return psum32(v);
}

__device__ __forceinline__ int rope_head_base(int pn, int hh) {
    if (pn == 0) return 64 * hh;
    if (pn == 1) return (hh < 2) ? 256 + 64 * hh : 384 + 64 * (hh - 2);
    return (hh < 2) ? 640 + 64 * hh : 896 + 64 * (hh - 2);
}
__device__ __forceinline__ void gen_group(int L, int& base, int& op) {
    if (L < 4) { base = 512 + 32 * L; op = 0; }
    else if (L < 8) { base = 768 + 32 * (L - 4); op = 0; }
    else if (L < 12) { base = 1024 + 32 * (L - 8); op = 0; }
    else if (L < 22) { base = 1536 + 32 * (L - 12); op = 2; }
    else if (L < 42) { base = 1856 + 32 * (L - 22); op = 0; }
    else if (L < 48) { base = 2816 + 32 * (L - 42); op = 0; }
    else if (L < 60) { base = 1152 + 32 * (L - 48); op = 1; }
    else if (L < 70) { base = 2496 + 32 * (L - 60); op = 1; }
    else { base = 3200 + 32 * (L - 70); op = 1; }
}
__device__ __forceinline__ int phys_to_act(int pn, int p) {
    if (pn < 3) { const int f = p >> 7, hh = (p >> 5) & 3, i = p & 31; return rope_head_base(pn, hh) + 32 * f + i; }
    if (pn < 13) { int base, op; gen_group((pn - 3) * 8 + (p >> 5), base, op); return base + (p & 31); }
    const int bj = p >> 7, q = p & 127;
    if (q < 64) return A_MCKV + 64 * bj + q;
    if (q < 80) return A_MKR + 16 * bj + (q - 64);
    if (q < 96) { const int gi = 16 * bj + (q - 80); return gi < 18 ? A_GATE + gi : -1; }
    return -1;
}

struct EpiInProj {
    static constexpr bool PERM = true, AFTER_DRAIN = false;
    bf16_t* ACT; const float* cs64; const float* cs32; float* ssqp; bf16_t* MKp;
    __device__ __forceinline__ void operator()(const pg8::f32x4 (&acc)[2][2][4][2], const pg8::Unit& u, int wr, int wc, int fr, int fq) const {
        using pg8::cvt_pk_bf16; typedef pg8::u32x4 u32x4;
        const int pn = u.pn; const int row0 = u.pm * 256 + wr * 64 + fr;
        if (pn < 3) {
            const int hb = rope_head_base(pn, wc) + 8 * fq; const float sc = (pn == 0 || (pn == 1 && wc < 2)) ? QS_NSA : 1.f;
#pragma unroll
            for (int ai = 0; ai < 2; ++ai)
#pragma unroll
                for (int m = 0; m < 4; ++m) {
                    const int row = row0 + ai * 128 + m * 16;
                    const f32x4* cp = (const f32x4*)(cs64 + ((size_t)row * 32 + 8 * fq) * 2);
                    const f32x4 t0 = cp[0], t1 = cp[1], t2 = cp[2], t3 = cp[3];
                    const f32x4 a0 = acc[ai][0][m][0], a1 = acc[ai][0][m][1], b0 = acc[ai][1][m][0], b1 = acc[ai][1][m][1];
                    float o1[8], o2[8];
                    o1[0] = a0[0] * t0[0] - b0[0] * t0[1]; o2[0] = b0[0] * t0[0] + a0[0] * t0[1];
                    o1[1] = a0[1] * t0[2] - b0[1] * t0[3]; o2[1] = b0[1] * t0[2] + a0[1] * t0[3];
                    o1[2] = a0[2] * t1[0] - b0[2] * t1[1]; o2[2] = b0[2] * t1[0] + a0[2] * t1[1];
                    o1[3] = a0[3] * t1[2] - b0[3] * t1[3]; o2[3] = b0[3] * t1[2] + a0[3] * t1[3];
                    o1[4] = a1[0] * t2[0] - b1[0] * t2[1]; o2[4] = b1[0] * t2[0] + a1[0] * t2[1];
                    o1[5] = a1[1] * t2[2] - b1[1] * t2[3]; o2[5] = b1[1] * t2[2] + a1[1] * t2[3];
                    o1[6] = a1[2] * t3[0] - b1[2] * t3[1]; o2[6] = b1[2] * t3[0] + a1[2] * t3[1];
                    o1[7] = a1[3] * t3[2] - b1[3] * t3[3]; o2[7] = b1[3] * t3[2] + a1[3] * t3[3];
                    u32x4 w1, w2;
                    w1.x = cvt_pk_bf16(o1[0] * sc, o1[1] * sc); w1.y = cvt_pk_bf16(o1[2] * sc, o1[3] * sc); w1.z = cvt_pk_bf16(o1[4] * sc, o1[5] * sc); w1.w = cvt_pk_bf16(o1[6] * sc, o1[7] * sc);
                    w2.x = cvt_pk_bf16(o2[0] * sc, o2[1] * sc); w2.y = cvt_pk_bf16(o2[2] * sc, o2[3] * sc); w2.z = cvt_pk_bf16(o2[4] * sc, o2[5] * sc); w2.w = cvt_pk_bf16(o2[6] * sc, o2[7] * sc);
                    bf16_t* rp = ACT + (size_t)row * ACTW + hb;
                    *(u32x4*)rp = w1; *(u32x4*)(rp + 32) = w2;
                }
        } else if (pn < 13) {
#pragma unroll
            for (int bj = 0; bj < 2; ++bj) {
                int base, op; gen_group((pn - 3) * 8 + bj * 4 + wc, base, op);
#pragma unroll
                for (int ai = 0; ai < 2; ++ai)
#pragma unroll
                    for (int m = 0; m < 4; ++m) {
                        const int row = row0 + ai * 128 + m * 16;
                        f32x4 v0 = acc[ai][bj][m][0], v1 = acc[ai][bj][m][1];
                        if (op == 1) {
#pragma unroll
                            for (int e = 0; e < 4; ++e) { v0[e] = silu_f(v0[e]); v1[e] = silu_f(v1[e]); }
                        } else if (op == 2) { v0 = v0 * 0.125f; v1 = v1 * 0.125f; }
                        u32x4 w; w.x = cvt_pk_bf16(v0[0], v0[1]); w.y = cvt_pk_bf16(v0[2], v0[3]); w.z = cvt_pk_bf16(v1[0], v1[1]); w.w = cvt_pk_bf16(v1[2], v1[3]);
                        *(u32x4*)(ACT + (size_t)row * ACTW + base + 8 * fq) = w;
                        const int L = (pn - 3) * 8 + bj * 4 + wc;
                        if (L >= 42 && L < 48) {
                            float ss = (v0[0] * v0[0] + v0[1] * v0[1]) + (v0[2] * v0[2] + v0[3] * v0[3]) + (v1[0] * v1[0] + v1[1] * v1[1]) + (v1[2] * v1[2] + v1[3] * v1[3]);
                            ss += xs_f<16>(ss); ss = psum32(ss);
                            if (fq == 0) ssqp[(size_t)row * 16 + (L - 42)] = ss;
                        }
                    }
            }
        } else {
            if (wc < 2) {
#pragma unroll
                for (int bj = 0; bj < 2; ++bj)
#pragma unroll
                    for (int ai = 0; ai < 2; ++ai)
#pragma unroll
                        for (int m = 0; m < 4; ++m) {
                            const int row = row0 + ai * 128 + m * 16;
                            const f32x4 v0 = acc[ai][bj][m][0], v1 = acc[ai][bj][m][1];
                            u32x4 w; w.x = cvt_pk_bf16(v0[0], v0[1]); w.y = cvt_pk_bf16(v0[2], v0[3]); w.z = cvt_pk_bf16(v1[0], v1[1]); w.w = cvt_pk_bf16(v1[2], v1[3]);
                            *(u32x4*)(ACT + (size_t)row * ACTW + A_MCKV + 64 * bj + 32 * wc + 8 * fq) = w;
                            float ss = (v0[0] * v0[0] + v0[1] * v0[1]) + (v0[2] * v0[2] + v0[3] * v0[3]) + (v1[0] * v1[0] + v1[1] * v1[1]) + (v1[2] * v1[2] + v1[3] * v1[3]);
                            ss += xs_f<16>(ss); ss = psum32(ss);
                            if (fq == 0) ssqp[(size_t)row * 16 + 6 + bj * 2 + wc] = ss;
                        }
            } else if (wc == 2) {
#pragma unroll
                for (int ai = 0; ai < 2; ++ai)
#pragma unroll
                    for (int m = 0; m < 4; ++m) {
                        const int row = row0 + ai * 128 + m * 16;
                        const f32x4 a0 = acc[ai][0][m][0], a1 = acc[ai][0][m][1], b0 = acc[ai][1][m][0], b1 = acc[ai][1][m][1];
                        if (fq < 2) {
                            const f32x4* cp = (const f32x4*)(cs32 + ((size_t)row * 16 + 8 * fq) * 2);
                            const f32x4 t0 = cp[0], t1 = cp[1], t2 = cp[2], t3 = cp[3];
                            float o1[8], o2[8];
                            o1[0] = a0[0] * t0[0] - b0[0] * t0[1]; o2[0] = b0[0] * t0[0] + a0[0] * t0[1];
                            o1[1] = a0[1] * t0[2] - b0[1] * t0[3]; o2[1] = b0[1] * t0[2] + a0[1] * t0[3];
                            o1[2] = a0[2] * t1[0] - b0[2] * t1[1]; o2[2] = b0[2] * t1[0] + a0[2] * t1[1];
                            o1[3] = a0[3] * t1[2] - b0[3] * t1[3]; o2[3] = b0[3] * t1[2] + a0[3] * t1[3];
                            o1[4] = a1[0] * t2[0] - b1[0] * t2[1]; o2[4] = b1[0] * t2[0] + a1[0] * t2[1];
                            o1[5] = a1[1] * t2[2] - b1[1] * t2[3]; o2[5] = b1[1] * t2[2] + a1[1] * t2[3];
                            o1[6] = a1[2] * t3[0] - b1[2] * t3[1]; o2[6] = b1[2] * t3[0] + a1[2] * t3[1];
                            o1[7] = a1[3] * t3[2] - b1[3] * t3[3]; o2[7] = b1[3] * t3[2] + a1[3] * t3[3];
                            u32x4 w1, w2;
                            w1.x = cvt_pk_bf16(o1[0], o1[1]); w1.y = cvt_pk_bf16(o1[2], o1[3]); w1.z = cvt_pk_bf16(o1[4], o1[5]); w1.w = cvt_pk_bf16(o1[6], o1[7]);
                            w2.x = cvt_pk_bf16(o2[0], o2[1]); w2.y = cvt_pk_bf16(o2[2], o2[3]); w2.z = cvt_pk_bf16(o2[4], o2[5]); w2.w = cvt_pk_bf16(o2[6], o2[7]);
                            bf16_t* rp = ACT + (size_t)row * ACTW + A_MKR + 8 * fq;
                            *(u32x4*)rp = w1; *(u32x4*)(rp + 16) = w2;
#pragma unroll
                            for (int hh = 0; hh < 5; ++hh) { bf16_t* kp = MKp + (size_t)row * 480 + hh * 96 + 64 + 8 * fq; *(u32x4*)kp = w1; *(u32x4*)(kp + 16) = w2; }
                        } else {
                            const int g0 = 8 * (fq - 2);
                            float ga[8], gb[8];
#pragma unroll
                            for (int e = 0; e < 4; ++e) { ga[e] = a0[e]; ga[4 + e] = a1[e]; gb[e] = b0[e]; gb[4 + e] = b1[e]; }
#pragma unroll
                            for (int e = 0; e < 8; ++e) { ga[e] = (g0 + e < 18) ? sigm_f(ga[e]) : 0.f; gb[e] = (16 + g0 + e < 18) ? sigm_f(gb[e]) : 0.f; }
                            u32x4 w1, w2;
                            w1.x = cvt_pk_bf16(ga[0], ga[1]); w1.y = cvt_pk_bf16(ga[2], ga[3]); w1.z = cvt_pk_bf16(ga[4], ga[5]); w1.w = cvt_pk_bf16(ga[6], ga[7]);
                            w2.x = cvt_pk_bf16(gb[0], gb[1]); w2.y = cvt_pk_bf16(gb[2], gb[3]); w2.z = cvt_pk_bf16(gb[4], gb[5]); w2.w = cvt_pk_bf16(gb[6], gb[7]);
                            bf16_t* rp = ACT + (size_t)row * ACTW + A_GATE + g0;
                            *(u32x4*)rp = w1; *(u32x4*)(rp + 16) = w2;
                        }
                    }
            }
        }
    }
};

struct EpiOutProj {
    static constexpr bool PERM = false, AFTER_DRAIN = false;
    const float* xin; float* xout; const float* gate;
    __device__ __forceinline__ void operator()(const pg8::f32x4 (&acc)[2][2][4][2], const pg8::Unit& u, int wr, int wc, int fr, int fq) const {
        const int col0 = u.pn * 256 + wc * 32 + 4 * fq;
#pragma unroll
        for (int ai = 0; ai < 2; ++ai)
#pragma unroll
            for (int m = 0; m < 4; ++m) {
                const int row = u.pm * 256 + ai * 128 + wr * 64 + m * 16 + fr; const int b = row / SEQ;
                const size_t off = (size_t)row * DM + col0; const float* gp = gate + (size_t)b * 3072 + col0;
#pragma unroll
                for (int bj = 0; bj < 2; ++bj)
#pragma unroll
                    for (int n = 0; n < 2; ++n) {
                        const f32x4 g4 = *(const f32x4*)(gp + bj * 128 + n * 16); const f32x4 xi = *(const f32x4*)(xin + off + bj * 128 + n * 16);
                        *(f32x4*)(xout + off + bj * 128 + n * 16) = xi + g4 * acc[ai][bj][m][n];
                    }
            }
    }
};

__device__ __forceinline__ int wuq_src(int p) {
    if (p < 256) return (p >> 6) * 96 + (p & 63);
    const int q = p - 256, bj = q >> 7, r = q & 127;
    if (r < 80) return (r >> 4) * 96 + 64 + 16 * bj + (r & 15);
    const int idx = (r - 80) + 48 * bj; return idx < 64 ? 4 * 96 + idx : -1;
}
__device__ __forceinline__ int wukv_src(int p) {
    if (p < 320) return (p >> 6) * 128 + (p & 63);
    if (p < 640) { const int q = p - 320; return (q >> 6) * 128 + 64 + (q & 63); }
    return -1;
}
struct EpiQUp {
    static constexpr bool PERM = true, AFTER_DRAIN = false;
    bf16_t* MQ; const float* ssqp; const float* cs32;
    __device__ __forceinline__ void operator()(const pg8::f32x4 (&acc)[2][2][4][2], const pg8::Unit& u, int wr, int wc, int fr, int fq) const {
        using pg8::cvt_pk_bf16; typedef pg8::u32x4 u32x4;
        const int row0 = u.pm * 256 + wr * 64 + fr; const int q = 32 * wc + 8 * fq;
#pragma unroll
        for (int ai = 0; ai < 2; ++ai)
#pragma unroll
            for (int m = 0; m < 4; ++m) {
                const int row = row0 + ai * 128 + m * 16;
                const f32x4 sa = *(const f32x4*)(ssqp + (size_t)row * 16); const float2 sb = *(const float2*)(ssqp + (size_t)row * 16 + 4);
                const float rs = rsqrtf(((sa[0] + sa[1]) + (sa[2] + sa[3]) + (sb.x + sb.y)) * (1.f / 192.f) + 1e-6f) * QS_MLA;
                const f32x4 a0 = acc[ai][0][m][0], a1 = acc[ai][0][m][1], b0 = acc[ai][1][m][0], b1 = acc[ai][1][m][1];
                bf16_t* rowp = MQ + (size_t)row * 480;
                if (u.pn == 0) {
                    u32x4 w1, w2;
                    w1.x = cvt_pk_bf16(a0[0] * rs, a0[1] * rs); w1.y = cvt_pk_bf16(a0[2] * rs, a0[3] * rs); w1.z = cvt_pk_bf16(a1[0] * rs, a1[1] * rs); w1.w = cvt_pk_bf16(a1[2] * rs, a1[3] * rs);
                    w2.x = cvt_pk_bf16(b0[0] * rs, b0[1] * rs); w2.y = cvt_pk_bf16(b0[2] * rs, b0[3] * rs); w2.z = cvt_pk_bf16(b1[0] * rs, b1[1] * rs); w2.w = cvt_pk_bf16(b1[2] * rs, b1[3] * rs);
                    *(u32x4*)(rowp + (q >> 6) * 96 + (q & 63)) = w1;
                    *(u32x4*)(rowp + (2 + (q >> 6)) * 96 + (q & 63)) = w2;
                } else if (q < 80) {
                    const int head = q >> 4, i = q & 15;
                    const f32x4* cp = (const f32x4*)(cs32 + ((size_t)row * 16 + i) * 2);
                    const f32x4 t0 = cp[0], t1 = cp[1], t2 = cp[2], t3 = cp[3];
                    float o1[8], o2[8];
                    o1[0] = a0[0] * t0[0] - b0[0] * t0[1]; o2[0] = b0[0] * t0[0] + a0[0] * t0[1];
                    o1[1] = a0[1] * t0[2] - b0[1] * t0[3]; o2[1] = b0[1] * t0[2] + a0[1] * t0[3];
                    o1[2] = a0[2] * t1[0] - b0[2] * t1[1]; o2[2] = b0[2] * t1[0] + a0[2] * t1[1];
                    o1[3] = a0[3] * t1[2] - b0[3] * t1[3]; o2[3] = b0[3] * t1[2] + a0[3] * t1[3];
                    o1[4] = a1[0] * t2[0] - b1[0] * t2[1]; o2[4] = b1[0] * t2[0] + a1[0] * t2[1];
                    o1[5] = a1[1] * t2[2] - b1[1] * t2[3]; o2[5] = b1[1] * t2[2] + a1[1] * t2[3];
                    o1[6] = a1[2] * t3[0] - b1[2] * t3[1]; o2[6] = b1[2] * t3[0] + a1[2] * t3[1];
                    o1[7] = a1[3] * t3[2] - b1[3] * t3[3]; o2[7] = b1[3] * t3[2] + a1[3] * t3[3];
                    u32x4 w1, w2;
                    w1.x = cvt_pk_bf16(o1[0] * rs, o1[1] * rs); w1.y = cvt_pk_bf16(o1[2] * rs, o1[3] * rs); w1.z = cvt_pk_bf16(o1[4] * rs, o1[5] * rs); w1.w = cvt_pk_bf16(o1[6] * rs, o1[7] * rs);
                    w2.x = cvt_pk_bf16(o2[0] * rs, o2[1] * rs); w2.y = cvt_pk_bf16(o2[2] * rs, o2[3] * rs); w2.z = cvt_pk_bf16(o2[4] * rs, o2[5] * rs); w2.w = cvt_pk_bf16(o2[6] * rs, o2[7] * rs);
                    *(u32x4*)(rowp + head * 96 + 64 + i) = w1; *(u32x4*)(rowp + head * 96 + 80 + i) = w2;
                } else {
                    const int idx0 = q - 80;
                    u32x4 w1; w1.x = cvt_pk_bf16(a0[0] * rs, a0[1] * rs); w1.y = cvt_pk_bf16(a0[2] * rs, a0[3] * rs); w1.z = cvt_pk_bf16(a1[0] * rs, a1[1] * rs); w1.w = cvt_pk_bf16(a1[2] * rs, a1[3] * rs);
                    *(u32x4*)(rowp + 384 + idx0) = w1;
                    if (48 + idx0 < 64) { u32x4 w2; w2.x = cvt_pk_bf16(b0[0] * rs, b0[1] * rs); w2.y = cvt_pk_bf16(b0[2] * rs, b0[3] * rs); w2.z = cvt_pk_bf16(b1[0] * rs, b1[1] * rs); w2.w = cvt_pk_bf16(b1[2] * rs, b1[3] * rs);
                        *(u32x4*)(rowp + 384 + 48 + idx0) = w2; }
                }
            }
    }
};
struct EpiKVUp {
    static constexpr bool PERM = true, AFTER_DRAIN = false;
    bf16_t* MKp; bf16_t* MV; const float* ssqp;
    __device__ __forceinline__ void operator()(const pg8::f32x4 (&acc)[2][2][4][2], const pg8::Unit& u, int wr, int wc, int fr, int fq) const {
        using pg8::cvt_pk_bf16; typedef pg8::u32x4 u32x4;
        const int row0 = u.pm * 256 + wr * 64 + fr;
#pragma unroll
        for (int ai = 0; ai < 2; ++ai)
#pragma unroll
            for (int m = 0; m < 4; ++m) {
                const int row = row0 + ai * 128 + m * 16;
                const f32x4 sa = *(const f32x4*)(ssqp + (size_t)row * 16 + 6 - 2);
                const float2 sb = *(const float2*)(ssqp + (size_t)row * 16 + 8);
                const float rs = rsqrtf(((sa[2] + sa[3]) + (sb.x + sb.y)) * (1.f / 128.f) + 1e-6f);
#pragma unroll
                for (int bj = 0; bj < 2; ++bj) {
                    const int p = u.pn * 256 + 128 * bj + 32 * wc + 8 * fq;
                    const f32x4 v0 = acc[ai][bj][m][0] * rs, v1 = acc[ai][bj][m][1] * rs;
                    u32x4 w; w.x = cvt_pk_bf16(v0[0], v0[1]); w.y = cvt_pk_bf16(v0[2], v0[3]); w.z = cvt_pk_bf16(v1[0], v1[1]); w.w = cvt_pk_bf16(v1[2], v1[3]);
                    if (p < 320) *(u32x4*)(MKp + (size_t)row * 480 + (p >> 6) * 96 + (p & 63)) = w;
                    else if (p < 640) *(u32x4*)(MV + (size_t)row * 320 + (p - 320)) = w;
                }
            }
    }
};

__device__ __forceinline__ void tr_item(const float* W, int ldw, int srccol, bf16_t* WT, int K, int wt_row0, int k0, LAS float* scr, int lane, const float* kscale = nullptr) {
#pragma unroll 8
    for (int i = 0; i < 32; ++i) { const int kk = 2 * i + (lane >> 5); float v = (srccol >= 0) ? W[(size_t)(k0 + kk) * ldw + srccol] : 0.f; if (kscale) v *= kscale[k0 + kk]; scr[kk * 33 + (lane & 31)] = v; }
    LDS_WAIT(); asm volatile("" ::: "memory");
    const int c = lane & 7;
#pragma unroll
    for (int j = 0; j < 4; ++j) { const int n = (lane >> 3) + 8 * j; const LAS float* s = scr + (8 * c) * 33 + n;
        v4u o; o.x = pk2(s[0 * 33], s[1 * 33]); o.y = pk2(s[2 * 33], s[3 * 33]); o.z = pk2(s[4 * 33], s[5 * 33]); o.w = pk2(s[6 * 33], s[7 * 33]);
        *(v4u*)(WT + (size_t)(wt_row0 + n) * K + k0 + 8 * c) = o; }
    LDS_WAIT(); asm volatile("" ::: "memory");
}

struct MK {
    LAS unsigned char* lds; int tid, lane, wave, G, bid; float* out; unsigned char* ws;
};
#define ARGF(A, i) ((const float*)(A).in[i])

__device__ __forceinline__ void ph_prologue(MK& F, const Args& A) {
    const RopeInv& inv = A.inv;
    float* mod = (float*)(F.ws + WS_MOD);
    {
        LAS float* red = (LAS float*)F.lds;
        for (int item = F.bid; item < DEPTH * 48; item += F.G) {
            const int l = item / 48, col = (item % 48) * 64 + F.lane;
            float acc[NB];
#pragma unroll
            for (int b = 0; b < NB; ++b) acc[b] = 0.f;
            const float* cvec = ARGF(A, 1); const float* adab = ARGF(A, 4);
            const float* wp = ARGF(A, 3) + ((size_t)l * DM + F.wave * 128) * 3072 + col;
            for (int k = 0; k < 128; ++k) { const float w = wp[(size_t)k * 3072];
#pragma unroll
                for (int b = 0; b < NB; ++b) { const float cv = cvec[b * DM + F.wave * 128 + k]; acc[b] += silu_f(cv) * w; } }
#pragma unroll
            for (int b = 0; b < NB; ++b) red[(F.wave * NB + b) * 64 + F.lane] = acc[b];
            __syncthreads();
            { const int b = F.tid >> 6; float s = adab[l * 3072 + col];
#pragma unroll
              for (int w = 0; w < 8; ++w) s += red[(w * NB + b) * 64 + F.lane];
              mod[((size_t)l * NB + b) * 3072 + col] = s; }
            __syncthreads();
        }
    }
    const int gw = F.bid * NWAVES + F.wave, NGW = F.G * NWAVES;
    {
        LAS float* scr = (LAS float*)(F.lds + F.wave * 16384);
        bf16_t* WIN_T = (bf16_t*)(F.ws + WS_WIN_T); bf16_t* WOUT_T = (bf16_t*)(F.ws + WS_WOUT_T);
        bf16_t* WUQ_T = (bf16_t*)(F.ws + WS_WUQ_T); bf16_t* WUKV_T = (bf16_t*)(F.ws + WS_WUKV_T);
        constexpr int I_IN = 16 * 112, I_OUT = 16 * 32, I_UQ = 4 * 16, I_UKV = 2 * 24, I_W1 = 2 * 128, I_W2 = 2 * 4, I_PB = 2 * 32, I_L = I_IN + I_OUT + I_UQ + I_UKV + I_W1 + I_W2 + I_PB, NIT = DEPTH * I_L;
        for (int it = gw; it < NIT; it += NGW) {
            int r = it; const int l = r / I_L; r -= l * I_L;
            if (r < I_IN) { const int kb = r / 112, nb = r % 112; const int prow = nb * 32 + (F.lane & 31); const int act = phys_to_act(prow >> 8, prow & 255); const int src = (act < 0) ? -1 : inproj_src_col(act);
                tr_item(ARGF(A, 6) + (size_t)l * DM * D_IN, D_IN, src, WIN_T + (size_t)l * 3584 * DM, DM, nb * 32, kb * 64, scr, F.lane); }
            else if (r < I_IN + I_OUT) { r -= I_IN; const int kb = r / 32, nb = r % 32;
                tr_item(ARGF(A, 17) + (size_t)l * DM * DM, DM, nb * 32 + (F.lane & 31), WOUT_T + (size_t)l * DM * DM, DM, nb * 32, kb * 64, scr, F.lane); }
            else if (r < I_IN + I_OUT + I_UQ) { r -= I_IN + I_OUT; const int kb = r / 16, nb = r % 16;
                const int src = (kb < 3) ? wuq_src(nb * 32 + (F.lane & 31)) : -1;
                tr_item(ARGF(A, 14) + (size_t)l * 192 * 480, 480, src, WUQ_T + (size_t)l * 512 * 256, 256, nb * 32, kb * 64, scr, F.lane, (kb < 3) ? ARGF(A, 13) + l * 192 : nullptr); }
            else if (r < I_IN + I_OUT + I_UQ + I_UKV) { r -= I_IN + I_OUT + I_UQ; const int kb = r / 24, nb = r % 24;
                tr_item(ARGF(A, 16) + (size_t)l * 128 * 640, 640, wukv_src(nb * 32 + (F.lane & 31)), WUKV_T + (size_t)l * 768 * 128, 128, nb * 32, kb * 64, scr, F.lane, ARGF(A, 15) + l * 128); }
            else if (r < I_IN + I_OUT + I_UQ + I_UKV + I_W1) { r -= I_IN + I_OUT + I_UQ + I_UKV; const int kv = r / 128, kb = (r % 128) / 4, nb = r % 4;
                tr_item(ARGF(A, kv ? 11 : 9) + (size_t)l * 2048 * 128, 128, nb * 32 + (F.lane & 31), (bf16_t*)(F.ws + WS_W1T) + (size_t)(l * 2 + kv) * 128 * 2048, 2048, nb * 32, kb * 64, scr, F.lane); }
            else if (r < I_IN + I_OUT + I_UQ + I_UKV + I_W1 + I_W2) { r -= I_IN + I_OUT + I_UQ + I_UKV + I_W1; const int kv = r / 4, kb = (r % 4) / 2, nb = r % 2;
                tr_item(ARGF(A, kv ? 12 : 10) + (size_t)l * 128 * 64, 64, nb * 32 + (F.lane & 31), (bf16_t*)(F.ws + WS_W2T) + (size_t)(l * 2 + kv) * 64 * 128, 128, nb * 32, kb * 64, scr, F.lane); }
            else { r -= I_IN + I_OUT + I_UQ + I_UKV + I_W1 + I_W2; const int kv = r / 32, ch = r % 32;
                const float* pe = ARGF(A, kv ? 8 : 7) + (size_t)l * 2048 + ch * 64; const float* w1 = ARGF(A, kv ? 11 : 9) + ((size_t)l * 2048 + ch * 64) * 128;
                float s0 = 0.f, s1 = 0.f;
                for (int k = 0; k < 64; ++k) { const float pv_ = pe[k]; s0 += pv_ * w1[(size_t)k * 128 + F.lane]; s1 += pv_ * w1[(size_t)k * 128 + 64 + F.lane]; }
                float* pb = (float*)(F.ws + WS_POSBP) + ((size_t)(l * 2 + kv) * 32 + ch) * 128; pb[F.lane] = s0; pb[64 + F.lane] = s1; }
        }
    }
    {
        float* cs64 = (float*)(F.ws + WS_CS64); float* cs32 = (float*)(F.ws + WS_CS32);
        for (int idx = F.bid * 512 + F.tid; idx < M * 48; idx += F.G * 512) {
            const int m = idx / 48, i = idx % 48; const float p = (float)((const int*)A.in[2])[m]; float s, c;
            if (i < 32) { sincos_rev(p * inv.i64[i], s, c); *(float2*)(cs64 + ((size_t)m * 32 + i) * 2) = make_float2(c, s); }
            else { const int j = i - 32; sincos_rev(p * inv.i32[j], s, c); *(float2*)(cs32 + ((size_t)m * 16 + j) * 2) = make_float2(c, s); }
        }
    }
}

__device__ __forceinline__ void ph_norm_mod(MK& F, const Args& A, const float* xin, int l) {
    const float* g = ARGF(A, 5) + l * DM; const float* mod = (const float*)(F.ws + WS_MOD) + (size_t)l * NB * 3072; bf16_t* H = (bf16_t*)(F.ws + WS_H);
    const int gw = F.bid * NWAVES + F.wave, NGW = F.G * NWAVES;
    for (int row = gw; row < M; row += NGW) {
        const int b = row / SEQ; const f32x4* xr = (const f32x4*)(xin + (size_t)row * DM) + F.lane; f32x4 v[4]; float ss = 0.f;
#pragma unroll
        for (int j = 0; j < 4; ++j) { v[j] = xr[64 * j]; ss += (v[j].x * v[j].x + v[j].y * v[j].y) + (v[j].z * v[j].z + v[j].w * v[j].w); }
        const float r = rsqrtf(wave_sum(ss) * (1.f / DM) + 1e-6f);
        const float* sh = mod + (size_t)b * 3072; const float* sc = sh + 1024;
#pragma unroll
        for (int j = 0; j < 4; ++j) { const int c = 256 * j + 4 * F.lane; const f32x4 g4 = *(const f32x4*)(g + c), s4 = *(const f32x4*)(sc + c), h4 = *(const f32x4*)(sh + c);
            const f32x4 h = v[j] * r * g4 * (s4 + 1.f) + h4;
            uint2 o; o.x = pk2(h.x, h.y); o.y = pk2(h.z, h.w); *(uint2*)(H + (size_t)row * DM + c) = o; }
    }
}
__device__ __forceinline__ void ph_final_norm(MK& F, const Args& A) {
    const float* fnorm = ARGF(A, 18);
    const int gw = F.bid * NWAVES + F.wave, NGW = F.G * NWAVES;
    for (int row = gw; row < M; row += NGW) {
        f32x4* xr = (f32x4*)(F.out + (size_t)row * DM) + F.lane; f32x4 v[4]; float ss = 0.f;
#pragma unroll
        for (int j = 0; j < 4; ++j) { v[j] = xr[64 * j]; ss += (v[j].x * v[j].x + v[j].y * v[j].y) + (v[j].z * v[j].z + v[j].w * v[j].w); }
        const float r = rsqrtf(wave_sum(ss) * (1.f / DM) + 1e-6f);
#pragma unroll
        for (int j = 0; j < 4; ++j) { const f32x4 g4 = *(const f32x4*)(fnorm + 256 * j + 4 * F.lane); xr[64 * j] = v[j] * r * g4; }
    }
}

__global__ void __launch_bounds__(NWAVES * 64, 2) mk_fwd(Args args) {
    extern __shared__ __attribute__((aligned(16))) unsigned char lds[];
    MK F;
    const int s_wave = __builtin_amdgcn_readfirstlane((int)threadIdx.x >> 6);
    F.lds = (LAS unsigned char*)lds; F.tid = threadIdx.x; F.lane = F.tid & 63; F.wave = s_wave; F.G = gridDim.x; F.bid = blockIdx.x;
    F.out = args.out; F.ws = args.ws;
    for (int u = F.tid; u < (LDS_BYTES - LDSCTL_OFF) / 4; u += NWAVES * 64) ((LAS unsigned*)(F.lds + LDSCTL_OFF))[u] = 0u;
    __syncthreads();
    cooperative_groups::grid_group grid = cooperative_groups::this_grid();
    XcdBarrier xbar = xcd_barrier_post((unsigned*)(F.ws + WS_CTL) + CW_BAR, (volatile LAS unsigned*)(F.lds + MISC_OFF) + 8);
    const int lo = args.ph_lo, hi = args.ph_hi;
    for (int ph = lo; ph < hi; ++ph) {
        { int bid_ = blockIdx.x; asm volatile("" : "+s"(bid_)); F.bid = bid_; }
#define FRESH_TID(var) int var; asm volatile("v_mbcnt_lo_u32_b32 %0, -1, 0\n\tv_mbcnt_hi_u32_b32 %0, -1, %0" : "=v"(var)); var += s_wave * 64
        if (ph == PH_PRO) { FRESH_TID(t_); F.tid = t_; F.lane = t_ & 63; ph_prologue(F, args); }
        else if (ph == PH_FINAL) { FRESH_TID(t_); F.tid = t_; F.lane = t_ & 63; ph_final_norm(F, args); }
        else {
            const int l = (ph - PH_L0) / PH_PER_LAYER, k = (ph - PH_L0) % PH_PER_LAYER;
            const float* xin = (l == 0) ? ARGF(args, 0) : F.out;
            if (k == PK_NORM) { FRESH_TID(t_); F.tid = t_; F.lane = t_ & 63; ph_norm_mod(F, args, xin, l); }
            else if (k == PK_INPROJ) {
                pg8::Gemm g = pg8::make_gemm((const bf16_t*)(F.ws + WS_H), DM, (const bf16_t*)(F.ws + WS_WIN_T) + (size_t)l * 3584 * DM, DM, M, 3584, DM);
                pg8::StaticOrder S; S.init(M, 3584, F.G, F.bid);
                EpiInProj E{(bf16_t*)(F.ws + WS_ACT), (const float*)(F.ws + WS_CS64), (const float*)(F.ws + WS_CS32), (float*)(F.ws + WS_SSQP), (bf16_t*)(F.ws + WS_MK)};
                { FRESH_TID(ftid); pg8::gemm_phase<EpiInProj, pg8::StaticOrder, true, true>(F.lds, g, S, E, ftid); }
            } else if (k == PK_P3) {
                { pg8::Gemm g = pg8::make_gemm((const bf16_t*)(F.ws + WS_ACT) + A_MCQ, ACTW, (const bf16_t*)(F.ws + WS_WUQ_T) + (size_t)l * 512 * 256, 256, M, 512, 256);
                  pg8::StaticOrder S; S.init(M, 512, F.G, F.bid);
                  EpiQUp E{(bf16_t*)(F.ws + WS_MQ), (const float*)(F.ws + WS_SSQP), (const float*)(F.ws + WS_CS32)};
                  { FRESH_TID(ftid); pg8::gemm_phase<EpiQUp, pg8::StaticOrder, true, true>(F.lds, g, S, E, ftid); } }
                { pg8::Gemm g = pg8::make_gemm((const bf16_t*)(F.ws + WS_ACT) + A_MCKV, ACTW, (const bf16_t*)(F.ws + WS_WUKV_T) + (size_t)l * 768 * 128, 128, M, 768, 128);
                  pg8::StaticOrder S; S.init(M, 768, F.G, F.bid);
                  EpiKVUp E{(bf16_t*)(F.ws + WS_MK), (bf16_t*)(F.ws + WS_MV), (const float*)(F.ws + WS_SSQP)};
                  { FRESH_TID(ftid); pg8::gemm_phase<EpiKVUp, pg8::StaticOrder, true, true>(F.lds, g, S, E, ftid); } }
                { FRESH_TID(t_); cm::compress_phase(F.ws, (fa::lds_ptr)F.lds, l, F.bid, F.G, t_, s_wave, t_ & 63); }
            } else if (k == PK_P4) {
                { FRESH_TID(t_); cm::cmp_phase(F.ws, (fa::lds_ptr)F.lds, (unsigned*)(F.ws + WS_CTL) + CW_Q + 64 * (2 + l), t_, s_wave, t_ & 63); }
            } else if (k == PK_ATTN) {
                { FRESH_TID(t_); fa::attn_phase(F.ws, (fa::lds_ptr)F.lds, (unsigned*)(F.ws + WS_CTL) + CW_Q + 64 * l, t_, s_wave, t_ & 63); }
            } else if (k == PK_OUTPROJ) {
                pg8::Gemm g = pg8::make_gemm((const bf16_t*)(F.ws + WS_MIX), DM, (const bf16_t*)(F.ws + WS_WOUT_T) + (size_t)l * DM * DM, DM, M, DM, DM);
                pg8::StaticOrder S; S.init(M, DM, F.G, F.bid);
                EpiOutProj E{xin, F.out, (const float*)(F.ws + WS_MOD) + (size_t)l * NB * 3072 + 2048};
                { FRESH_TID(ftid); pg8::gemm_phase<EpiOutProj, pg8::StaticOrder, true, true>(F.lds, g, S, E, ftid); }
            }
        }
        if (ph + 1 < hi) { if (ph == lo) grid.sync(); else xcd_barrier(xbar); }
    }
}
static int g_grid = 0;
static void launch_mk(Args a, int lo, int hi, hipStream_t stream) {
    a.ph_lo = lo; a.ph_hi = hi;
    if (hi - lo > 1) { void* params[] = {&a}; hipLaunchCooperativeKernel((const void*)mk_fwd, dim3(g_grid), dim3(NWAVES * 64), params, LDS_BYTES, stream); }
    else hipLaunchKernelGGL(mk_fwd, dim3(g_grid), dim3(NWAVES * 64), LDS_BYTES, stream, a);
}
extern "C" void kernel_launch(void* const* d_in, const int* in_sizes, int n_in, void* d_out, int out_size, void* d_ws, size_t ws_size, hipStream_t stream) {
    if (n_in != 19 || out_size != M * DM || ws_size < WS_END) { fprintf(stderr, "kernel_launch: unexpected shapes (n_in %d out %d ws %zu)\n", n_in, out_size, ws_size); return; }
    if (g_grid == 0) {
        int dev = 0, cus = 0, per_cu = 0;
        hipGetDevice(&dev); hipDeviceGetAttribute(&cus, hipDeviceAttributeMultiprocessorCount, dev);
        hipFuncSetAttribute((const void*)mk_fwd, hipFuncAttributeMaxDynamicSharedMemorySize, LDS_BYTES);
        hipOccupancyMaxActiveBlocksPerMultiprocessor(&per_cu, (const void*)mk_fwd, NWAVES * 64, LDS_BYTES);
        if (per_cu < 1) { fprintf(stderr, "kernel_launch: occupancy query says %d blocks per CU\n", per_cu); per_cu = 1; }
        g_grid = cus;
        (void)hipGetLastError();
    }
    char* ws = (char*)d_ws;
    Args a{};
    for (int i = 0; i < 19; ++i) a.in[i] = d_in[i];
    a.out = (float*)d_out; a.ws = (unsigned char*)d_ws;
    for (int i = 0; i < 32; ++i) a.inv.i64[i] = (float)std::pow(10000.0, -(double)i / 32.0);
    for (int i = 0; i < 16; ++i) a.inv.i32[i] = (float)std::pow(10000.0, -(double)i / 16.0);
    hipMemsetAsync(ws + WS_CTL, 0, CTL_ZERO_BYTES, stream);

    launch_mk(a, 0, PH_COUNT, stream);
}
```

```cpp
#include <hip/hip_runtime.h>
#include <cstdio>
#include <cstdint>
#include <cmath>
#include <hip/hip_cooperative_groups.h>

typedef unsigned short bf16_t;
typedef unsigned long long u64;

constexpr int NB = 8, SEQ = 4096, DM = 1024, M = NB * SEQ, DEPTH = 2;
constexpr int D_IN = 3506;
constexpr int NCMP = 255;
constexpr int ACTW = 3584;
constexpr int A_NQ = 0, A_KC = 384, A_VC = 512, A_KS = 640, A_VS = 768, A_KW = 896, A_VW = 1024;
constexpr int A_NZ = 1152, A_SQ = 1536, A_SK = 1856, A_SV = 2176, A_SZ = 2496;
constexpr int A_MCQ = 2816, A_MCKV = 3008, A_MKR = 3136, A_GATE = 3168, A_MZ = 3200;
constexpr float LOG2E = 1.4426950408889634f;
constexpr float QS_NSA = 0.125f * LOG2E;
constexpr float QS_MLA = 0.10206207261596577f * LOG2E;

constexpr size_t MiB = 1u << 20;
constexpr size_t WS_CTL = 0;
constexpr size_t WS_MOD = 1 * MiB;
constexpr size_t WS_CS64 = 2 * MiB;
constexpr size_t WS_CS32 = 10 * MiB;
constexpr size_t WS_POSB = 14 * MiB;
constexpr size_t WS_POSBP = 14 * MiB + 512 * 1024;
constexpr size_t WS_HID = 15 * MiB;
constexpr size_t WS_WIN_T = 20 * MiB;
constexpr size_t WS_WOUT_T = 34 * MiB;
constexpr size_t WS_WUQ_T = 38 * MiB;
constexpr size_t WS_WUKV_T = 39 * MiB;
constexpr size_t WS_W1T = 40 * MiB;
constexpr size_t WS_W2T = 42 * MiB;
constexpr size_t WS_SSQP = 44 * MiB;
constexpr size_t WS_H = 64 * MiB;
constexpr size_t WS_MIX = 64 * MiB;
constexpr size_t WS_ACT = 128 * MiB;
constexpr size_t WS_MQ = 352 * MiB;
constexpr size_t WS_MK = 382 * MiB;
constexpr size_t WS_MV = 412 * MiB;
constexpr size_t WS_OC = 432 * MiB;
constexpr size_t WS_KC = 456 * MiB;
constexpr size_t WS_VC = 457 * MiB;
constexpr size_t WS_SEL = 458 * MiB;
constexpr size_t WS_END = 460 * MiB;

__device__ __forceinline__ float bf2f(bf16_t v) { return __uint_as_float(((unsigned)v) << 16); }
__device__ __forceinline__ bf16_t f2bf(float f) { unsigned u = __float_as_uint(f); return (bf16_t)((u + 0x7fffu + ((u >> 16) & 1u)) >> 16); }
__device__ __forceinline__ float blo(unsigned u) { return __uint_as_float(u << 16); }
__device__ __forceinline__ float bhi(unsigned u) { return __uint_as_float(u & 0xffff0000u); }
__device__ __forceinline__ float silu_f(float v) { return v / (1.f + __expf(-v)); }
__device__ __forceinline__ float sigm_f(float v) { return 1.f / (1.f + __expf(-v)); }

struct RopeInv { float i64[32]; float i32[16]; };


#define GAS __attribute__((address_space(1)))
#define LAS __attribute__((address_space(3)))
typedef unsigned v4u __attribute__((ext_vector_type(4)));
typedef float f32x4 __attribute__((ext_vector_type(4)));
#define RLX_AGENT __ATOMIC_RELAXED, __HIP_MEMORY_SCOPE_AGENT
#define LDS_WAIT() asm volatile("s_waitcnt lgkmcnt(0)" ::: "memory")
#define VM_WAIT() asm volatile("s_waitcnt vmcnt(0)" ::: "memory")
__device__ __forceinline__ unsigned pk2(float lo, float hi) { return (unsigned)f2bf(lo) | ((unsigned)f2bf(hi) << 16); }

template <int MASK> __device__ __forceinline__ float xs_f(float v) { return __int_as_float(__builtin_amdgcn_ds_swizzle(__float_as_int(v), (MASK << 10) | 0x1f)); }
template <int MASK> __device__ __forceinline__ int xs_i(int v) { return __builtin_amdgcn_ds_swizzle(v, (MASK << 10) | 0x1f); }
__device__ __forceinline__ float psum32(float v) { auto rr = __builtin_amdgcn_permlane32_swap(__float_as_uint(v), __float_as_uint(v), false, false); return __uint_as_float(rr[0]) + __uint_as_float(rr[1]); }
__device__ __forceinline__ float pmax32(float v) { auto rr = __builtin_amdgcn_permlane32_swap(__float_as_uint(v), __float_as_uint(v), false, false); return fmaxf(__uint_as_float(rr[0]), __uint_as_float(rr[1])); }
__device__ __forceinline__ float pxchg32(float v, int hi) { auto rr = __builtin_amdgcn_permlane32_swap(__float_as_uint(v), __float_as_uint(v), false, false); return hi ? __uint_as_float(rr[0]) : __uint_as_float(rr[1]); }
namespace pg8 {
#define PG8_LAS __attribute__((address_space(3)))
typedef short bf16x8 __attribute__((ext_vector_type(8)));
typedef float f32x4 __attribute__((ext_vector_type(4)));
typedef unsigned u32x4 __attribute__((ext_vector_type(4)));
constexpr int BM = 256, BK = 64, HALF = 128, HTB = HALF * BK * 2  , STAGE_BYTES = 8 * HTB, NXCD = 8, WGM = 8;

__host__ __device__ __forceinline__ int lds_byte(int r, int c) { const int st = (r >> 4) * 2 + (c >> 5), rr = r & 15, cc = c & 31, ob = rr * 64 + cc * 2; return st * 1024 + (ob ^ (((ob >> 9) & 1) << 5)); }
__host__ __device__ __forceinline__ void stage_rc(int b, int& R, int& C) { const int st = b / 1024, sb = b % 1024, swz = sb ^ (((sb >> 9) & 1) << 5); R = (st >> 1) * 16 + swz / 64; C = (st & 1) * 32 + (swz % 64) / 2; }
__host__ __device__ __forceinline__ int perm32(int rho) { const int n = rho >> 4, i = rho & 15; return 8 * (i >> 2) + 4 * n + (i & 3); }

struct Unit { int pm, pn; };
struct Gemm { const bf16_t* A; const bf16_t* Bt; int lda, ldb, kstepA; size_t a_ts_hi, a_ts_lo; int M, N, K;
    __device__ __forceinline__ size_t a_off(int pm) const { return (size_t)(pm >> 1) * a_ts_hi + (size_t)(pm & 1) * a_ts_lo; } };
__host__ __device__ inline Gemm make_gemm(const bf16_t* A, int lda, const bf16_t* Bt, int ldb, int M, int N, int K) {
    Gemm g; g.A = A; g.Bt = Bt; g.lda = lda; g.ldb = ldb; g.kstepA = BK; g.a_ts_hi = (size_t)512 * lda * 2; g.a_ts_lo = (size_t)256 * lda * 2; g.M = M; g.N = N; g.K = K; return g; }

struct StaticOrder {
    int nM, nN, nwg, G, c;
    __host__ __device__ void init(int M, int N, int G_, int c_) { nM = M / BM; nN = N / BM; nwg = nM * nN; G = G_; c = c_; }
    __host__ __device__ bool next(int i, Unit& u) const {
        const long L = (long)i * G + c; if (L >= nwg) return false;
        int wgid = (int)L; { const int q = nwg / NXCD, r = nwg % NXCD, xcd = wgid % NXCD, off = wgid / NXCD; wgid = (xcd < r ? xcd * (q + 1) : r * (q + 1) + (xcd - r) * q) + off; }
        const int nig = WGM * nN, gid = wgid / nig, fm = gid * WGM, gsz = (nM - fm) < WGM ? (nM - fm) : WGM;
        u.pm = fm + ((wgid % nig) % gsz); u.pn = (wgid % nig) / gsz; return true;
    }
    __device__ __forceinline__ void a_ready(const Unit&) const {}
    __device__ __forceinline__ void done(const Unit&) const {}
};
__device__ __forceinline__ unsigned cvt_pk_bf16(float lo, float hi) { unsigned r; asm volatile("v_cvt_pk_bf16_f32 %0, %1, %2" : "=v"(r) : "v"(lo), "v"(hi)); return r; }

template <class Epi, class Sched, bool ALIGN_EPI = false, bool SP2 = false>
__device__ __forceinline__ void gemm_phase(PG8_LAS unsigned char* lds, const Gemm g, const Sched& S, const Epi& E, int tid_in) {
    int tid_ = tid_in; asm volatile("" : "+v"(tid_));
    const int tid = tid_, wid = __builtin_amdgcn_readfirstlane(tid >> 6), lane = tid & 63, wr = wid >> 2, wc = wid & 3, fr = lane & 15, fq = lane >> 4;
    const int K = g.K, nt = K / BK;
    unsigned voffA[2], voffB[2];
#pragma unroll
    for (int i = 0; i < 2; ++i) { int R, C; stage_rc(tid * 16 + i * 8192, R, C); const int Rb = Epi::PERM ? ((R & ~31) + perm32(R & 31)) : R;
        voffA[i] = (unsigned)(R * g.lda + C) * 2u; voffB[i] = (unsigned)(Rb * g.ldb + C) * 2u; }
    const size_t kstepA = (size_t)g.kstepA * 2, kstepB = (size_t)(BK * 2);
    const size_t hstepA = (size_t)HALF * g.lda * 2, hstepB = (size_t)HALF * g.ldb * 2;
    const size_t tstepB = 2 * hstepB;
    const unsigned ldsw = (unsigned)wid * 1024u;
    const int aoff = lds_byte(wr * 64 + fr, fq * 8), boff = lds_byte(wc * 32 + fr, fq * 8);
#define PG8_SA(b, h) (((b) * 2 + (h)) * HTB)
#define PG8_SB(b, h) ((4 + (b) * 2 + (h)) * HTB)
#define PG8_STAGE(bufoff, gbase, voff) do { _Pragma("unroll") for (int _i = 0; _i < 2; ++_i) \
        __builtin_amdgcn_global_load_lds((const unsigned*)((const char*)(gbase) + (voff)[_i]), (PG8_LAS unsigned*)(lds + (bufoff) + ldsw + _i * 8192), 16, 0, 0); } while (0)
#define PG8_LDA(dst, b, h) do { _Pragma("unroll") for (int m = 0; m < 4; ++m) _Pragma("unroll") for (int k = 0; k < 2; ++k) dst[m][k] = *(const PG8_LAS bf16x8*)(lds + PG8_SA(b, h) + aoff + m * 2048 + k * 1024); } while (0)
#define PG8_LDB(dst, b, h) do { _Pragma("unroll") for (int n = 0; n < 2; ++n) _Pragma("unroll") for (int k = 0; k < 2; ++k) dst[n][k] = *(const PG8_LAS bf16x8*)(lds + PG8_SB(b, h) + boff + n * 2048 + k * 1024); } while (0)
#define PG8_MMA(ai, bj, At, Bt) do { __builtin_amdgcn_s_setprio(1); _Pragma("unroll") for (int m = 0; m < 4; ++m) _Pragma("unroll") for (int n = 0; n < 2; ++n) _Pragma("unroll") for (int k = 0; k < 2; ++k) \
        acc[ai][bj][m][n] = __builtin_amdgcn_mfma_f32_16x16x32_bf16(Bt[n][k], At[m][k], acc[ai][bj][m][n], 0, 0, 0); __builtin_amdgcn_s_setprio(0); } while (0)
#define PG8_WAIT_V(n) asm volatile("s_waitcnt vmcnt(" #n ")" ::: "memory")
#define PG8_WAIT_L(n) asm volatile("s_waitcnt lgkmcnt(" #n ")" ::: "memory")
#define PG8_BAR __builtin_amdgcn_s_barrier()
#define PG8_SCHED __builtin_amdgcn_sched_barrier(0)
    Unit cur, nxt; int ui = 0;
    if (!S.next(0, cur)) return;
    f32x4 acc[2][2][4][2];
#pragma unroll
    for (int a = 0; a < 2; ++a)
#pragma unroll
        for (int b = 0; b < 2; ++b)
#pragma unroll
            for (int m = 0; m < 4; ++m)
#pragma unroll
                for (int n = 0; n < 2; ++n) acc[a][b][m][n] = (f32x4){0.f, 0.f, 0.f, 0.f};
    bf16x8 At[4][2], B0[2][2], B1[2][2];
    const char* cA = (const char*)g.A + g.a_off(cur.pm); const char* cB = (const char*)g.Bt + (size_t)cur.pn * tstepB;
    S.a_ready(cur);
    if constexpr (SP2) {
        PG8_STAGE(PG8_SB(0, 0), cB, voffB); PG8_STAGE(PG8_SB(0, 1), cB + hstepB, voffB); PG8_STAGE(PG8_SA(0, 0), cA, voffA); PG8_STAGE(PG8_SA(0, 1), cA + hstepA, voffA);
        if (wr == 1) PG8_BAR;
        PG8_WAIT_V(2); PG8_BAR;
        PG8_STAGE(PG8_SB(1, 0), cB + kstepB, voffB); PG8_STAGE(PG8_SA(1, 0), cA + kstepA, voffA); PG8_STAGE(PG8_SB(1, 1), cB + hstepB + kstepB, voffB);
        PG8_WAIT_V(6); PG8_BAR;
    } else {
        PG8_STAGE(PG8_SB(0, 0), cB, voffB); PG8_STAGE(PG8_SA(0, 0), cA, voffA); PG8_STAGE(PG8_SB(0, 1), cB + hstepB, voffB); PG8_STAGE(PG8_SA(0, 1), cA + hstepA, voffA);
        if (wr == 1) PG8_BAR;
        PG8_WAIT_V(4); PG8_BAR;
        PG8_STAGE(PG8_SB(1, 0), cB + kstepB, voffB); PG8_STAGE(PG8_SA(1, 0), cA + kstepA, voffA); PG8_STAGE(PG8_SB(1, 1), cB + hstepB + kstepB, voffB);
        PG8_WAIT_V(6); PG8_BAR;
    }
    for (;;) {
        const bool has_next = S.next(ui + 1, nxt);
        const char* nA = has_next ? (const char*)g.A + g.a_off(nxt.pm) : cA; const char* nB = has_next ? (const char*)g.Bt + (size_t)nxt.pn * tstepB : cB;
        for (int t = 0; t < nt; t += 2) {
            const bool last = (t == nt - 2);
            const char* a1 = cA + (size_t)(t + 1) * kstepA;
            const char* a2 = last ? nA : cA + (size_t)(t + 2) * kstepA; const char* b2 = last ? nB : cB + (size_t)(t + 2) * kstepB;
            const char* a3 = a2 + kstepA; const char* b3 = b2 + kstepB;
            if (last && has_next) S.a_ready(nxt);
            if constexpr (SP2) {
            PG8_LDB(B0, 0, 0); PG8_LDB(B1, 0, 1); PG8_SCHED; PG8_LDA(At, 0, 0); PG8_STAGE(PG8_SA(1, 1), a1 + hstepA, voffA);
            PG8_WAIT_V(8); PG8_WAIT_L(0); PG8_BAR; PG8_MMA(0, 0, At, B0); PG8_MMA(0, 1, At, B1); PG8_BAR; PG8_SCHED;
            PG8_LDA(At, 0, 1); PG8_STAGE(PG8_SB(0, 0), b2, voffB); PG8_STAGE(PG8_SB(0, 1), b2 + hstepB, voffB); PG8_STAGE(PG8_SA(0, 0), a2, voffA);
            PG8_WAIT_V(8); PG8_WAIT_L(0); PG8_BAR; PG8_MMA(1, 0, At, B0); PG8_MMA(1, 1, At, B1); PG8_BAR; PG8_SCHED;
            PG8_LDB(B0, 1, 0); PG8_LDB(B1, 1, 1); PG8_SCHED; PG8_LDA(At, 1, 0); PG8_STAGE(PG8_SA(0, 1), a2 + hstepA, voffA);
            PG8_WAIT_V(8); PG8_WAIT_L(0); PG8_BAR; PG8_MMA(0, 0, At, B0); PG8_MMA(0, 1, At, B1); PG8_BAR; PG8_SCHED;
            PG8_LDA(At, 1, 1); PG8_STAGE(PG8_SB(1, 0), b3, voffB); PG8_STAGE(PG8_SB(1, 1), b3 + hstepB, voffB); PG8_STAGE(PG8_SA(1, 0), a3, voffA);
            PG8_WAIT_V(8); PG8_WAIT_L(0); PG8_BAR; PG8_MMA(1, 0, At, B0); PG8_MMA(1, 1, At, B1); PG8_BAR; PG8_SCHED;
            } else {
            PG8_LDB(B0, 0, 0); PG8_SCHED; PG8_LDA(At, 0, 0); PG8_STAGE(PG8_SA(1, 1), a1 + hstepA, voffA);
            PG8_WAIT_L(8); PG8_BAR; PG8_WAIT_L(0); PG8_MMA(0, 0, At, B0); PG8_BAR; PG8_SCHED;
            PG8_LDB(B1, 0, 1); PG8_STAGE(PG8_SB(0, 0), b2, voffB);
            PG8_BAR; PG8_WAIT_L(0); PG8_MMA(0, 1, At, B1); PG8_BAR;
            PG8_LDA(At, 0, 1); PG8_STAGE(PG8_SA(0, 0), a2, voffA);
            PG8_BAR; PG8_WAIT_L(0); PG8_MMA(1, 0, At, B0); PG8_BAR; PG8_SCHED;
            PG8_STAGE(PG8_SB(0, 1), b2 + hstepB, voffB);
            PG8_WAIT_V(6); PG8_BAR; PG8_MMA(1, 1, At, B1); PG8_BAR;
            PG8_LDB(B0, 1, 0); PG8_SCHED; PG8_LDA(At, 1, 0); PG8_STAGE(PG8_SA(0, 1), a2 + hstepA, voffA);
            PG8_WAIT_L(8); PG8_BAR; PG8_WAIT_L(0); PG8_MMA(0, 0, At, B0); PG8_BAR; PG8_SCHED;
            PG8_LDB(B1, 1, 1); PG8_STAGE(PG8_SB(1, 0), b3, voffB);
            PG8_BAR; PG8_WAIT_L(0); PG8_MMA(0, 1, At, B1); PG8_BAR;
            PG8_LDA(At, 1, 1); PG8_STAGE(PG8_SA(1, 0), a3, voffA);
            PG8_BAR; PG8_WAIT_L(0); PG8_MMA(1, 0, At, B0); PG8_BAR; PG8_SCHED;
            PG8_STAGE(PG8_SB(1, 1), b3 + hstepB, voffB);
            PG8_WAIT_V(6); PG8_BAR; PG8_MMA(1, 1, At, B1); PG8_BAR;
            }
        }
        if constexpr (ALIGN_EPI) { if (wr == 0) PG8_BAR; }
        if constexpr (!Epi::AFTER_DRAIN) { E(acc, cur, wr, wc, fr, fq); S.done(cur); }
        if (!has_next) break;
#pragma unroll
        for (int a = 0; a < 2; ++a)
#pragma unroll
            for (int b = 0; b < 2; ++b)
#pragma unroll
                for (int m = 0; m < 4; ++m)
#pragma unroll
                    for (int n = 0; n < 2; ++n) acc[a][b][m][n] = (f32x4){0.f, 0.f, 0.f, 0.f};
        cur = nxt; cA = nA; cB = nB; ++ui;
        if constexpr (ALIGN_EPI) { if (wr == 1) PG8_BAR; }
    }
    PG8_WAIT_V(0);
    if constexpr (!ALIGN_EPI) { if (wr == 0) PG8_BAR; }
    PG8_BAR;
    if constexpr (Epi::AFTER_DRAIN) { E.fused(acc, cur, wr, wc, fr, fq, lds, wid, lane); S.done(cur); }
#undef PG8_SA
#undef PG8_SB
#undef PG8_STAGE
#undef PG8_LDA
#undef PG8_LDB
#undef PG8_MMA
#undef PG8_WAIT_V
#undef PG8_WAIT_L
#undef PG8_BAR
#undef PG8_SCHED
}
}
#define XB_TMO      128
#define XB_XCNT(j)  (256  + 64 * (j))
#define XB_XSUB(j)  (1280 + 64 * (j))
#define XB_XGEN(j)  (2304 + 64 * (j))
#define XB_TOP      3328
#define XB_TOPGEN   3392
#define XCD_BAR_WORDS 3456
#define XB_SPIN_CAP (1u << 18)

__device__ __forceinline__ unsigned xb_ld(unsigned* p)              { return __hip_atomic_load(p, __ATOMIC_RELAXED, __HIP_MEMORY_SCOPE_AGENT); }
__device__ __forceinline__ unsigned xb_add(unsigned* p, unsigned v) { return __hip_atomic_fetch_add(p, v, __ATOMIC_RELAXED, __HIP_MEMORY_SCOPE_AGENT); }
__device__ __forceinline__ unsigned xb_xcc_id() { return (unsigned)__builtin_amdgcn_s_getreg((3 << 11) | 20) & 0xFu; }
#define XB_SPIN(cond, bar) do { unsigned _sp = 0; while (cond) { __builtin_amdgcn_s_sleep(1); \
    if ((++_sp & 255u) == 0u) { if (xb_ld(&(bar)[XB_TMO])) break; if (_sp > XB_SPIN_CAP) { atomicAdd(&(bar)[XB_TMO], 1u); break; } } } } while (0)

struct XcdBarrier {
    unsigned* bar; unsigned x;
    volatile LAS unsigned* st;
};

__device__ __forceinline__ XcdBarrier xcd_barrier_post(unsigned* bar, volatile LAS unsigned* st) {
    XcdBarrier b; b.bar = bar; b.x = xb_xcc_id(); b.st = st;
    if (threadIdx.x == 0) (void)xb_add(&bar[XB_XCNT(b.x)], 1u);
    return b;
}
__device__ __forceinline__ void xcd_barrier_complete(unsigned* bar, unsigned x, unsigned& nloc, unsigned& nx) {
    const unsigned G = gridDim.x * gridDim.y * gridDim.z;
    unsigned sum, cnt, mine, sp = 0u;
    for (;;) {
        sum = 0u; cnt = 0u; mine = 0u;
#pragma unroll
        for (unsigned j = 0; j < 16; ++j) { const unsigned c = xb_ld(&bar[XB_XCNT(j)]); sum += c; cnt += (c > 0u) ? 1u : 0u; mine = (j == x) ? c : mine; }
        if (sum == G) break;
        __builtin_amdgcn_s_sleep(1);
        if ((++sp & 255u) == 0u) { if (xb_ld(&bar[XB_TMO])) break; if (sp > XB_SPIN_CAP) { atomicAdd(&bar[XB_TMO], 1u); break; } }
    }
    nloc = mine > 0u ? mine : 1u; nx = cnt > 0u ? cnt : 1u;
}

__device__ __forceinline__ void xcd_barrier(const XcdBarrier& b) {
    asm volatile("s_waitcnt vmcnt(0)" ::: "memory");
    __syncthreads();
    if (threadIdx.x == 0) {
        unsigned* bar = b.bar;
        __builtin_amdgcn_s_waitcnt(0);
        unsigned nloc = b.st[0], nx = b.st[1];
        if (nloc == 0u) { xcd_barrier_complete(bar, b.x, nloc, nx); b.st[0] = nloc; b.st[1] = nx; }
        const unsigned old = xb_add(&bar[XB_XSUB(b.x)], 1u);
        const unsigned gen = old / nloc;
        if (old + 1u == (gen + 1u) * nloc) {
            __builtin_amdgcn_fence(__ATOMIC_RELEASE, "agent");
            asm volatile("s_waitcnt vmcnt(0)" ::: "memory");
            const unsigned og = xb_add(&bar[XB_TOP], 1u);
            const unsigned tg = og / nx;
            if (og + 1u == (tg + 1u) * nx) xb_add(&bar[XB_TOPGEN], 1u);
            else XB_SPIN(xb_ld(&bar[XB_TOPGEN]) == tg, bar);
            __builtin_amdgcn_fence(__ATOMIC_ACQUIRE, "agent");
            xb_add(&bar[XB_XGEN(b.x)], 1u);
            asm volatile("s_waitcnt vmcnt(0)" ::: "memory");
        } else {
            XB_SPIN(xb_ld(&bar[XB_XGEN(b.x)]) == gen, bar);
            __builtin_amdgcn_fence(__ATOMIC_ACQUIRE, "agent");
            asm volatile("s_waitcnt vmcnt(0)" ::: "memory");
        }
    }
    __syncthreads();
}
__device__ __forceinline__ void sincos_rev(float ang, float& s, float& c) {
    double rev = (double)ang * 0.15915494309189535; rev -= rint(rev);
    float r = (float)rev; s = __builtin_amdgcn_sinf(r); c = __builtin_amdgcn_cosf(r);
}
__device__ __forceinline__ int inproj_src_col(int c) {
    if (c < 1152) return c;
    if (c < 1536) return 1170 + (c - 1152);
    if (c < 3168) return c + 18;
    if (c < 3200) return (c - 3168 < 18) ? 1152 + (c - 3168) : -1;
    if (c < 3520) return c - 14;
    return -1;
}
namespace fa {
typedef short bf16x8 __attribute__((ext_vector_type(8)));
typedef short s16x4 __attribute__((ext_vector_type(4)));
typedef float f32x16 __attribute__((ext_vector_type(16)));
typedef unsigned u32x4 __attribute__((ext_vector_type(4)));
typedef __attribute__((address_space(3))) const char* lds_cptr;
typedef __attribute__((address_space(3))) char* lds_ptr;
#define FA_LAS __attribute__((address_space(3)))

constexpr int STAGE_B = 20480, KIMG = 0, VIMG = 12288;
constexpr int L_WSF = 2 * STAGE_B, L_MISC = L_WSF + 2048, L_OST = L_MISC + 2048, OST_RS = 68, OST_WB = 32 * OST_RS * 4;
constexpr int L_END = L_OST + 8 * OST_WB;
static_assert(L_END <= 131072, "attention LDS map");
constexpr float NEG_INF = -INFINITY;
constexpr float THR = 6.0f;

__device__ __forceinline__ float ex2(float x) { return __builtin_amdgcn_exp2f(x); }
__device__ __forceinline__ int crow(int r, int hi) { return (r & 3) + 8 * (r >> 2) + 4 * hi; }
__device__ __forceinline__ unsigned cvtpk(float lo, float hi) { typedef float f2 __attribute__((ext_vector_type(2))); typedef __bf16 b2 __attribute__((ext_vector_type(2))); f2 v = {lo, hi}; b2 b = __builtin_convertvector(v, b2); return __builtin_bit_cast(unsigned, b); }

struct KVSrc { const bf16_t* K; const bf16_t* V; int kpitch, vpitch; };
struct StageRegs { u32x4 k0, k1, v; };

template <int NKC>
__device__ __forceinline__ void stage_load(StageRegs& R, const KVSrc& s, int key0, int tid, int wave, int lane) {
    R.k0 = *(const u32x4*)(s.K + (size_t)(key0 + (tid & 63)) * s.kpitch + (tid >> 6) * 8);
    if (NKC == 12) { if (tid < 256) R.k1 = *(const u32x4*)(s.K + (size_t)(key0 + (tid & 63)) * s.kpitch + (8 + (tid >> 6)) * 8); }
    R.v = *(const u32x4*)(s.V + (size_t)(key0 + 16 * (wave & 3) + (lane >> 2)) * s.vpitch + 32 * (wave >> 2) + 8 * (lane & 3));
}
template <int NKC>
__device__ __forceinline__ void stage_write(const StageRegs& R, lds_ptr st, int tid, int wave, int lane) {
    *(FA_LAS u32x4*)(st + KIMG + (tid >> 6) * 1024 + (tid & 63) * 16) = R.k0;
    if (NKC == 12) { if (tid < 256) *(FA_LAS u32x4*)(st + KIMG + (8 + (tid >> 6)) * 1024 + (tid & 63) * 16) = R.k1; }
    *(FA_LAS u32x4*)(st + VIMG + wave * 1024 + lane * 16) = R.v;
}

template <int NK>
__device__ __forceinline__ void qkt(f32x16& p0, f32x16& p1, lds_cptr Kimg, const bf16x8* qr, const f32x16& cinit, int r32, int hi) {
    lds_cptr kb = Kimg + hi * 1024 + r32 * 16;
#pragma unroll
    for (int d0 = 0; d0 < NK; ++d0) {
        const bf16x8 b0 = *(const FA_LAS bf16x8*)(kb + d0 * 2048), b1 = *(const FA_LAS bf16x8*)(kb + d0 * 2048 + 512);
        if (d0 == 0) { p0 = __builtin_amdgcn_mfma_f32_32x32x16_bf16(b0, qr[0], cinit, 0, 0, 0); p1 = __builtin_amdgcn_mfma_f32_32x32x16_bf16(b1, qr[0], cinit, 0, 0, 0); }
        else { p0 = __builtin_amdgcn_mfma_f32_32x32x16_bf16(b0, qr[d0], p0, 0, 0, 0); p1 = __builtin_amdgcn_mfma_f32_32x32x16_bf16(b1, qr[d0], p1, 0, 0, 0); }
    }
}
typedef short v4i16_t __attribute__((ext_vector_type(4)));
__device__ __forceinline__ s16x4 vtr(lds_cptr p) { return __builtin_bit_cast(s16x4, __builtin_amdgcn_ds_read_tr16_b64_v4i16((FA_LAS v4i16_t*)p)); }
__device__ __forceinline__ void pv(f32x16* o, lds_cptr vp, const u32x4& w0, const u32x4& w1, const u32x4& w2, const u32x4& w3) {
    const bf16x8 pa[4] = {__builtin_bit_cast(bf16x8, w0), __builtin_bit_cast(bf16x8, w1), __builtin_bit_cast(bf16x8, w2), __builtin_bit_cast(bf16x8, w3)};
#pragma unroll
    for (int d0 = 0; d0 < 2; ++d0)
#pragma unroll
        for (int ks = 0; ks < 4; ++ks) {
            const s16x4 lo = vtr(vp + d0 * 4096 + ks * 1024), hi_ = vtr(vp + d0 * 4096 + ks * 1024 + 512);
            const bf16x8 vf = {lo[0], lo[1], lo[2], lo[3], hi_[0], hi_[1], hi_[2], hi_[3]};
            o[d0] = __builtin_amdgcn_mfma_f32_32x32x16_bf16(pa[ks], vf, o[d0], 0, 0, 0);
        }
}
__device__ __forceinline__ float mx2(float a, float b) { return __builtin_amdgcn_fmed3f(a, b, INFINITY); }
__device__ __forceinline__ float rowmax32(const f32x16& p0, const f32x16& p1) {
    float a = mx2(p0[0], p1[0]), b = mx2(p0[1], p1[1]);
#pragma unroll
    for (int r = 2; r < 16; r += 2) { a = mx2(a, mx2(p0[r], p1[r])); b = mx2(b, mx2(p0[r + 1], p1[r + 1])); }
    a = mx2(a, b);
    auto rr = __builtin_amdgcn_permlane32_swap(__float_as_uint(a), __float_as_uint(a), false, false);
    return mx2(__uint_as_float(rr[0]), __uint_as_float(rr[1]));
}

constexpr int MK_CAUSAL = 0, MK_SEL = 1, MK_WIN = 2;

__device__ __forceinline__ float max3f(float a, float b, float c) { float r; asm("v_max3_f32 %0, %1, %2, %3" : "=v"(r) : "v"(a), "v"(b), "v"(c)); return r; }
__device__ __forceinline__ float rowmax32a(const f32x16& p0, const f32x16& p1) {
    float a = max3f(p0[0], p0[1], p1[0]), b = max3f(p0[2], p0[3], p1[1]); a = max3f(a, p1[2], p1[3]);
#pragma unroll
    for (int r = 4; r < 16; r += 4) { a = max3f(a, p0[r], p0[r + 1]); b = max3f(b, p0[r + 2], p0[r + 3]); a = max3f(a, p1[r], p1[r + 1]); b = max3f(b, p1[r + 2], p1[r + 3]); }
    float m; asm("v_max_f32_e32 %0, %1, %2" : "=v"(m) : "v"(a), "v"(b));
    auto rr = __builtin_amdgcn_permlane32_swap(__float_as_uint(m), __float_as_uint(m), false, false);
    float q; asm("v_max_f32_e32 %0, %1, %2" : "=v"(q) : "v"(__uint_as_float(rr[0])), "v"(__uint_as_float(rr[1]))); return q;
}

template <int MKIND>
__device__ __forceinline__ void apply_masks(f32x16& p0, f32x16& p1, int t, int qidx, int wrow0, int hi) {
    const int kb = 64 * t + 4 * hi;
    if (64 * t + 63 > wrow0) {
#pragma unroll
        for (int r = 0; r < 16; ++r) { const int kv = kb + (r & 3) + 8 * (r >> 2); if (kv > qidx) p0[r] = NEG_INF; if (kv + 32 > qidx) p1[r] = NEG_INF; }
    }
    if (MKIND == MK_WIN) { if (64 * t <= wrow0 + 31 - 512) {
#pragma unroll
        for (int r = 0; r < 16; ++r) { const int kv = kb + (r & 3) + 8 * (r >> 2); if (kv <= qidx - 512) p0[r] = NEG_INF; if (kv + 32 <= qidx - 512) p1[r] = NEG_INF; }
    } }
}
template <int MKIND> __device__ __forceinline__ bool tile_boundary(int t, int wrow0) {
    return (64 * t + 63 > wrow0) || (MKIND == MK_WIN && 64 * t <= wrow0 + 31 - 512);
}

template <int MKIND, int NK, int NKC>
__device__ __forceinline__ void softmax_branch(f32x16 (&o)[2], float& l, lds_ptr lds, const KVSrc& src, const bf16x8* qr, int t_lo, int t_hi, int qidx, int wrow0, u64 selmask, int tid, int wave, int lane) {
    const int r32 = lane & 31, hi = lane >> 5;
    FA_LAS float* wsf = (FA_LAS float*)(lds + L_WSF) + wave * 64;
    lds_cptr vlane = (lds_cptr)lds + VIMG + ((lane >> 4) & 1) * 32 + (lane & 3) * 8 + (4 * hi + ((lane & 15) >> 2)) * 64;
    float mu = 0.f; bool mvalid = false; l = 0.f; { f32x16 z = {}; o[0] = z; o[1] = z; }
    const f32x16 zc = {};
    u32x4 wp0 = {0u, 0u, 0u, 0u}, wp1 = wp0, wp2 = wp0, wp3 = wp0;
    {
        u32x4 kA0, kA1, kB0, kB1; const u32x4 zz = {0u, 0u, 0u, 0u};
        kA0 = *(const u32x4*)(src.K + (size_t)(t_lo * 64 + (tid & 63)) * src.kpitch + (tid >> 6) * 8);
        if (NKC == 12) { if (tid < 256) kA1 = *(const u32x4*)(src.K + (size_t)(t_lo * 64 + (tid & 63)) * src.kpitch + (8 + (tid >> 6)) * 8); }
        const int t1 = (t_lo < t_hi) ? t_lo + 1 : t_lo;
        kB0 = *(const u32x4*)(src.K + (size_t)(t1 * 64 + (tid & 63)) * src.kpitch + (tid >> 6) * 8);
        if (NKC == 12) { if (tid < 256) kB1 = *(const u32x4*)(src.K + (size_t)(t1 * 64 + (tid & 63)) * src.kpitch + (8 + (tid >> 6)) * 8); }
        lds_ptr sa = lds + (t_lo & 1) * STAGE_B, sb = lds + ((t_lo + 1) & 1) * STAGE_B;
        *(FA_LAS u32x4*)(sa + KIMG + (tid >> 6) * 1024 + (tid & 63) * 16) = kA0; *(FA_LAS u32x4*)(sb + KIMG + (tid >> 6) * 1024 + (tid & 63) * 16) = kB0;
        if (NKC == 12) { if (tid < 256) { *(FA_LAS u32x4*)(sa + KIMG + (8 + (tid >> 6)) * 1024 + (tid & 63) * 16) = kA1; *(FA_LAS u32x4*)(sb + KIMG + (8 + (tid >> 6)) * 1024 + (tid & 63) * 16) = kB1; } }
        *(FA_LAS u32x4*)(sa + VIMG + tid * 16) = zz; *(FA_LAS u32x4*)(sb + VIMG + tid * 16) = zz;
    }
    __syncthreads();
    f32x16 pA0, pA1, pB0, pB1;
    qkt<NK>(pA0, pA1, (lds_cptr)lds + (t_lo & 1) * STAGE_B + KIMG, qr, zc, r32, hi);
    if (tile_boundary<MKIND>(t_lo, wrow0)) apply_masks<MKIND>(pA0, pA1, t_lo, qidx, wrow0, hi);
    __syncthreads();
#define FA_STEP(C0, C1, N0, N1, t) do { \
        const int t_ = (t); \
        u32x4 gk0, gk1, gv; const bool ldk = (t_ + 2 <= t_hi); \
        if (ldk) { gk0 = *(const u32x4*)(src.K + (size_t)((t_ + 2) * 64 + (tid & 63)) * src.kpitch + (tid >> 6) * 8); \
            if (NKC == 12) { if (tid < 256) gk1 = *(const u32x4*)(src.K + (size_t)((t_ + 2) * 64 + (tid & 63)) * src.kpitch + (8 + (tid >> 6)) * 8); } } \
        gv = *(const u32x4*)(src.V + (size_t)(t_ * 64 + 16 * (wave & 3) + (lane >> 2)) * src.vpitch + 32 * (wave >> 2) + 8 * (lane & 3)); \
        asm volatile("s_nop 7\n\ts_nop 7" : "+v"(C0), "+v"(C1));     \
        float rm = rowmax32a(C0, C1) - mu;     \
        bool rowon = true; if (MKIND == MK_SEL) { rowon = ((selmask >> t_) & 1ull) != 0ull; rm = rowon ? rm : NEG_INF; } \
        const bool trig = mvalid ? (rm > THR) : (rm > NEG_INF); \
        bool fix = false; float delta = 0.f; \
        if (__any(trig)) { fix = true; delta = mvalid ? fmaxf(rm, 0.f) : ((rm > NEG_INF) ? rm : 0.f); const float f = mvalid ? ex2(-delta) : 1.f; \
            l *= f; mu += delta; mvalid = mvalid || (rm > NEG_INF); if (hi == 0) wsf[r32] = f; } \
          \
        qkt<NK>(N0, N1, (lds_cptr)lds + ((t_ + 1) & 1) * STAGE_B + KIMG, qr, zc, r32, hi); \
        float sum = 0.f; \
        _Pragma("unroll") for (int r = 0; r < 16; ++r) { C0[r] = ex2(C0[r] - mu); C1[r] = ex2(C1[r] - mu); sum += C0[r] + C1[r]; } \
        l += (MKIND == MK_SEL) ? (rowon ? sum : 0.f) : sum; \
        pv(o, vlane + ((t_ + 1) & 1) * STAGE_B, wp0, wp1, wp2, wp3);     \
        wp0.x = cvtpk(C0[0], C0[1]); wp0.y = cvtpk(C0[2], C0[3]); wp0.z = cvtpk(C0[4], C0[5]); wp0.w = cvtpk(C0[6], C0[7]); \
        wp1.x = cvtpk(C0[8], C0[9]); wp1.y = cvtpk(C0[10], C0[11]); wp1.z = cvtpk(C0[12], C0[13]); wp1.w = cvtpk(C0[14], C0[15]); \
        wp2.x = cvtpk(C1[0], C1[1]); wp2.y = cvtpk(C1[2], C1[3]); wp2.z = cvtpk(C1[4], C1[5]); wp2.w = cvtpk(C1[6], C1[7]); \
        wp3.x = cvtpk(C1[8], C1[9]); wp3.y = cvtpk(C1[10], C1[11]); wp3.z = cvtpk(C1[12], C1[13]); wp3.w = cvtpk(C1[14], C1[15]); \
        if (MKIND == MK_SEL) { \
            _Pragma("unroll") for (int e = 0; e < 4; ++e) { wp0[e] = rowon ? wp0[e] : 0u; wp1[e] = rowon ? wp1[e] : 0u; wp2[e] = rowon ? wp2[e] : 0u; wp3[e] = rowon ? wp3[e] : 0u; } } \
          \
        if (fix) { asm volatile("s_waitcnt lgkmcnt(0)" ::: "memory"); \
            _Pragma("unroll") for (int g = 0; g < 4; ++g) { const f32x4 fv = *(const FA_LAS f32x4*)(wsf + 8 * g + 4 * hi); \
                _Pragma("unroll") for (int e = 0; e < 4; ++e) { o[0][4 * g + e] *= fv[e]; o[1][4 * g + e] *= fv[e]; } } \
            } \
        if (t_ + 1 <= t_hi) { if (tile_boundary<MKIND>(t_ + 1, wrow0)) apply_masks<MKIND>(N0, N1, t_ + 1, qidx, wrow0, hi); } \
        { lds_ptr sw = lds + (t_ & 1) * STAGE_B; \
          if (ldk) { *(FA_LAS u32x4*)(sw + KIMG + (tid >> 6) * 1024 + (tid & 63) * 16) = gk0; \
              if (NKC == 12) { if (tid < 256) *(FA_LAS u32x4*)(sw + KIMG + (8 + (tid >> 6)) * 1024 + (tid & 63) * 16) = gk1; } } \
          *(FA_LAS u32x4*)(sw + VIMG + wave * 1024 + lane * 16) = gv; } \
        __syncthreads(); \
    } while (0)
    int t = t_lo;
    for (;;) {
        FA_STEP(pA0, pA1, pB0, pB1, t); if (t == t_hi) break; ++t;
        FA_STEP(pB0, pB1, pA0, pA1, t); if (t == t_hi) break; ++t;
    }
#undef FA_STEP
    pv(o, vlane + (t_hi & 1) * STAGE_B, wp0, wp1, wp2, wp3);
    __syncthreads();
}

template <bool FIRST>
__device__ __forceinline__ void stage_acc(const f32x16 (&o)[2], float fac, lds_ptr lds, int wave, int lane) {
    const int r32 = lane & 31, hi = lane >> 5;
    FA_LAS float* wsf = (FA_LAS float*)(lds + L_WSF) + wave * 64;
    FA_LAS float* stg = (FA_LAS float*)(lds + L_OST + wave * OST_WB);
    asm volatile("s_waitcnt lgkmcnt(0)" ::: "memory");
    if (hi == 0) wsf[r32] = fac;
    asm volatile("s_waitcnt lgkmcnt(0)" ::: "memory");
#pragma unroll
    for (int g = 0; g < 4; ++g) { const f32x4 fv = *(const FA_LAS f32x4*)(wsf + 8 * g + 4 * hi);
#pragma unroll
        for (int e = 0; e < 4; ++e) { const int r = 4 * g + e, q = crow(r, hi); FA_LAS float* p0_ = stg + q * OST_RS + r32;
            if (FIRST) { p0_[0] = o[0][r] * fv[e]; p0_[32] = o[1][r] * fv[e]; } else { p0_[0] += o[0][r] * fv[e]; p0_[32] += o[1][r] * fv[e]; } } }
    asm volatile("s_waitcnt lgkmcnt(0)" ::: "memory");
}
__device__ __forceinline__ void store_rows(lds_ptr lds, int wave, int lane, bf16_t* mixrow0  , const bf16_t* addrow0, int addpitch, const bf16_t* mulrow0, int mulpitch) {
    FA_LAS float* stg = (FA_LAS float*)(lds + L_OST + wave * OST_WB);
#pragma unroll
    for (int i = 0; i < 4; ++i) {
        const int row = i * 8 + (lane >> 3), ch = lane & 7;
        const f32x4 a = *(const FA_LAS f32x4*)(stg + row * OST_RS + ch * 8), b = *(const FA_LAS f32x4*)(stg + row * OST_RS + ch * 8 + 4);
        float v[8] = {a[0], a[1], a[2], a[3], b[0], b[1], b[2], b[3]};
        if (addrow0) { const u32x4 ad = *(const u32x4*)(addrow0 + (size_t)row * addpitch + ch * 8);
            v[0] += blo(ad.x); v[1] += bhi(ad.x); v[2] += blo(ad.y); v[3] += bhi(ad.y); v[4] += blo(ad.z); v[5] += bhi(ad.z); v[6] += blo(ad.w); v[7] += bhi(ad.w); }
        const u32x4 mu = *(const u32x4*)(mulrow0 + (size_t)row * mulpitch + ch * 8);
        v[0] *= blo(mu.x); v[1] *= bhi(mu.x); v[2] *= blo(mu.y); v[3] *= bhi(mu.y); v[4] *= blo(mu.z); v[5] *= bhi(mu.z); v[6] *= blo(mu.w); v[7] *= bhi(mu.w);
        u32x4 ov; ov.x = cvtpk(v[0], v[1]); ov.y = cvtpk(v[2], v[3]); ov.z = cvtpk(v[4], v[5]); ov.w = cvtpk(v[6], v[7]);
        *(u32x4*)(mixrow0 + (size_t)row * DM + ch * 8) = ov;
    }
    asm volatile("s_waitcnt lgkmcnt(0)" ::: "memory");
}

__device__ __forceinline__ void unit_mla(unsigned char* ws, lds_ptr lds, int b, int h, int qb, int tid, int wave, int lane) {
    const int r32 = lane & 31, hi = lane >> 5; const int q0 = qb * 256, wrow0 = q0 + 32 * wave, qidx = wrow0 + r32; const size_t m0 = (size_t)b * SEQ;
    const bf16_t* MQ = (const bf16_t*)(ws + WS_MQ); const bf16_t* MKp = (const bf16_t*)(ws + WS_MK); const bf16_t* MV = (const bf16_t*)(ws + WS_MV); const bf16_t* ACT = (const bf16_t*)(ws + WS_ACT); bf16_t* MIX = (bf16_t*)(ws + WS_MIX);
    bf16x8 qr[6];
#pragma unroll
    for (int d0 = 0; d0 < 6; ++d0) qr[d0] = *(const bf16x8*)(MQ + (m0 + qidx) * 480 + h * 96 + d0 * 16 + hi * 8);
    KVSrc src{MKp + m0 * 480 + h * 96, MV + m0 * 320 + h * 64, 480, 320};
    f32x16 o[2]; float l;
    softmax_branch<MK_CAUSAL, 6, 12>(o, l, lds, src, qr, 0, (q0 + 255) >> 6, qidx, wrow0, 0ull, tid, wave, lane);
    l = psum32(l);
    stage_acc<true>(o, 1.f / l, lds, wave, lane);
    store_rows(lds, wave, lane, MIX + (m0 + wrow0) * DM + 704 + h * 64, nullptr, 0, ACT + (m0 + wrow0) * ACTW + A_MZ + h * 64, ACTW);
}
__device__ __forceinline__ void unit_nsa(unsigned char* ws, lds_ptr lds, int b, int h, int qb, int tid, int wave, int lane) {
    const int r32 = lane & 31, hi = lane >> 5; const int q0 = qb * 256, wrow0 = q0 + 32 * wave, qidx = wrow0 + r32, g = h / 3; const size_t m0 = (size_t)b * SEQ;
    const bf16_t* ACT = (const bf16_t*)(ws + WS_ACT); const bf16_t* OC = (const bf16_t*)(ws + WS_OC); const u64* SEL = (const u64*)(ws + WS_SEL); bf16_t* MIX = (bf16_t*)(ws + WS_MIX);
    bf16x8 qr[4];
#pragma unroll
    for (int d0 = 0; d0 < 4; ++d0) qr[d0] = *(const bf16x8*)(ACT + (m0 + qidx) * ACTW + A_NQ + h * 64 + d0 * 16 + hi * 8);
    const u64 sel = SEL[(size_t)(b * 2 + g) * SEQ + qidx];
    const float gs = bf2f(ACT[(m0 + qidx) * ACTW + A_GATE + h * 3 + 1]), gw = bf2f(ACT[(m0 + qidx) * ACTW + A_GATE + h * 3 + 2]);
    {
        KVSrc src{ACT + m0 * ACTW + A_KS + g * 64, ACT + m0 * ACTW + A_VS + g * 64, ACTW, ACTW};
        f32x16 o[2]; float l;
        softmax_branch<MK_SEL, 4, 8>(o, l, lds, src, qr, 0, (q0 + 255) >> 6, qidx, wrow0, sel, tid, wave, lane);
        l = psum32(l);
        stage_acc<true>(o, gs / l, lds, wave, lane);
    }
    {
        KVSrc src{ACT + m0 * ACTW + A_KW + g * 64, ACT + m0 * ACTW + A_VW + g * 64, ACTW, ACTW};
        f32x16 o[2]; float l; const int tlo = (q0 >= 512) ? ((q0 - 512) >> 6) : 0;
        softmax_branch<MK_WIN, 4, 8>(o, l, lds, src, qr, tlo, (q0 + 255) >> 6, qidx, wrow0, 0ull, tid, wave, lane);
        l = psum32(l);
        stage_acc<false>(o, gw / l, lds, wave, lane);
    }
    store_rows(lds, wave, lane, MIX + (m0 + wrow0) * DM + h * 64, OC + (m0 + wrow0) * 384 + h * 64, 384, ACT + (m0 + wrow0) * ACTW + A_NZ + h * 64, ACTW);
}

constexpr float SB_CUT = 104.0f;
__device__ __forceinline__ void unit_sb(unsigned char* ws, lds_ptr lds, int b, int h, int qb, int tid, int wave, int lane) {
    const int r32 = lane & 31, hi = lane >> 5; const int q0 = qb * 256, wrow0 = q0 + 32 * wave, qidx = wrow0 + r32; const size_t m0 = (size_t)b * SEQ;
    const bf16_t* ACT = (const bf16_t*)(ws + WS_ACT); bf16_t* MIX = (bf16_t*)(ws + WS_MIX);
    bf16x8 qr[4];
#pragma unroll
    for (int d0 = 0; d0 < 4; ++d0) qr[d0] = *(const bf16x8*)(ACT + (m0 + qidx) * ACTW + A_SQ + h * 64 + d0 * 16 + hi * 8);
    KVSrc src{ACT + m0 * ACTW + A_SK + h * 64, ACT + m0 * ACTW + A_SV + h * 64, ACTW, ACTW};
    FA_LAS unsigned* flags = (FA_LAS unsigned*)(lds + L_MISC) + 16;
    lds_cptr vlane = (lds_cptr)lds + VIMG + ((lane >> 4) & 1) * 32 + (lane & 3) * 8 + (4 * hi + ((lane & 15) >> 2)) * 64;
    f32x16 o[2]; { f32x16 z = {}; o[0] = z; o[1] = z; }
    float R = 0.f;
    const int t_hi = (q0 + 255) >> 6;
    StageRegs SR;
    stage_load<8>(SR, src, t_hi * 64, tid, wave, lane);
    stage_write<8>(SR, lds, tid, wave, lane);
    __syncthreads();
    for (int t = t_hi; t >= 0; --t) {
        const int it = t_hi - t, cur = it & 1; lds_ptr st = lds + cur * STAGE_B; lds_ptr stn = lds + (cur ^ 1) * STAGE_B;
        if (t > 0) stage_load<8>(SR, src, (t - 1) * 64, tid, wave, lane);
        const bool mydone = __all(R >= SB_CUT) != 0;
        const bool need = (64 * t < wrow0 + 31) && !mydone;
        if (need) {
            f32x16 p0, p1;
            { const f32x16 zc = {}; qkt<4>(p0, p1, (lds_cptr)st + KIMG, qr, zc, r32, hi); }
            const bool diag = (64 * t + 63 >= wrow0);
            const int kb = 64 * t + 4 * hi;
            f32x16 s0, s1;
#pragma unroll
            for (int r = 0; r < 16; ++r) {
                const float z0 = p0[r], z1 = p1[r];
                float a0 = fmaxf(z0, 0.f) + 0.6931471805599453f * __log2f(1.f + ex2(-fabsf(z0) * LOG2E));
                float a1 = fmaxf(z1, 0.f) + 0.6931471805599453f * __log2f(1.f + ex2(-fabsf(z1) * LOG2E));
                if (diag) { const int kv = kb + (r & 3) + 8 * (r >> 2); if (kv >= qidx) a0 = 0.f; if (kv + 32 >= qidx) a1 = 0.f; }
                s0[r] = a0; s1[r] = a1;
            }
            float T[8];
#pragma unroll
            for (int i = 0; i < 4; ++i) {
                s0[4 * i + 2] += s0[4 * i + 3]; s0[4 * i + 1] += s0[4 * i + 2]; s0[4 * i] += s0[4 * i + 1]; T[i] = s0[4 * i];
                s1[4 * i + 2] += s1[4 * i + 3]; s1[4 * i + 1] += s1[4 * i + 2]; s1[4 * i] += s1[4 * i + 1]; T[4 + i] = s1[4 * i];
            }
            float TP[8];
#pragma unroll
            for (int i = 0; i < 8; ++i) TP[i] = pxchg32(T[i], hi);
            float accS = R, suf[8];
#pragma unroll
            for (int i = 7; i >= 0; --i) { suf[i] = accS + (hi == 0 ? TP[i] : 0.f); accS += T[i] + TP[i]; }
            R = accS;
#pragma unroll
            for (int r = 0; r < 16; ++r) {
                float a0 = ex2((p0[r] - (s0[r] + suf[r >> 2])) * LOG2E), a1 = ex2((p1[r] - (s1[r] + suf[4 + (r >> 2)])) * LOG2E);
                if (diag) { const int kv = kb + (r & 3) + 8 * (r >> 2); if (kv >= qidx) a0 = 0.f; if (kv + 32 >= qidx) a1 = 0.f; }
                p0[r] = a0; p1[r] = a1;
            }
            u32x4 w0, w1, w2, w3;
            w0.x = cvtpk(p0[0], p0[1]); w0.y = cvtpk(p0[2], p0[3]); w0.z = cvtpk(p0[4], p0[5]); w0.w = cvtpk(p0[6], p0[7]);
            w1.x = cvtpk(p0[8], p0[9]); w1.y = cvtpk(p0[10], p0[11]); w1.z = cvtpk(p0[12], p0[13]); w1.w = cvtpk(p0[14], p0[15]);
            w2.x = cvtpk(p1[0], p1[1]); w2.y = cvtpk(p1[2], p1[3]); w2.z = cvtpk(p1[4], p1[5]); w2.w = cvtpk(p1[6], p1[7]);
            w3.x = cvtpk(p1[8], p1[9]); w3.y = cvtpk(p1[10], p1[11]); w3.z = cvtpk(p1[12], p1[13]); w3.w = cvtpk(p1[14], p1[15]);
            pv(o, vlane + cur * STAGE_B, w0, w1, w2, w3);
        }
        const bool fin = (__all(R >= SB_CUT) != 0) || (t == 0);
        if (lane == 0) flags[cur * 8 + wave] = fin ? 1u : 0u;
        if (t > 0) stage_write<8>(SR, stn, tid, wave, lane);
        __syncthreads();
        unsigned alld = 1u;
#pragma unroll
        for (int w = 0; w < 8; ++w) alld &= flags[cur * 8 + w];
        if (alld) break;
    }
    __syncthreads();
    stage_acc<true>(o, 1.f, lds, wave, lane);
    store_rows(lds, wave, lane, MIX + (m0 + wrow0) * DM + 384 + h * 64, nullptr, 0, ACT + (m0 + wrow0) * ACTW + A_SZ + h * 64, ACTW);
}

constexpr int N_HEAVY = 16 * 88, N_UNITS = N_HEAVY + 16 * 40;
#ifndef PROBE_ATT
#define PROBE_ATT (0)
#endif
__device__ __forceinline__ void attn_phase(unsigned char* ws, lds_ptr lds, unsigned* qctr, int tid, int wave, int lane) {
    FA_LAS int* ubox = (FA_LAS int*)(lds + L_MISC);
    for (int pass = 0; pass < (PROBE_ATT ? 2 : 1); ++pass)
    for (;;) {
        if (tid == 0) ubox[0] = (int)atomicAdd(qctr + 16 * pass, 1u);
        __syncthreads();
        const int u = ubox[0];
        __syncthreads();
        if (u >= N_UNITS) break;
        if (pass == 1) { const bool heavy = u < N_HEAVY; const bool isnsa = heavy && (u % 88) < 48; const int kind = heavy ? (isnsa ? 1 : 2) : 3; if (kind != PROBE_ATT) continue; }
        asm volatile("" : "+v"(tid), "+v"(lane));
        if (u < N_HEAVY) { const int qb = 15 - u / 88, r = u % 88;
            if (r < 48) unit_nsa(ws, lds, r / 6, r % 6, qb, tid, wave, lane);
            else unit_mla(ws, lds, (r - 48) / 5, (r - 48) % 5, qb, tid, wave, lane);
        } else { const int v = u - N_HEAVY; unit_sb(ws, lds, (v % 40) / 5, v % 5, 15 - v / 40, tid, wave, lane); }
        __syncthreads();
    }
}
}
namespace cm {
using fa::bf16x8; using fa::f32x16; using fa::u32x4; using fa::lds_cptr; using fa::lds_ptr; using fa::crow; using fa::ex2; using fa::cvtpk; using fa::vtr; using fa::s16x4;
#define CM_LAS __attribute__((address_space(3)))

__device__ __forceinline__ int tok_off(int T, int c) { return T * 128 + (T >> 7) * 128 + ((c ^ ((T >> 4) & 7)) << 4); }
constexpr int L_TOK = 0, L_RED = 69632, L_HID = L_RED + 16384, HID_PITCH = 272;
__device__ __forceinline__ void compress_unit(unsigned char* ws, lds_ptr lds, int l, int kv, int bg, int nb, int tid, int wave, int lane) {
    const int b = bg >> 1, g = bg & 1, n0 = 32 * nb, r32 = lane & 31, hi = lane >> 5, cg = wave & 3, kh = wave >> 2;
    const bf16_t* ACT = (const bf16_t*)(ws + WS_ACT);
    const bf16_t* src = ACT + (size_t)b * SEQ * ACTW + (kv ? A_VC : A_KC) + g * 64;
    for (int idx = tid; idx < 528 * 8; idx += 512) { const int T = idx >> 3, c = idx & 7; int tok = 16 * n0 + T; tok = tok > SEQ - 1 ? SEQ - 1 : tok;
        *(CM_LAS u32x4*)(lds + L_TOK + tok_off(T, c)) = *(const u32x4*)(src + (size_t)tok * ACTW + c * 8); }
    __syncthreads();
    const bf16_t* W1T = (const bf16_t*)(ws + WS_W1T) + (size_t)((l * 2 + kv) * 128 + 32 * cg + r32) * 2048 + kh * 1024 + 8 * hi;
    f32x16 acc = {};
#pragma unroll 8
    for (int ks = 0; ks < 64; ++ks) {
        const int k = kh * 1024 + ks * 16 + 8 * hi; const int T = 16 * r32 + (k >> 6), c = (k & 63) >> 3;
        const bf16x8 a = *(const CM_LAS bf16x8*)(lds + L_TOK + tok_off(T, c));
        const bf16x8 bfrag = *(const bf16x8*)(W1T + ks * 16);
        acc = __builtin_amdgcn_mfma_f32_32x32x16_bf16(a, bfrag, acc, 0, 0, 0);
    }
    CM_LAS float* red = (CM_LAS float*)(lds + L_RED) + cg * 1024;
    if (kh == 1) {
#pragma unroll
        for (int r = 0; r < 16; ++r) red[r * 64 + lane] = acc[r];
    }
    __syncthreads();
    if (kh == 0) {
        const float* pp = (const float*)(ws + WS_POSBP) + (size_t)(l * 2 + kv) * 32 * 128 + 32 * cg + r32; float pb = 0.f;
        for (int i = 0; i < 32; ++i) pb += pp[i * 128];
#pragma unroll
        for (int r = 0; r < 16; ++r) { const float v = acc[r] + red[r * 64 + lane] + pb; const float s = silu_f(v);
            *(CM_LAS bf16_t*)(lds + L_HID + crow(r, hi) * HID_PITCH + (32 * cg + r32) * 2) = f2bf(s); }
    }
    __syncthreads();
    if (wave < 2) {
        const bf16_t* W2T = (const bf16_t*)(ws + WS_W2T) + (size_t)((l * 2 + kv) * 64 + 32 * wave + r32) * 128 + 8 * hi;
        f32x16 o = {};
#pragma unroll
        for (int ks = 0; ks < 8; ++ks) {
            const bf16x8 a = *(const CM_LAS bf16x8*)(lds + L_HID + r32 * HID_PITCH + (ks * 16 + 8 * hi) * 2);
            const bf16x8 bfrag = *(const bf16x8*)(W2T + ks * 16);
            o = __builtin_amdgcn_mfma_f32_32x32x16_bf16(a, bfrag, o, 0, 0, 0);
        }
        bf16_t* outp = (bf16_t*)(ws + (kv ? WS_VC : WS_KC)) + (size_t)bg * 256 * 64 + 32 * wave + r32;
#pragma unroll
        for (int r = 0; r < 16; ++r) { const int n = n0 + crow(r, hi); outp[(size_t)n * 64] = (n < NCMP) ? f2bf(o[r]) : (bf16_t)0; }
    }
    __syncthreads();
}
__device__ __forceinline__ void compress_phase(unsigned char* ws, lds_ptr lds, int l, int bid, int G, int tid, int wave, int lane) {
    for (int u = bid; u < 2 * 16 * 8; u += G) compress_unit(ws, lds, l, u >> 7, (u >> 3) & 15, u & 7, tid, wave, lane);
}

constexpr int L_KCI = 0, L_VCI = 32768, L_IMP = 65536, L_WSF2 = 131072 + 512;
__device__ __forceinline__ void cmp_unit(unsigned char* ws, lds_ptr lds, int bg, int qb, int tid, int wave, int lane) {
    asm volatile("" : "+v"(tid), "+v"(lane));
    const int b = bg >> 1, g = bg & 1, t0 = 256 * qb, r32 = lane & 31, hi = lane >> 5; const size_t m0 = (size_t)b * SEQ;
    const bf16_t* ACT = (const bf16_t*)(ws + WS_ACT); const bf16_t* KC = (const bf16_t*)(ws + WS_KC) + (size_t)bg * 256 * 64; const bf16_t* VC = (const bf16_t*)(ws + WS_VC) + (size_t)bg * 256 * 64;
    { const int tlast = t0 + 255; const int nvmax = (tlast >= 31) ? min(NCMP, (tlast - 31) / 16 + 1) : 0; const int nblk_u = (nvmax + 31) >> 5;
      for (int idx = tid; idx < nblk_u * 32 * 8; idx += 512) { const int key = idx >> 3, c = idx & 7;
        *(CM_LAS u32x4*)(lds + L_KCI + c * 4096 + key * 16) = *(const u32x4*)(KC + key * 64 + c * 8);
        *(CM_LAS u32x4*)(lds + L_VCI + (c >> 2) * 16384 + (key >> 4) * 1024 + (key & 15) * 64 + (c & 3) * 16) = *(const u32x4*)(VC + key * 64 + c * 8); } }
    __syncthreads();
    const int t = t0 + 32 * wave + r32;
    const int nv = (t >= 31) ? min(NCMP, (t - 31) / 16 + 1) : 0;
    const int tl = t0 + 32 * wave + 31; const int nvw = (tl >= 31) ? min(NCMP, (tl - 31) / 16 + 1) : 0; const int nblk = (nvw + 31) >> 5;
    CM_LAS float* impw = (CM_LAS float*)(lds + L_IMP) + wave * 2048 + lane;
    CM_LAS float* wsf = (CM_LAS float*)(lds + L_WSF2) + wave * 64;
    lds_cptr kb = (lds_cptr)lds + L_KCI + hi * 4096 + r32 * 16;
    lds_cptr vlane = (lds_cptr)lds + L_VCI + ((lane >> 4) & 1) * 32 + (lane & 3) * 8 + (4 * hi + ((lane & 15) >> 2)) * 64;
    for (int hh = 0; hh < 3; ++hh) {
        const int h = 3 * g + hh;
        bf16x8 qr[4];
#pragma unroll
        for (int d0 = 0; d0 < 4; ++d0) qr[d0] = *(const bf16x8*)(ACT + (m0 + t) * ACTW + A_NQ + h * 64 + d0 * 16 + hi * 8);
        f32x16 s[8];
#pragma unroll
        for (int nbk = 0; nbk < 8; ++nbk) { f32x16 z = {}; s[nbk] = z;
            if (nbk < nblk) {
#pragma unroll
                for (int d0 = 0; d0 < 4; ++d0) { const bf16x8 kf = *(const CM_LAS bf16x8*)(kb + d0 * 8192 + nbk * 512); s[nbk] = __builtin_amdgcn_mfma_f32_32x32x16_bf16(kf, qr[d0], s[nbk], 0, 0, 0); }
            }
#pragma unroll
            for (int r = 0; r < 16; ++r) { const int n = 32 * nbk + crow(r, hi); if (n >= nv) s[nbk][r] = fa::NEG_INF; }
        }
        float mx = fa::NEG_INF;
#pragma unroll
        for (int nbk = 0; nbk < 8; ++nbk)
#pragma unroll
            for (int r = 0; r < 16; ++r) mx = fmaxf(mx, s[nbk][r]);
        mx = pmax32(mx);
        const float mu = (mx == fa::NEG_INF) ? 0.f : mx;
        float lsum = 0.f;
#pragma unroll
        for (int nbk = 0; nbk < 8; ++nbk)
#pragma unroll
            for (int r = 0; r < 16; ++r) { s[nbk][r] = ex2(s[nbk][r] - mu); lsum += s[nbk][r]; }
        lsum = psum32(lsum);
        const float inv = (lsum > 0.f) ? 1.f / lsum : 0.f;
        f32x16 o[2]; { f32x16 z = {}; o[0] = z; o[1] = z; }
        float eprev = 0.f;
#pragma unroll
        for (int nbk = 0; nbk < 8; ++nbk) {
            if (nbk < nblk) {
#pragma unroll
                for (int r = 0; r < 16; ++r) s[nbk][r] *= inv;
#pragma unroll
                for (int gq = 0; gq < 4; ++gq) {
                    const float G = (s[nbk][4 * gq] + s[nbk][4 * gq + 1]) + (s[nbk][4 * gq + 2] + s[nbk][4 * gq + 3]);
                    const float eP = pxchg32(s[nbk][4 * gq + 3], hi);
                    const float val = G + ((hi == 1) ? eP : eprev);
                    CM_LAS float* ip = impw + 64 * (4 * nbk + gq);
                    if (hh == 0) *ip = val; else *ip += val;
                    eprev = eP;
                }
                u32x4 w0, w1;
                w0.x = cvtpk(s[nbk][0], s[nbk][1]); w0.y = cvtpk(s[nbk][2], s[nbk][3]); w0.z = cvtpk(s[nbk][4], s[nbk][5]); w0.w = cvtpk(s[nbk][6], s[nbk][7]);
                w1.x = cvtpk(s[nbk][8], s[nbk][9]); w1.y = cvtpk(s[nbk][10], s[nbk][11]); w1.z = cvtpk(s[nbk][12], s[nbk][13]); w1.w = cvtpk(s[nbk][14], s[nbk][15]);
                const bf16x8 pa0 = __builtin_bit_cast(bf16x8, w0), pa1 = __builtin_bit_cast(bf16x8, w1);
#pragma unroll
                for (int d0 = 0; d0 < 2; ++d0) {
                    { const s16x4 lo = vtr(vlane + d0 * 16384 + (2 * nbk) * 1024), hi_ = vtr(vlane + d0 * 16384 + (2 * nbk) * 1024 + 512);
                      const bf16x8 vf = {lo[0], lo[1], lo[2], lo[3], hi_[0], hi_[1], hi_[2], hi_[3]}; o[d0] = __builtin_amdgcn_mfma_f32_32x32x16_bf16(pa0, vf, o[d0], 0, 0, 0); }
                    { const s16x4 lo = vtr(vlane + d0 * 16384 + (2 * nbk + 1) * 1024), hi_ = vtr(vlane + d0 * 16384 + (2 * nbk + 1) * 1024 + 512);
                      const bf16x8 vf = {lo[0], lo[1], lo[2], lo[3], hi_[0], hi_[1], hi_[2], hi_[3]}; o[d0] = __builtin_amdgcn_mfma_f32_32x32x16_bf16(pa1, vf, o[d0], 0, 0, 0); }
                }
            } else if (hh == 0) {
#pragma unroll
                for (int gq = 0; gq < 4; ++gq) impw[64 * (4 * nbk + gq)] = 0.f;
            }
        }
        const float gc = bf2f(ACT[(m0 + t) * ACTW + A_GATE + h * 3 + 0]);
        asm volatile("s_waitcnt lgkmcnt(0)" ::: "memory");
        if (hi == 0) wsf[r32] = gc;
        asm volatile("s_waitcnt lgkmcnt(0)" ::: "memory");
        bf16_t* OC = (bf16_t*)(ws + WS_OC) + (m0 + t0 + 32 * wave) * 384 + h * 64 + r32;
#pragma unroll
        for (int r = 0; r < 16; ++r) { const int q = crow(r, hi); const float gq = wsf[q]; OC[(size_t)q * 384] = f2bf(o[0][r] * gq); OC[(size_t)q * 384 + 32] = f2bf(o[1][r] * gq); }
    }
    {
        asm volatile("s_waitcnt lgkmcnt(0)" ::: "memory");
        const int cur = t >> 6; float v[32];
#pragma unroll
        for (int i = 0; i < 32; ++i) { const int j = 2 * i + hi; const float im = impw[64 * i];
            const bool valid = (j * 64 <= t), forced = (j == 0) || (j == cur) || (j == cur - 1); v[i] = valid ? (forced ? 1e9f : im) : -1e9f; }
        unsigned mymask = 0u;
        for (int rnd = 0; rnd < 16; ++rnd) {
            float bv = -3.0e38f; int bi = 0;
#pragma unroll
            for (int i = 0; i < 32; ++i) { if (v[i] > bv) { bv = v[i]; bi = i; } }
            const int bj = 2 * bi + hi;
            const float ov = pxchg32(bv, hi); const int oj = __float_as_int(pxchg32(__int_as_float(bj), hi));
            const bool mine = (bv > ov) || (bv == ov && bj < oj);
            if (mine) { mymask |= (1u << bi);
#pragma unroll
                for (int i = 0; i < 32; ++i) if (i == bi) v[i] = -3.4e38f; }
        }
        u64 m64 = 0ull;
#pragma unroll
        for (int i = 0; i < 32; ++i) m64 |= (u64)((mymask >> i) & 1u) << (2 * i);
        m64 <<= hi;
        const unsigned plo = __float_as_uint(pxchg32(__uint_as_float((unsigned)m64), hi)), phi = __float_as_uint(pxchg32(__uint_as_float((unsigned)(m64 >> 32)), hi));
        m64 |= ((u64)phi << 32) | plo;
        const u64 vmask = (cur >= 63) ? ~0ull : ((1ull << (cur + 1)) - 1ull);
        if (hi == 0) ((u64*)(ws + WS_SEL))[(size_t)bg * SEQ + t] = m64 & vmask;
    }
    __syncthreads();
}
__device__ __forceinline__ void cmp_phase(unsigned char* ws, lds_ptr lds, unsigned* qctr, int tid, int wave, int lane) {
    CM_LAS int* ubox = (CM_LAS int*)(lds + L_WSF2 + 2048);
    for (;;) {
        if (tid == 0) ubox[0] = (int)atomicAdd(qctr, 1u);
        __syncthreads();
        const int u = ubox[0];
        __syncthreads();
        if (u >= 256) break;
        cmp_unit(ws, lds, u & 15, 15 - (u >> 4), tid, wave, lane);
    }
}
}
constexpr int NWAVES = 8;
constexpr int RING_BYTES = 131072;
constexpr int LDSCTL_OFF = RING_BYTES, MISC_OFF = LDSCTL_OFF + 320;
constexpr int LDS_BYTES = 147456;
constexpr int CW_BAR = 4096;
constexpr size_t CTL_ZERO_BYTES = 256 * 1024;
constexpr int CW_Q = 1024;

#ifndef PROBE_DUP
#define PROBE_DUP (-1)
#endif
#ifndef PROBE_P3
#define PROBE_P3 (0)
#endif
constexpr int PH_PRO = 0, PH_L0 = 1, PH_PER_LAYER = 6, PH_FINAL = 1 + 2 * PH_PER_LAYER, PH_COUNT = PH_FINAL + 1;
constexpr int PK_NORM = 0, PK_INPROJ = 1, PK_P3 = 2, PK_P4 = 3, PK_ATTN = 4, PK_OUTPROJ = 5;

struct Args { const void* in[19]; float* out; unsigned char* ws; RopeInv inv; int ph_lo, ph_hi; };

__device__ __forceinline__ float wave_sum(float v) {
    v += xs_f<1>(v); v += xs_f<2>(v); v += xs_f<4>(v); v += xs_f<8>(v); v += xs_f<16>(v); return psum32(v);
}

__device__ __forceinline__ int rope_head_base(int pn, int hh) {
    if (pn == 0) return 64 * hh;
    if (pn == 1) return (hh < 2) ? 256 + 64 * hh : 384 + 64 * (hh - 2);
    return (hh < 2) ? 640 + 64 * hh : 896 + 64 * (hh - 2);
}
__device__ __forceinline__ void gen_group(int L, int& base, int& op) {
    if (L < 4) { base = 512 + 32 * L; op = 0; }
    else if (L < 8) { base = 768 + 32 * (L - 4); op = 0; }
    else if (L < 12) { base = 1024 + 32 * (L - 8); op = 0; }
    else if (L < 22) { base = 1536 + 32 * (L - 12); op = 2; }
    else if (L < 42) { base = 1856 + 32 * (L - 22); op = 0; }
    else if (L < 48) { base = 2816 + 32 * (L - 42); op = 0; }
    else if (L < 60) { base = 1152 + 32 * (L - 48); op = 1; }
    else if (L < 70) { base = 2496 + 32 * (L - 60); op = 1; }
    else { base = 3200 + 32 * (L - 70); op = 1; }
}
__device__ __forceinline__ int phys_to_act(int pn, int p) {
    if (pn < 3) { const int f = p >> 7, hh = (p >> 5) & 3, i = p & 31; return rope_head_base(pn, hh) + 32 * f + i; }
    if (pn < 13) { int base, op; gen_group((pn - 3) * 8 + (p >> 5), base, op); return base + (p & 31); }
    const int bj = p >> 7, q = p & 127;
    if (q < 64) return A_MCKV + 64 * bj + q;
    if (q < 80) return A_MKR + 16 * bj + (q - 64);
    if (q < 96) { const int gi = 16 * bj + (q - 80); return gi < 18 ? A_GATE + gi : -1; }
    return -1;
}

struct EpiInProj {
    static constexpr bool PERM = true, AFTER_DRAIN = false;
    bf16_t* ACT; const float* cs64; const float* cs32; float* ssqp; bf16_t* MKp;
    __device__ __forceinline__ void operator()(const pg8::f32x4 (&acc)[2][2][4][2], const pg8::Unit& u, int wr, int wc, int fr, int fq) const {
        using pg8::cvt_pk_bf16; typedef pg8::u32x4 u32x4;
        const int pn = u.pn; const int row0 = u.pm * 256 + wr * 64 + fr;
        if (pn < 3) {
            const int hb = rope_head_base(pn, wc) + 8 * fq; const float sc = (pn == 0 || (pn == 1 && wc < 2)) ? QS_NSA : 1.f;
#pragma unroll
            for (int ai = 0; ai < 2; ++ai)
#pragma unroll
                for (int m = 0; m < 4; ++m) {
                    const int row = row0 + ai * 128 + m * 16;
                    const f32x4* cp = (const f32x4*)(cs64 + ((size_t)row * 32 + 8 * fq) * 2);
                    const f32x4 t0 = cp[0], t1 = cp[1], t2 = cp[2], t3 = cp[3];
                    const f32x4 a0 = acc[ai][0][m][0], a1 = acc[ai][0][m][1], b0 = acc[ai][1][m][0], b1 = acc[ai][1][m][1];
                    float o1[8], o2[8];
                    o1[0] = a0[0] * t0[0] - b0[0] * t0[1]; o2[0] = b0[0] * t0[0] + a0[0] * t0[1];
                    o1[1] = a0[1] * t0[2] - b0[1] * t0[3]; o2[1] = b0[1] * t0[2] + a0[1] * t0[3];
                    o1[2] = a0[2] * t1[0] - b0[2] * t1[1]; o2[2] = b0[2] * t1[0] + a0[2] * t1[1];
                    o1[3] = a0[3] * t1[2] - b0[3] * t1[3]; o2[3] = b0[3] * t1[2] + a0[3] * t1[3];
                    o1[4] = a1[0] * t2[0] - b1[0] * t2[1]; o2[4] = b1[0] * t2[0] + a1[0] * t2[1];
                    o1[5] = a1[1] * t2[2] - b1[1] * t2[3]; o2[5] = b1[1] * t2[2] + a1[1] * t2[3];
                    o1[6] = a1[2] * t3[0] - b1[2] * t3[1]; o2[6] = b1[2] * t3[0] + a1[2] * t3[1];
                    o1[7] = a1[3] * t3[2] - b1[3] * t3[3]; o2[7] = b1[3] * t3[2] + a1[3] * t3[3];
                    u32x4 w1, w2;
                    w1.x = cvt_pk_bf16(o1[0] * sc, o1[1] * sc); w1.y = cvt_pk_bf16(o1[2] * sc, o1[3] * sc); w1.z = cvt_pk_bf16(o1[4] * sc, o1[5] * sc); w1.w = cvt_pk_bf16(o1[6] * sc, o1[7] * sc);
                    w2.x = cvt_pk_bf16(o2[0] * sc, o2[1] * sc); w2.y = cvt_pk_bf16(o2[2] * sc, o2[3] * sc); w2.z = cvt_pk_bf16(o2[4] * sc, o2[5] * sc); w2.w = cvt_pk_bf16(o2[6] * sc, o2[7] * sc);
                    bf16_t* rp = ACT + (size_t)row * ACTW + hb;
                    *(u32x4*)rp = w1; *(u32x4*)(rp + 32) = w2;
                }
        } else if (pn < 13) {
#pragma unroll
            for (int bj = 0; bj < 2; ++bj) {
                int base, op; gen_group((pn - 3) * 8 + bj * 4 + wc, base, op);
#pragma unroll
                for (int ai = 0; ai < 2; ++ai)
#pragma unroll
                    for (int m = 0; m < 4; ++m) {
                        const int row = row0 + ai * 128 + m * 16;
                        f32x4 v0 = acc[ai][bj][m][0], v1 = acc[ai][bj][m][1];
                        if (op == 1) {
#pragma unroll
                            for (int e = 0; e < 4; ++e) { v0[e] = silu_f(v0[e]); v1[e] = silu_f(v1[e]); }
                        } else if (op == 2) { v0 = v0 * 0.125f; v1 = v1 * 0.125f; }
                        u32x4 w; w.x = cvt_pk_bf16(v0[0], v0[1]); w.y = cvt_pk_bf16(v0[2], v0[3]); w.z = cvt_pk_bf16(v1[0], v1[1]); w.w = cvt_pk_bf16(v1[2], v1[3]);
                        *(u32x4*)(ACT + (size_t)row * ACTW + base + 8 * fq) = w;
                        const int L = (pn - 3) * 8 + bj * 4 + wc;
                        if (L >= 42 && L < 48) {
                            float ss = (v0[0] * v0[0] + v0[1] * v0[1]) + (v0[2] * v0[2] + v0[3] * v0[3]) + (v1[0] * v1[0] + v1[1] * v1[1]) + (v1[2] * v1[2] + v1[3] * v1[3]);
                            ss += xs_f<16>(ss); ss = psum32(ss);
                            if (fq == 0) ssqp[(size_t)row * 16 + (L - 42)] = ss;
                        }
                    }
            }
        } else {
            if (wc < 2) {
#pragma unroll
                for (int bj = 0; bj < 2; ++bj)
#pragma unroll
                    for (int ai = 0; ai < 2; ++ai)
#pragma unroll
                        for (int m = 0; m < 4; ++m) {
                            const int row = row0 + ai * 128 + m * 16;
                            const f32x4 v0 = acc[ai][bj][m][0], v1 = acc[ai][bj][m][1];
                            u32x4 w; w.x = cvt_pk_bf16(v0[0], v0[1]); w.y = cvt_pk_bf16(v0[2], v0[3]); w.z = cvt_pk_bf16(v1[0], v1[1]); w.w = cvt_pk_bf16(v1[2], v1[3]);
                            *(u32x4*)(ACT + (size_t)row * ACTW + A_MCKV + 64 * bj + 32 * wc + 8 * fq) = w;
                            float ss = (v0[0] * v0[0] + v0[1] * v0[1]) + (v0[2] * v0[2] + v0[3] * v0[3]) + (v1[0] * v1[0] + v1[1] * v1[1]) + (v1[2] * v1[2] + v1[3] * v1[3]);
                            ss += xs_f<16>(ss); ss = psum32(ss);
                            if (fq == 0) ssqp[(size_t)row * 16 + 6 + bj * 2 + wc] = ss;
                        }
            } else if (wc == 2) {
#pragma unroll
                for (int ai = 0; ai < 2; ++ai)
#pragma unroll
                    for (int m = 0; m < 4; ++m) {
                        const int row = row0 + ai * 128 + m * 16;
                        const f32x4 a0 = acc[ai][0][m][0], a1 = acc[ai][0][m][1], b0 = acc[ai][1][m][0], b1 = acc[ai][1][m][1];
                        if (fq < 2) {
                            const f32x4* cp = (const f32x4*)(cs32 + ((size_t)row * 16 + 8 * fq) * 2);
                            const f32x4 t0 = cp[0], t1 = cp[1], t2 = cp[2], t3 = cp[3];
                            float o1[8], o2[8];
                            o1[0] = a0[0] * t0[0] - b0[0] * t0[1]; o2[0] = b0[0] * t0[0] + a0[0] * t0[1];
                            o1[1] = a0[1] * t0[2] - b0[1] * t0[3]; o2[1] = b0[1] * t0[2] + a0[1] * t0[3];
                            o1[2] = a0[2] * t1[0] - b0[2] * t1[1]; o2[2] = b0[2] * t1[0] + a0[2] * t1[1];
                            o1[3] = a0[3] * t1[2] - b0[3] * t1[3]; o2[3] = b0[3] * t1[2] + a0[3] * t1[3];
                            o1[4] = a1[0] * t2[0] - b1[0] * t2[1]; o2[4] = b1[0] * t2[0] + a1[0] * t2[1];
                            o1[5] = a1[1] * t2[2] - b1[1] * t2[3]; o2[5] = b1[1] * t2[2] + a1[1] * t2[3];
                            o1[6] = a1[2] * t3[0] - b1[2] * t3[1]; o2[6] = b1[2] * t3[0] + a1[2] * t3[1];
                            o1[7] = a1[3] * t3[2] - b1[3] * t3[3]; o2[7] = b1[3] * t3[2] + a1[3] * t3[3];
                            u32x4 w1, w2;
                            w1.x = cvt_pk_bf16(o1[0], o1[1]); w1.y = cvt_pk_bf16(o1[2], o1[3]); w1.z = cvt_pk_bf16(o1[4], o1[5]); w1.w = cvt_pk_bf16(o1[6], o1[7]);
                            w2.x = cvt_pk_bf16(o2[0], o2[1]); w2.y = cvt_pk_bf16(o2[2], o2[3]); w2.z = cvt_pk_bf16(o2[4], o2[5]); w2.w = cvt_pk_bf16(o2[6], o2[7]);
                            bf16_t* rp = ACT + (size_t)row * ACTW + A_MKR + 8 * fq;
                            *(u32x4*)rp = w1; *(u32x4*)(rp + 16) = w2;
#pragma unroll
                            for (int hh = 0; hh < 5; ++hh) { bf16_t* kp = MKp + (size_t)row * 480 + hh * 96 + 64 + 8 * fq; *(u32x4*)kp = w1; *(u32x4*)(kp + 16) = w2; }
                        } else {
                            const int g0 = 8 * (fq - 2);
                            float ga[8], gb[8];
#pragma unroll
                            for (int e = 0; e < 4; ++e) { ga[e] = a0[e]; ga[4 + e] = a1[e]; gb[e] = b0[e]; gb[4 + e] = b1[e]; }
#pragma unroll
                            for (int e = 0; e < 8; ++e) { ga[e] = (g0 + e < 18) ? sigm_f(ga[e]) : 0.f; gb[e] = (16 + g0 + e < 18) ? sigm_f(gb[e]) : 0.f; }
                            u32x4 w1, w2;
                            w1.x = cvt_pk_bf16(ga[0], ga[1]); w1.y = cvt_pk_bf16(ga[2], ga[3]); w1.z = cvt_pk_bf16(ga[4], ga[5]); w1.w = cvt_pk_bf16(ga[6], ga[7]);
                            w2.x = cvt_pk_bf16(gb[0], gb[1]); w2.y = cvt_pk_bf16(gb[2], gb[3]); w2.z = cvt_pk_bf16(gb[4], gb[5]); w2.w = cvt_pk_bf16(gb[6], gb[7]);
                            bf16_t* rp = ACT + (size_t)row * ACTW + A_GATE + g0;
                            *(u32x4*)rp = w1; *(u32x4*)(rp + 16) = w2;
                        }
                    }
            }
        }
    }
};

struct EpiOutProj {
    static constexpr bool PERM = false, AFTER_DRAIN = false;
    const float* xin; float* xout; const float* gate;
    __device__ __forceinline__ void operator()(const pg8::f32x4 (&acc)[2][2][4][2], const pg8::Unit& u, int wr, int wc, int fr, int fq) const {
        const int col0 = u.pn * 256 + wc * 32 + 4 * fq;
#pragma unroll
        for (int ai = 0; ai < 2; ++ai)
#pragma unroll
            for (int m = 0; m < 4; ++m) {
                const int row = u.pm * 256 + ai * 128 + wr * 64 + m * 16 + fr; const int b = row / SEQ;
                const size_t off = (size_t)row * DM + col0; const float* gp = gate + (size_t)b * 3072 + col0;
#pragma unroll
                for (int bj = 0; bj < 2; ++bj)
#pragma unroll
                    for (int n = 0; n < 2; ++n) {
                        const f32x4 g4 = *(const f32x4*)(gp + bj * 128 + n * 16); const f32x4 xi = *(const f32x4*)(xin + off + bj * 128 + n * 16);
                        *(f32x4*)(xout + off + bj * 128 + n * 16) = xi + g4 * acc[ai][bj][m][n];
                    }
            }
    }
};

__device__ __forceinline__ int wuq_src(int p) {
    if (p < 256) return (p >> 6) * 96 + (p & 63);
    const int q = p - 256, bj = q >> 7, r = q & 127;
    if (r < 80) return (r >> 4) * 96 + 64 + 16 * bj + (r & 15);
    const int idx = (r - 80) + 48 * bj; return idx < 64 ? 4 * 96 + idx : -1;
}
__device__ __forceinline__ int wukv_src(int p) {
    if (p < 320) return (p >> 6) * 128 + (p & 63);
    if (p < 640) { const int q = p - 320; return (q >> 6) * 128 + 64 + (q & 63); }
    return -1;
}
struct EpiQUp {
    static constexpr bool PERM = true, AFTER_DRAIN = false;
    bf16_t* MQ; const float* ssqp; const float* cs32;
    __device__ __forceinline__ void operator()(const pg8::f32x4 (&acc)[2][2][4][2], const pg8::Unit& u, int wr, int wc, int fr, int fq) const {
        using pg8::cvt_pk_bf16; typedef pg8::u32x4 u32x4;
        const int row0 = u.pm * 256 + wr * 64 + fr; const int q = 32 * wc + 8 * fq;
#pragma unroll
        for (int ai = 0; ai < 2; ++ai)
#pragma unroll
            for (int m = 0; m < 4; ++m) {
                const int row = row0 + ai * 128 + m * 16;
                const f32x4 sa = *(const f32x4*)(ssqp + (size_t)row * 16); const float2 sb = *(const float2*)(ssqp + (size_t)row * 16 + 4);
                const float rs = rsqrtf(((sa[0] + sa[1]) + (sa[2] + sa[3]) + (sb.x + sb.y)) * (1.f / 192.f) + 1e-6f) * QS_MLA;
                const f32x4 a0 = acc[ai][0][m][0], a1 = acc[ai][0][m][1], b0 = acc[ai][1][m][0], b1 = acc[ai][1][m][1];
                bf16_t* rowp = MQ + (size_t)row * 480;
                if (u.pn == 0) {
                    u32x4 w1, w2;
                    w1.x = cvt_pk_bf16(a0[0] * rs, a0[1] * rs); w1.y = cvt_pk_bf16(a0[2] * rs, a0[3] * rs); w1.z = cvt_pk_bf16(a1[0] * rs, a1[1] * rs); w1.w = cvt_pk_bf16(a1[2] * rs, a1[3] * rs);
                    w2.x = cvt_pk_bf16(b0[0] * rs, b0[1] * rs); w2.y = cvt_pk_bf16(b0[2] * rs, b0[3] * rs); w2.z = cvt_pk_bf16(b1[0] * rs, b1[1] * rs); w2.w = cvt_pk_bf16(b1[2] * rs, b1[3] * rs);
                    *(u32x4*)(rowp + (q >> 6) * 96 + (q & 63)) = w1;
                    *(u32x4*)(rowp + (2 + (q >> 6)) * 96 + (q & 63)) = w2;
                } else if (q < 80) {
                    const int head = q >> 4, i = q & 15;
                    const f32x4* cp = (const f32x4*)(cs32 + ((size_t)row * 16 + i) * 2);
                    const f32x4 t0 = cp[0], t1 = cp[1], t2 = cp[2], t3 = cp[3];
                    float o1[8], o2[8];
                    o1[0] = a0[0] * t0[0] - b0[0] * t0[1]; o2[0] = b0[0] * t0[0] + a0[0] * t0[1];
                    o1[1] = a0[1] * t0[2] - b0[1] * t0[3]; o2[1] = b0[1] * t0[2] + a0[1] * t0[3];
                    o1[2] = a0[2] * t1[0] - b0[2] * t1[1]; o2[2] = b0[2] * t1[0] + a0[2] * t1[1];
                    o1[3] = a0[3] * t1[2] - b0[3] * t1[3]; o2[3] = b0[3] * t1[2] + a0[3] * t1[3];
                    o1[4] = a1[0] * t2[0] - b1[0] * t2[1]; o2[4] = b1[0] * t2[0] + a1[0] * t2[1];
                    o1[5] = a1[1] * t2[2] - b1[1] * t2[3]; o2[5] = b1[1] * t2[2] + a1[1] * t2[3];
                    o1[6] = a1[2] * t3[0] - b1[2] * t3[1]; o2[6] = b1[2] * t3[0] + a1[2] * t3[1];
                    o1[7] = a1[3] * t3[2] - b1[3] * t3[3]; o2[7] = b1[3] * t3[2] + a1[3] * t3[3];
                    u32x4 w1, w2;
                    w1.x = cvt_pk_bf16(o1[0] * rs, o1[1] * rs); w1.y = cvt_pk_bf16(o1[2] * rs, o1[3] * rs); w1.z = cvt_pk_bf16(o1[4] * rs, o1[5] * rs); w1.w = cvt_pk_bf16(o1[6] * rs, o1[7] * rs);
                    w2.x = cvt_pk_bf16(o2[0] * rs, o2[1] * rs); w2.y = cvt_pk_bf16(o2[2] * rs, o2[3] * rs); w2.z = cvt_pk_bf16(o2[4] * rs, o2[5] * rs); w2.w = cvt_pk_bf16(o2[6] * rs, o2[7] * rs);
                    *(u32x4*)(rowp + head * 96 + 64 + i) = w1; *(u32x4*)(rowp + head * 96 + 80 + i) = w2;
                } else {
                    const int idx0 = q - 80;
                    u32x4 w1; w1.x = cvt_pk_bf16(a0[0] * rs, a0[1] * rs); w1.y = cvt_pk_bf16(a0[2] * rs, a0[3] * rs); w1.z = cvt_pk_bf16(a1[0] * rs, a1[1] * rs); w1.w = cvt_pk_bf16(a1[2] * rs, a1[3] * rs);
                    *(u32x4*)(rowp + 384 + idx0) = w1;
                    if (48 + idx0 < 64) { u32x4 w2; w2.x = cvt_pk_bf16(b0[0] * rs, b0[1] * rs); w2.y = cvt_pk_bf16(b0[2] * rs, b0[3] * rs); w2.z = cvt_pk_bf16(b1[0] * rs, b1[1] * rs); w2.w = cvt_pk_bf16(b1[2] * rs, b1[3] * rs);
                        *(u32x4*)(rowp + 384 + 48 + idx0) = w2; }
                }
            }
    }
};
struct EpiKVUp {
    static constexpr bool PERM = true, AFTER_DRAIN = false;
    bf16_t* MKp; bf16_t* MV; const float* ssqp;
    __device__ __forceinline__ void operator()(const pg8::f32x4 (&acc)[2][2][4][2], const pg8::Unit& u, int wr, int wc, int fr, int fq) const {
        using pg8::cvt_pk_bf16; typedef pg8::u32x4 u32x4;
        const int row0 = u.pm * 256 + wr * 64 + fr;
#pragma unroll
        for (int ai = 0; ai < 2; ++ai)
#pragma unroll
            for (int m = 0; m < 4; ++m) {
                const int row = row0 + ai * 128 + m * 16;
                const f32x4 sa = *(const f32x4*)(ssqp + (size_t)row * 16 + 6 - 2);
                const float2 sb = *(const float2*)(ssqp + (size_t)row * 16 + 8);
                const float rs = rsqrtf(((sa[2] + sa[3]) + (sb.x + sb.y)) * (1.f / 128.f) + 1e-6f);
#pragma unroll
                for (int bj = 0; bj < 2; ++bj) {
                    const int p = u.pn * 256 + 128 * bj + 32 * wc + 8 * fq;
                    const f32x4 v0 = acc[ai][bj][m][0] * rs, v1 = acc[ai][bj][m][1] * rs;
                    u32x4 w; w.x = cvt_pk_bf16(v0[0], v0[1]); w.y = cvt_pk_bf16(v0[2], v0[3]); w.z = cvt_pk_bf16(v1[0], v1[1]); w.w = cvt_pk_bf16(v1[2], v1[3]);
                    if (p < 320) *(u32x4*)(MKp + (size_t)row * 480 + (p >> 6) * 96 + (p & 63)) = w;
                    else if (p < 640) *(u32x4*)(MV + (size_t)row * 320 + (p - 320)) = w;
                }
            }
    }
};

__device__ __forceinline__ void tr_item(const float* W, int ldw, int srccol, bf16_t* WT, int K, int wt_row0, int k0, LAS float* scr, int lane, const float* kscale = nullptr) {
#pragma unroll 8
    for (int i = 0; i < 32; ++i) { const int kk = 2 * i + (lane >> 5); float v = (srccol >= 0) ? W[(size_t)(k0 + kk) * ldw + srccol] : 0.f; if (kscale) v *= kscale[k0 + kk]; scr[kk * 33 + (lane & 31)] = v; }
    LDS_WAIT(); asm volatile("" ::: "memory");
    const int c = lane & 7;
#pragma unroll
    for (int j = 0; j < 4; ++j) { const int n = (lane >> 3) + 8 * j; const LAS float* s = scr + (8 * c) * 33 + n;
        v4u o; o.x = pk2(s[0 * 33], s[1 * 33]); o.y = pk2(s[2 * 33], s[3 * 33]); o.z = pk2(s[4 * 33], s[5 * 33]); o.w = pk2(s[6 * 33], s[7 * 33]);
        *(v4u*)(WT + (size_t)(wt_row0 + n) * K + k0 + 8 * c) = o; }
    LDS_WAIT(); asm volatile("" ::: "memory");
}

struct MK {
    LAS unsigned char* lds; int tid, lane, wave, G, bid; float* out; unsigned char* ws;
};
#define ARGF(A, i) ((const float*)(A).in[i])

__device__ __forceinline__ void ph_prologue(MK& F, const Args& A) {
    const RopeInv& inv = A.inv;
    float* mod = (float*)(F.ws + WS_MOD);
    if (F.bid < DEPTH * 48) {
        LAS float* sc = (LAS float*)F.lds;
        LAS float* red = (LAS float*)(F.lds + 32768);
        const float* cvec = ARGF(A, 1); const float* adab = ARGF(A, 4);
        for (int i = F.tid; i < NB * DM; i += 512) sc[i] = silu_f(cvec[i]);
        __syncthreads();
        for (int item = F.bid; item < DEPTH * 48; item += F.G) {
            const int l = item / 48, col = (item % 48) * 64 + F.lane;
            float acc[NB];
#pragma unroll
            for (int b = 0; b < NB; ++b) acc[b] = 0.f;
            const float* wp = ARGF(A, 3) + ((size_t)l * DM + F.wave * 128) * 3072 + col;
#pragma unroll 8
            for (int k = 0; k < 128; ++k) { const float w = wp[(size_t)k * 3072];
#pragma unroll
                for (int b = 0; b < NB; ++b) acc[b] += sc[b * DM + F.wave * 128 + k] * w; }
#pragma unroll
            for (int b = 0; b < NB; ++b) red[(F.wave * NB + b) * 64 + F.lane] = acc[b];
            __syncthreads();
            { const int b = F.tid >> 6; float s = adab[l * 3072 + col];
#pragma unroll
              for (int w = 0; w < 8; ++w) s += red[(w * NB + b) * 64 + F.lane];
              mod[((size_t)l * NB + b) * 3072 + col] = s; }
            __syncthreads();
        }
    }
    const int gw = F.bid * NWAVES + F.wave, NGW = F.G * NWAVES;
    {
        LAS float* scr = (LAS float*)(F.lds + F.wave * 16384);
        bf16_t* WIN_T = (bf16_t*)(F.ws + WS_WIN_T); bf16_t* WOUT_T = (bf16_t*)(F.ws + WS_WOUT_T);
        bf16_t* WUQ_T = (bf16_t*)(F.ws + WS_WUQ_T); bf16_t* WUKV_T = (bf16_t*)(F.ws + WS_WUKV_T);
        constexpr int I_IN = 16 * 112, I_OUT = 16 * 32, I_UQ = 4 * 16, I_UKV = 2 * 24, I_W1 = 2 * 128, I_W2 = 2 * 4, I_PB = 2 * 32, I_L = I_IN + I_OUT + I_UQ + I_UKV + I_W1 + I_W2 + I_PB, NIT = DEPTH * I_L;
        for (int it = gw; it < NIT; it += NGW) {
            int r = it; const int l = r / I_L; r -= l * I_L;
            if (r < I_IN) { const int kb = r / 112, nb = r % 112; const int prow = nb * 32 + (F.lane & 31); const int act = phys_to_act(prow >> 8, prow & 255); const int src = (act < 0) ? -1 : inproj_src_col(act);
                tr_item(ARGF(A, 6) + (size_t)l * DM * D_IN, D_IN, src, WIN_T + (size_t)l * 3584 * DM, DM, nb * 32, kb * 64, scr, F.lane); }
            else if (r < I_IN + I_OUT) { r -= I_IN; const int kb = r / 32, nb = r % 32;
                tr_item(ARGF(A, 17) + (size_t)l * DM * DM, DM, nb * 32 + (F.lane & 31), WOUT_T + (size_t)l * DM * DM, DM, nb * 32, kb * 64, scr, F.lane); }
            else if (r < I_IN + I_OUT + I_UQ) { r -= I_IN + I_OUT; const int kb = r / 16, nb = r % 16;
                const int src = (kb < 3) ? wuq_src(nb * 32 + (F.lane & 31)) : -1;
                tr_item(ARGF(A, 14) + (size_t)l * 192 * 480, 480, src, WUQ_T + (size_t)l * 512 * 256, 256, nb * 32, kb * 64, scr, F.lane, (kb < 3) ? ARGF(A, 13) + l * 192 : nullptr); }
            else if (r < I_IN + I_OUT + I_UQ + I_UKV) { r -= I_IN + I_OUT + I_UQ; const int kb = r / 24, nb = r % 24;
                tr_item(ARGF(A, 16) + (size_t)l * 128 * 640, 640, wukv_src(nb * 32 + (F.lane & 31)), WUKV_T + (size_t)l * 768 * 128, 128, nb * 32, kb * 64, scr, F.lane, ARGF(A, 15) + l * 128); }
            else if (r < I_IN + I_OUT + I_UQ + I_UKV + I_W1) { r -= I_IN + I_OUT + I_UQ + I_UKV; const int kv = r / 128, kb = (r % 128) / 4, nb = r % 4;
                tr_item(ARGF(A, kv ? 11 : 9) + (size_t)l * 2048 * 128, 128, nb * 32 + (F.lane & 31), (bf16_t*)(F.ws + WS_W1T) + (size_t)(l * 2 + kv) * 128 * 2048, 2048, nb * 32, kb * 64, scr, F.lane); }
            else if (r < I_IN + I_OUT + I_UQ + I_UKV + I_W1 + I_W2) { r -= I_IN + I_OUT + I_UQ + I_UKV + I_W1; const int kv = r / 4, kb = (r % 4) / 2, nb = r % 2;
                tr_item(ARGF(A, kv ? 12 : 10) + (size_t)l * 128 * 64, 64, nb * 32 + (F.lane & 31), (bf16_t*)(F.ws + WS_W2T) + (size_t)(l * 2 + kv) * 64 * 128, 128, nb * 32, kb * 64, scr, F.lane); }
            else { r -= I_IN + I_OUT + I_UQ + I_UKV + I_W1 + I_W2; const int kv = r / 32, ch = r % 32;
                const float* pe = ARGF(A, kv ? 8 : 7) + (size_t)l * 2048 + ch * 64; const float* w1 = ARGF(A, kv ? 11 : 9) + ((size_t)l * 2048 + ch * 64) * 128;
                float s0 = 0.f, s1 = 0.f;
                for (int k = 0; k < 64; ++k) { const float pv_ = pe[k]; s0 += pv_ * w1[(size_t)k * 128 + F.lane]; s1 += pv_ * w1[(size_t)k * 128 + 64 + F.lane]; }
                float* pb = (float*)(F.ws + WS_POSBP) + ((size_t)(l * 2 + kv) * 32 + ch) * 128; pb[F.lane] = s0; pb[64 + F.lane] = s1; }
        }
    }
    {
        float* cs64 = (float*)(F.ws + WS_CS64); float* cs32 = (float*)(F.ws + WS_CS32);
        for (int idx = F.bid * 512 + F.tid; idx < M * 48; idx += F.G * 512) {
            const int m = idx / 48, i = idx % 48; const float p = (float)((const int*)A.in[2])[m]; float s, c;
            if (i < 32) { sincos_rev(p * inv.i64[i], s, c); *(float2*)(cs64 + ((size_t)m * 32 + i) * 2) = make_float2(c, s); }
            else { const int j = i - 32; sincos_rev(p * inv.i32[j], s, c); *(float2*)(cs32 + ((size_t)m * 16 + j) * 2) = make_float2(c, s); }
        }
    }
}

__device__ __forceinline__ void ph_norm_mod(MK& F, const Args& A, const float* xin, int l) {
    const float* g = ARGF(A, 5) + l * DM; const float* mod = (const float*)(F.ws + WS_MOD) + (size_t)l * NB * 3072; bf16_t* H = (bf16_t*)(F.ws + WS_H);
    const int gw = F.bid * NWAVES + F.wave, NGW = F.G * NWAVES;
    for (int row = gw; row < M; row += NGW) {
        const int b = row / SEQ; const f32x4* xr = (const f32x4*)(xin + (size_t)row * DM) + F.lane; f32x4 v[4]; float ss = 0.f;
#pragma unroll
        for (int j = 0; j < 4; ++j) { v[j] = xr[64 * j]; ss += (v[j].x * v[j].x + v[j].y * v[j].y) + (v[j].z * v[j].z + v[j].w * v[j].w); }
        const float r = rsqrtf(wave_sum(ss) * (1.f / DM) + 1e-6f);
        const float* sh = mod + (size_t)b * 3072; const float* sc = sh + 1024;
#pragma unroll
        for (int j = 0; j < 4; ++j) { const int c = 256 * j + 4 * F.lane; const f32x4 g4 = *(const f32x4*)(g + c), s4 = *(const f32x4*)(sc + c), h4 = *(const f32x4*)(sh + c);
            const f32x4 h = v[j] * r * g4 * (s4 + 1.f) + h4;
            uint2 o; o.x = pk2(h.x, h.y); o.y = pk2(h.z, h.w); *(uint2*)(H + (size_t)row * DM + c) = o; }
    }
}
__device__ __forceinline__ void ph_final_norm(MK& F, const Args& A) {
    const float* fnorm = ARGF(A, 18);
    const int gw = F.bid * NWAVES + F.wave, NGW = F.G * NWAVES;
    for (int row = gw; row < M; row += NGW) {
        f32x4* xr = (f32x4*)(F.out + (size_t)row * DM) + F.lane; f32x4 v[4]; float ss = 0.f;
#pragma unroll
        for (int j = 0; j < 4; ++j) { v[j] = xr[64 * j]; ss += (v[j].x * v[j].x + v[j].y * v[j].y) + (v[j].z * v[j].z + v[j].w * v[j].w); }
        const float r = rsqrtf(wave_sum(ss) * (1.f / DM) + 1e-6f);
#pragma unroll
        for (int j = 0; j < 4; ++j) { const f32x4 g4 = *(const f32x4*)(fnorm + 256 * j + 4 * F.lane); xr[64 * j] = v[j] * r * g4; }
    }
}

__global__ void __launch_bounds__(NWAVES * 64, 2) mk_fwd(Args args) {
    extern __shared__ __attribute__((aligned(16))) unsigned char lds[];
    MK F;
    const int s_wave = __builtin_amdgcn_readfirstlane((int)threadIdx.x >> 6);
    F.lds = (LAS unsigned char*)lds; F.tid = threadIdx.x; F.lane = F.tid & 63; F.wave = s_wave; F.G = gridDim.x; F.bid = blockIdx.x;
    F.out = args.out; F.ws = args.ws;
    for (int u = F.tid; u < (LDS_BYTES - LDSCTL_OFF) / 4; u += NWAVES * 64) ((LAS unsigned*)(F.lds + LDSCTL_OFF))[u] = 0u;
    __syncthreads();
    cooperative_groups::grid_group grid = cooperative_groups::this_grid();
    XcdBarrier xbar = xcd_barrier_post((unsigned*)(args.ws + WS_CTL) + CW_BAR, (volatile LAS unsigned*)(F.lds + MISC_OFF) + 8);
#define FRESH_TID(var) int var; asm volatile("v_mbcnt_lo_u32_b32 %0, -1, 0\n\tv_mbcnt_hi_u32_b32 %0, -1, %0" : "=v"(var)); var += s_wave * 64
#define PHASE_BEGIN() { int bid_ = blockIdx.x; asm volatile("" : "+s"(bid_)); F.bid = bid_; unsigned char* ws_ = args.ws; asm volatile("" : "+s"(ws_)); F.ws = ws_; float* out_ = args.out; asm volatile("" : "+s"(out_)); F.out = out_; int g_ = gridDim.x; asm volatile("" : "+s"(g_)); F.G = g_; }
#define REPS(ph) for (int rep = 0; rep < ((PROBE_DUP == (ph)) ? 2 : 1); ++rep)
#define REP_SYNC() do { if (PROBE_DUP >= 0) __syncthreads(); } while (0)
#define LAYER_PHASES(l) \
      \
    PHASE_BEGIN(); REPS(PH_L0 + (l) * PH_PER_LAYER + PK_NORM) { FRESH_TID(t_); F.tid = t_; F.lane = t_ & 63; ph_norm_mod(F, args, ((l) == 0) ? ARGF(args, 0) : (const float*)F.out, (l)); REP_SYNC(); } \
    xcd_barrier(xbar); \
      \
    PHASE_BEGIN(); REPS(PH_L0 + (l) * PH_PER_LAYER + PK_INPROJ) { \
        pg8::Gemm g = pg8::make_gemm((const bf16_t*)(F.ws + WS_H), DM, (const bf16_t*)(F.ws + WS_WIN_T) + (size_t)(l) * 3584 * DM, DM, M, 3584, DM); \
        pg8::StaticOrder S; S.init(M, 3584, F.G, F.bid); \
        EpiInProj E{(bf16_t*)(F.ws + WS_ACT), (const float*)(F.ws + WS_CS64), (const float*)(F.ws + WS_CS32), (float*)(F.ws + WS_SSQP), (bf16_t*)(F.ws + WS_MK)}; \
        { FRESH_TID(ftid); pg8::gemm_phase<EpiInProj, pg8::StaticOrder, true, true>(F.lds, g, S, E, ftid); } REP_SYNC(); } \
    xcd_barrier(xbar); \
      \
    PHASE_BEGIN(); REPS(PH_L0 + (l) * PH_PER_LAYER + PK_P3) { \
        { pg8::Gemm g = pg8::make_gemm((const bf16_t*)(F.ws + WS_ACT) + A_MCQ, ACTW, (const bf16_t*)(F.ws + WS_WUQ_T) + (size_t)(l) * 512 * 256, 256, M, 512, 256); \
          pg8::StaticOrder S; S.init(M, 512, F.G, F.bid); \
          EpiQUp E{(bf16_t*)(F.ws + WS_MQ), (const float*)(F.ws + WS_SSQP), (const float*)(F.ws + WS_CS32)}; \
          { FRESH_TID(ftid); pg8::gemm_phase<EpiQUp, pg8::StaticOrder, true, true>(F.lds, g, S, E, ftid); } } \
        { pg8::Gemm g = pg8::make_gemm((const bf16_t*)(F.ws + WS_ACT) + A_MCKV, ACTW, (const bf16_t*)(F.ws + WS_WUKV_T) + (size_t)(l) * 768 * 128, 128, M, 768, 128); \
          pg8::StaticOrder S; S.init(M, 768, F.G, F.bid); \
          EpiKVUp E{(bf16_t*)(F.ws + WS_MK), (bf16_t*)(F.ws + WS_MV), (const float*)(F.ws + WS_SSQP)}; \
          { FRESH_TID(ftid); pg8::gemm_phase<EpiKVUp, pg8::StaticOrder, true, true>(F.lds, g, S, E, ftid); } } \
        { FRESH_TID(t_); cm::compress_phase(F.ws, (fa::lds_ptr)F.lds, (l), F.bid, F.G, t_, s_wave, t_ & 63); } REP_SYNC(); } \
    xcd_barrier(xbar); \
      \
    PHASE_BEGIN(); REPS(PH_L0 + (l) * PH_PER_LAYER + PK_P4) { FRESH_TID(t_); cm::cmp_phase(F.ws, (fa::lds_ptr)F.lds, (unsigned*)(F.ws + WS_CTL) + CW_Q + 64 * (2 + (l)) + 256 * rep, t_, s_wave, t_ & 63); REP_SYNC(); } \
    xcd_barrier(xbar); \
      \
    PHASE_BEGIN(); REPS(PH_L0 + (l) * PH_PER_LAYER + PK_ATTN) { FRESH_TID(t_); fa::attn_phase(F.ws, (fa::lds_ptr)F.lds, (unsigned*)(F.ws + WS_CTL) + CW_Q + 64 * (l) + 256 * rep, t_, s_wave, t_ & 63); REP_SYNC(); } \
    xcd_barrier(xbar); \
      \
    PHASE_BEGIN(); REPS(PH_L0 + (l) * PH_PER_LAYER + PK_OUTPROJ) { \
        pg8::Gemm g = pg8::make_gemm((const bf16_t*)(F.ws + WS_MIX), DM, (const bf16_t*)(F.ws + WS_WOUT_T) + (size_t)(l) * DM * DM, DM, M, DM, DM); \
        pg8::StaticOrder S; S.init(M, DM, F.G, F.bid); \
        EpiOutProj E{((l) == 0) ? ARGF(args, 0) : (const float*)F.out, F.out, (const float*)(F.ws + WS_MOD) + (size_t)(l) * NB * 3072 + 2048}; \
        { FRESH_TID(ftid); pg8::gemm_phase<EpiOutProj, pg8::StaticOrder, true, true>(F.lds, g, S, E, ftid); } REP_SYNC(); } \
    xcd_barrier(xbar);

    PHASE_BEGIN(); REPS(PH_PRO) { FRESH_TID(t_); F.tid = t_; F.lane = t_ & 63; ph_prologue(F, args); REP_SYNC(); }
    grid.sync();
    LAYER_PHASES(0)
    LAYER_PHASES(1)
    PHASE_BEGIN(); { FRESH_TID(t_); F.tid = t_; F.lane = t_ & 63; ph_final_norm(F, args); }
}
static int g_grid = 0;
static void launch_mk(Args a, int lo, int hi, hipStream_t stream) {
    a.ph_lo = lo; a.ph_hi = hi;
    void* params[] = {&a}; (void)hipLaunchCooperativeKernel((const void*)mk_fwd, dim3(g_grid), dim3(NWAVES * 64), params, LDS_BYTES, stream);
}
extern "C" void kernel_launch(void* const* d_in, const int* in_sizes, int n_in, void* d_out, int out_size, void* d_ws, size_t ws_size, hipStream_t stream) {
    if (n_in != 19 || out_size != M * DM || ws_size < WS_END) { fprintf(stderr, "kernel_launch: unexpected shapes (n_in %d out %d ws %zu)\n", n_in, out_size, ws_size); return; }
    if (g_grid == 0) {
        int dev = 0, cus = 0, per_cu = 0;
        hipGetDevice(&dev); hipDeviceGetAttribute(&cus, hipDeviceAttributeMultiprocessorCount, dev);
        hipFuncSetAttribute((const void*)mk_fwd, hipFuncAttributeMaxDynamicSharedMemorySize, LDS_BYTES);
        hipOccupancyMaxActiveBlocksPerMultiprocessor(&per_cu, (const void*)mk_fwd, NWAVES * 64, LDS_BYTES);
        if (per_cu < 1) { fprintf(stderr, "kernel_launch: occupancy query says %d blocks per CU\n", per_cu); per_cu = 1; }
        g_grid = cus;
        (void)hipGetLastError();
    }
    char* ws = (char*)d_ws;
    Args a{};
    for (int i = 0; i < 19; ++i) a.in[i] = d_in[i];
    a.out = (float*)d_out; a.ws = (unsigned char*)d_ws;
    for (int i = 0; i < 32; ++i) a.inv.i64[i] = (float)std::pow(10000.0, -(double)i / 32.0);
    for (int i = 0; i < 16; ++i) a.inv.i32[i] = (float)std::pow(10000.0, -(double)i / 16.0);
    hipMemsetAsync(ws + WS_CTL, 0, CTL_ZERO_BYTES, stream);

    launch_mk(a, 0, PH_COUNT, stream);
}
```
